# Optimizing an MI355X kernel written in HIP

```python
import jax, jax.numpy as jnp
from jax import lax
import numpy as np

D_MODEL = 2048
BATCH = 16
SEQ = 2048
DEPTH = 4

CHUNK = 64
N_MEM = 256
D_MIX = D_MODEL
POOL_W = D_MIX // 2
POOL_GROUPS = 4
POOL_GROUP_W = POOL_W // POOL_GROUPS
POOL_WINDOWS = (2, 4, 8, 16)
MLSTM_W = D_MIX - POOL_W
MLSTM_HEADS = 4
MLSTM_HEAD_DIM = MLSTM_W // MLSTM_HEADS
CONV_W = 4
D_IN = POOL_W + 4 * MLSTM_W + 2 * MLSTM_HEADS
XATTN_HEADS = 4
XATTN_HEAD_DIM = D_MODEL // XATTN_HEADS
D_FF = ((8 * D_MODEL // 3 + 255) // 256) * 256
EPS = 1e-6

kernel_name = "hymba_pool_mlstm_macaron_xattn"


def rms_norm(x, g):
    xf = x.astype(jnp.float32)
    y = xf * lax.rsqrt(jnp.mean(xf * xf, axis=-1, keepdims=True) + EPS)
    return (y * g.astype(jnp.float32)).astype(x.dtype)


def swiglu(x, w_gate, w_up, w_down):
    return (jax.nn.silu(x @ w_gate) * (x @ w_up)) @ w_down


def causal_dwconv(x, w):
    K = w.shape[0]
    S = x.shape[1]
    xp = jnp.pad(x, ((0, 0), (K - 1, 0), (0, 0)))
    y = xp[:, 0:S] * w[0]
    for j in range(1, K):
        y = y + xp[:, j:j + S] * w[j]
    return y


def multiscale_pool(p, pool_w, pool_scale):
    B, S, _ = p.shape
    pg = p.reshape(B, S, POOL_GROUPS, POOL_GROUP_W).astype(jnp.float32)
    cs = jnp.cumsum(pg, axis=1)
    t = jnp.arange(1, S + 1, dtype=jnp.float32)
    outs = []
    for g, w in enumerate(POOL_WINDOWS):
        c = cs[:, :, g]
        lag = jnp.pad(c[:, :-w], ((0, 0), (w, 0), (0, 0)))
        mean = (c - lag) / jnp.minimum(t, float(w))[None, :, None]
        outs.append(mean - pg[:, :, g])
    d = jnp.stack(outs, axis=2).astype(p.dtype)
    y = jnp.einsum('bsgc,gcd->bsgd', d, pool_w)
    return y.reshape(B, S, POOL_W) * pool_scale


def mlstm_chunkwise(q, k, v, log_i, log_f):
    B, S, H, dk = q.shape
    dv = v.shape[-1]
    nc = S // CHUNK

    def to_chunks(a):
        a = a.reshape((B, nc, CHUNK) + a.shape[2:])
        return jnp.moveaxis(jnp.moveaxis(a, 1, 0), 3, 2)

    qc, kc, vc, lic, lfc = (to_chunks(a) for a in (q, k, v, log_i, log_f))
    tril = jnp.tril(jnp.ones((CHUNK, CHUNK), dtype=bool))

    def step(carry, xs):
        C, n, m = carry
        qb, kb, vb, li, lf = xs
        b = jnp.cumsum(lf, axis=-1)
        Dm = b[..., :, None] - b[..., None, :] + li[..., None, :]
        Dm = jnp.where(tril, Dm, -jnp.inf)
        inter = b + m[..., None]
        m_t = jnp.maximum(inter, jnp.max(Dm, axis=-1))
        W = jnp.exp(Dm - m_t[..., None]) * jnp.einsum('bhtd,bhsd->bhts', qb, kb)
        iw = jnp.exp(inter - m_t)
        num = iw[..., None] * jnp.einsum('bhtk,bhkv->bhtv', qb, C) + jnp.einsum('bhts,bhsv->bhtv', W, vb)
        den = iw * jnp.einsum('bhtk,bhk->bht', qb, n) + jnp.sum(W, axis=-1)
        h = num / jnp.maximum(jnp.abs(den), jnp.exp(-m_t))[..., None]
        bL = b[..., -1]
        g = bL[..., None] - b + li
        m_new = jnp.maximum(bL + m, jnp.max(g, axis=-1))
        decay = jnp.exp(bL + m - m_new)
        ws = jnp.exp(g - m_new[..., None])
        C_new = decay[..., None, None] * C + jnp.einsum('bhs,bhsk,bhsv->bhkv', ws, kb, vb)
        n_new = decay[..., None] * n + jnp.einsum('bhs,bhsk->bhk', ws, kb)
        return (C_new, n_new, m_new), h

    init = (jnp.zeros((B, H, dk, dv), jnp.float32),
            jnp.zeros((B, H, dk), jnp.float32),
            jnp.zeros((B, H), jnp.float32))
    _, hs = lax.scan(step, init, (qc, kc, vc, lic, lfc))
    return jnp.transpose(hs, (1, 0, 3, 2, 4)).reshape(B, S, H, dv)


def token_mix(u, w_in, gate_bias, qk_conv, head_norm, pool_w, pool_scale, w_out):
    B, S, _ = u.shape
    H, dh = MLSTM_HEADS, MLSTM_HEAD_DIM
    z = u @ w_in
    o1 = POOL_W
    o2 = o1 + 2 * MLSTM_W
    o3 = o2 + MLSTM_W
    o4 = o3 + MLSTM_W
    o5 = o4 + H
    p, qk, v, og, gi, gf = z[..., :o1], z[..., o1:o2], z[..., o2:o3], z[..., o3:o4], z[..., o4:o5], z[..., o5:]
    y_pool = multiscale_pool(p, pool_w, pool_scale)
    qk = jax.nn.silu(causal_dwconv(qk, qk_conv)).astype(jnp.float32)
    q = qk[..., :MLSTM_W].reshape(B, S, H, dh) * (dh ** -0.5)
    k = qk[..., MLSTM_W:].reshape(B, S, H, dh)
    vh = v.astype(jnp.float32).reshape(B, S, H, dh)
    gb = gate_bias.astype(jnp.float32)
    log_i = gi.astype(jnp.float32) + gb[:H]
    log_f = jax.nn.log_sigmoid(gf.astype(jnp.float32) + gb[H:])
    h = mlstm_chunkwise(q, k, vh, log_i, log_f)
    h = h * lax.rsqrt(jnp.mean(h * h, axis=-1, keepdims=True) + EPS)
    h = h * head_norm.astype(jnp.float32).reshape(H, dh)
    y_mlstm = h.reshape(B, S, MLSTM_W).astype(u.dtype) * jax.nn.sigmoid(og)
    return jnp.concatenate([y_pool, y_mlstm], axis=-1) @ w_out


def cross_attention(u, mem_n, wq, wkv, wo):
    B, S, _ = u.shape
    q = (u @ wq).reshape(B, S, XATTN_HEADS, XATTN_HEAD_DIM)
    kv = (mem_n @ wkv).reshape(B, mem_n.shape[1], 2, XATTN_HEADS, XATTN_HEAD_DIM)
    k, v = kv[:, :, 0], kv[:, :, 1]
    s = jnp.einsum('bshd,bmhd->bhsm', q, k).astype(jnp.float32) * (XATTN_HEAD_DIM ** -0.5)
    pr = jax.nn.softmax(s, axis=-1).astype(v.dtype)
    o = jnp.einsum('bhsm,bmhd->bshd', pr, v).reshape(B, S, D_MODEL)
    return o @ wo


def setup_inputs(seed: int = 0) -> dict:
    key = jax.random.key(seed)
    ks = jax.random.split(key, 32)
    L, D, F = DEPTH, D_MODEL, D_FF

    def dense(k, shape, fan_in):
        return jax.random.normal(k, shape, jnp.float32) * (fan_in ** -0.5)

    def gain(k, shape):
        return 1.0 + 0.05 * jax.random.normal(k, shape, jnp.float32)

    f_bias = jnp.linspace(3.0, 6.0, MLSTM_HEADS, dtype=jnp.float32)
    gate_bias = jnp.concatenate([
        0.1 * jax.random.normal(ks[20], (L, MLSTM_HEADS), jnp.float32),
        f_bias[None, :] + 0.1 * jax.random.normal(ks[21], (L, MLSTM_HEADS), jnp.float32)], axis=-1)
    return {
        "x": jax.random.normal(ks[0], (BATCH, SEQ, D), jnp.float32),
        "mem": jax.random.normal(ks[1], (BATCH, N_MEM, D), jnp.float32),
        "ffn1_norm": gain(ks[2], (L, D)),
        "ffn1_w_gate": dense(ks[3], (L, D, F), D),
        "ffn1_w_up": dense(ks[4], (L, D, F), D),
        "ffn1_w_down": dense(ks[5], (L, F, D), F),
        "mix_norm": gain(ks[6], (L, D)),
        "w_in": dense(ks[7], (L, D, D_IN), D),
        "gate_bias": gate_bias,
        "qk_conv": dense(ks[8], (L, CONV_W, 2 * MLSTM_W), CONV_W),
        "head_norm": gain(ks[9], (L, MLSTM_W)),
        "pool_w": dense(ks[10], (L, POOL_GROUPS, POOL_GROUP_W, POOL_GROUP_W), POOL_GROUP_W),
        "pool_scale": gain(ks[11], (L, POOL_W)),
        "w_out": dense(ks[12], (L, D_MIX, D), D_MIX),
        "xattn_norm": gain(ks[13], (L, D)),
        "mem_norm": gain(ks[14], (L, D)),
        "xattn_wq": dense(ks[15], (L, D, D), D),
        "xattn_wkv": dense(ks[16], (L, D, 2 * D), D),
        "xattn_wo": dense(ks[17], (L, D, D), D),
        "ffn2_norm": gain(ks[18], (L, D)),
        "ffn2_w_gate": dense(ks[19], (L, D, F), D),
        "ffn2_w_up": dense(ks[22], (L, D, F), D),
        "ffn2_w_down": dense(ks[23], (L, F, D), F),
        "final_norm": gain(ks[24], (D,)),
    }


def reference(x, mem, ffn1_norm, ffn1_w_gate, ffn1_w_up, ffn1_w_down, mix_norm, w_in, gate_bias,
              qk_conv, head_norm, pool_w, pool_scale, w_out, xattn_norm, mem_norm, xattn_wq,
              xattn_wkv, xattn_wo, ffn2_norm, ffn2_w_gate, ffn2_w_up, ffn2_w_down, final_norm):
    h = x
    for l in range(DEPTH):
        h = h + 0.5 * swiglu(rms_norm(h, ffn1_norm[l]), ffn1_w_gate[l], ffn1_w_up[l], ffn1_w_down[l])
        h = h + token_mix(rms_norm(h, mix_norm[l]), w_in[l], gate_bias[l], qk_conv[l], head_norm[l],
                          pool_w[l], pool_scale[l], w_out[l])
        h = h + cross_attention(rms_norm(h, xattn_norm[l]), rms_norm(mem, mem_norm[l]),
                                xattn_wq[l], xattn_wkv[l], xattn_wo[l])
        h = h + 0.5 * swiglu(rms_norm(h, ffn2_norm[l]), ffn2_w_gate[l], ffn2_w_up[l], ffn2_w_down[l])
    return rms_norm(h, final_norm)
```

```cpp
#include <hip/hip_runtime.h>
#include <cstdio>
#include <cstdint>

#ifndef MK_ONE_LAUNCH
#define MK_ONE_LAUNCH 1
#endif

namespace pg8 {
typedef _Float16 f16x4_t __attribute__((ext_vector_type(4)));
#define PG8_LAS __attribute__((address_space(3)))
typedef unsigned short bf16_t;
typedef short bf16x8 __attribute__((ext_vector_type(8)));
typedef float f32x4 __attribute__((ext_vector_type(4)));
typedef unsigned u32x4 __attribute__((ext_vector_type(4)));
constexpr int FFH = 5632;
constexpr int BM = 256, BK = 64, HALF = 128, HTB = HALF * BK * 2  , STAGE_BYTES = 8 * HTB, NXCD = 8, WGM = 8;

__host__ __device__ __forceinline__ int lds_byte(int r, int c) { const int st = (r >> 4) * 2 + (c >> 5), rr = r & 15, cc = c & 31, ob = rr * 64 + cc * 2; return st * 1024 + (ob ^ (((ob >> 9) & 1) << 5)); }
__host__ __device__ __forceinline__ void stage_rc(int b, int& R, int& C) { const int st = b / 1024, sb = b % 1024, swz = sb ^ (((sb >> 9) & 1) << 5); R = (st >> 1) * 16 + swz / 64; C = (st & 1) * 32 + (swz % 64) / 2; }
__host__ __device__ __forceinline__ int perm32(int rho) { const int n = rho >> 4, i = rho & 15; return 8 * (i >> 2) + 4 * n + (i & 3); }

struct Unit { int pm, pn; };
struct Gemm { const bf16_t* A; const bf16_t* Bt; int K; int nMz; int nN; int ablk = 0, bblk = 0; };

struct StaticOrder {
    int nM, nN, nwg, G, c, base, count;
    __host__ __device__ void init(int nM_, int nN_, int G_, int c_) { nM = nM_; nN = nN_; nwg = nM * nN; G = G_; c = c_; base = 0; count = nwg; }
    __host__ __device__ void slice(int base_, int count_, int G_, int c_) { base = base_; count = count_; G = G_; c = c_; }
    __host__ __device__ bool next(int i, Unit& u) const {
        const long Lr = (long)i * G + c; if (Lr >= count) return false; const long L = base + Lr;
        int wgid = (int)L; { const int q = nwg / NXCD, r = nwg % NXCD, xcd = wgid % NXCD, off = wgid / NXCD; wgid = (xcd < r ? xcd * (q + 1) : r * (q + 1) + (xcd - r) * q) + off; }
        const int nig = WGM * nN, gid = wgid / nig, fm = gid * WGM, gsz = (nM - fm) < WGM ? (nM - fm) : WGM;
        u.pm = fm + ((wgid % nig) % gsz); u.pn = (wgid % nig) / gsz; return true;
    }
    __device__ __forceinline__ void a_ready(const Unit&) const {}
    __device__ __forceinline__ void done(const Unit&) const {}
};

struct SyncOrder : StaticOrder {
    unsigned* cnt; unsigned members; int w0;
    __device__ __forceinline__ void done(const Unit&) const {
        if (w0) {
            unsigned ln; asm volatile("v_mbcnt_lo_u32_b32 %0, -1, 0\n\tv_mbcnt_hi_u32_b32 %0, -1, %0" : "=v"(ln));
            unsigned old = 0u; if (ln == 0u) old = __hip_atomic_fetch_add(cnt, 1u, __ATOMIC_RELAXED, __HIP_MEMORY_SCOPE_AGENT);
            old = (unsigned)__builtin_amdgcn_readfirstlane((int)old);
            const unsigned target = (old / members + 1u) * members; unsigned sp = 0u;
            while ((unsigned)__builtin_amdgcn_readfirstlane((int)__hip_atomic_load(cnt, __ATOMIC_RELAXED, __HIP_MEMORY_SCOPE_AGENT)) < target) { __builtin_amdgcn_s_sleep(1); if (++sp > (1u << 16)) break; }
        }
        asm volatile("" ::: "memory"); __builtin_amdgcn_s_barrier(); asm volatile("" ::: "memory");
    }
};

__device__ __forceinline__ unsigned cvt_pk_bf16(float lo, float hi) { unsigned r; asm volatile("v_cvt_pk_bf16_f32 %0, %1, %2" : "=v"(r) : "v"(lo), "v"(hi)); return r; }

__device__ __forceinline__ float silu_f(float x) { return x * __builtin_amdgcn_rcpf(1.0f + __builtin_amdgcn_exp2f(-1.4426950408889634f * x)); }

typedef unsigned long long rss_t;
#define PG8_GAS __attribute__((address_space(1)))
__device__ __forceinline__ float rms_from_ss(rss_t v) { return __builtin_amdgcn_rsqf((float)v * (1.0f / (2048.0f * 1048576.0f)) + 1e-6f); }
__device__ __forceinline__ float rms_scale(const rss_t* rss, int row) { return rms_from_ss(((const PG8_GAS rss_t*)rss)[row]); }
struct EpiSwiGLU {
    static constexpr bool PERM = true, AFTER_DRAIN = false, ROWTAB = true;
    bf16_t* O; int ldc; const rss_t* rss; PG8_LAS float* tab;
    __device__ __forceinline__ void fill_table(int pm, int par, int tid) const { if (tid < 256) tab[par * 256 + tid] = rms_scale(rss, pm * BM + tid); }
    __device__ __forceinline__ void operator()(const f32x4 (&acc)[2][2][4][2], const Unit& u, int wr, int wc, int fr, int fq, int par) const {
        bf16_t* rowp = O + ((size_t)(u.pm * (FFH / 64) + 2 * u.pn + (wc >> 1)) * BM + wr * 64 + fr) * 64 + (wc & 1) * 32 + 8 * fq;
        float sv[2][4];
#pragma unroll
        for (int ai = 0; ai < 2; ++ai)
#pragma unroll
            for (int m = 0; m < 4; ++m) sv[ai][m] = tab[par * 256 + wr * 64 + fr + ai * HALF + m * 16];
#pragma unroll
        for (int ai = 0; ai < 2; ++ai) {
#pragma unroll
            for (int m = 0; m < 4; ++m) { const float rs = sv[ai][m], rsn = rs * -1.4426950408889634f, rs2 = rs * rs;
                f32x4 e0 = acc[ai][0][m][0] * rsn, e1 = acc[ai][0][m][1] * rsn;
#pragma unroll
                for (int j = 0; j < 4; ++j) { e0[j] = __builtin_amdgcn_exp2f(e0[j]); e1[j] = __builtin_amdgcn_exp2f(e1[j]); }
                e0 = e0 + 1.0f; e1 = e1 + 1.0f;
#pragma unroll
                for (int j = 0; j < 4; ++j) { e0[j] = __builtin_amdgcn_rcpf(e0[j]); e1[j] = __builtin_amdgcn_rcpf(e1[j]); }
                const f32x4 v0 = (acc[ai][0][m][0] * acc[ai][1][m][0]) * rs2 * e0, v1 = (acc[ai][0][m][1] * acc[ai][1][m][1]) * rs2 * e1;
                u32x4 w; w.x = cvt_pk_bf16(v0[0], v0[1]); w.y = cvt_pk_bf16(v0[2], v0[3]); w.z = cvt_pk_bf16(v1[0], v1[1]); w.w = cvt_pk_bf16(v1[2], v1[3]);
                *(PG8_GAS u32x4*)rowp = w; rowp += (size_t)16 * ldc; asm volatile("" : "+v"(rowp)); }
            rowp += (size_t)64 * ldc; asm volatile("" : "+v"(rowp)); }
    }
};
typedef __bf16 bf16x2_t __attribute__((ext_vector_type(2)));
__device__ __forceinline__ float dot2_bf16(unsigned w, float acc) { const bf16x2_t v = __builtin_bit_cast(bf16x2_t, w); return __builtin_amdgcn_fdot2_f32_bf16(v, v, acc, false); }
struct EpiResid16 {
    static constexpr bool PERM = true, AFTER_DRAIN = false, ROWTAB = false;
    const bf16_t* base; bf16_t* out; float scale; rss_t* rss_out;
    __device__ __forceinline__ void operator()(const f32x4 (&acc)[2][2][4][2], const Unit& u, int wr, int wc, int fr, int fq) const {
        const int row0 = u.pm * BM + wr * 64 + fr;
        const size_t off0 = ((size_t)(u.pm * 32 + 4 * u.pn + (wc >> 1)) * BM + wr * 64 + fr) * 64 + (wc & 1) * 32 + 8 * fq;
        const int l1 = (((fq ^ 1) << 4) | fr) << 2, l2 = (((fq ^ 2) << 4) | fr) << 2;
        u32x4 bs2[2][4][2];
#pragma unroll
        for (int ai = 0; ai < 2; ++ai)
#pragma unroll
            for (int m = 0; m < 4; ++m)
#pragma unroll
                for (int bj = 0; bj < 2; ++bj) bs2[ai][m][bj] = *(const PG8_GAS u32x4*)(base + off0 + (size_t)(ai * HALF + m * 16) * 64 + (size_t)bj * 2 * BM * 64);
        float ssv[2][4];
#pragma unroll
        for (int ai = 0; ai < 2; ++ai) {
#pragma unroll
            for (int m = 0; m < 4; ++m) {
                float ss = 0.f;
#pragma unroll
                for (int bj = 0; bj < 2; ++bj) { const u32x4 b4 = bs2[ai][m][bj];
                    f32x4 b0, b1; b0[0] = __uint_as_float(b4.x << 16); b0[1] = __uint_as_float(b4.x & 0xffff0000u); b0[2] = __uint_as_float(b4.y << 16); b0[3] = __uint_as_float(b4.y & 0xffff0000u);
                    b1[0] = __uint_as_float(b4.z << 16); b1[1] = __uint_as_float(b4.z & 0xffff0000u); b1[2] = __uint_as_float(b4.w << 16); b1[3] = __uint_as_float(b4.w & 0xffff0000u);
                    const f32x4 r0 = acc[ai][bj][m][0] * scale + b0, r1 = acc[ai][bj][m][1] * scale + b1;
                    u32x4 w; w.x = cvt_pk_bf16(r0[0], r0[1]); w.y = cvt_pk_bf16(r0[2], r0[3]); w.z = cvt_pk_bf16(r1[0], r1[1]); w.w = cvt_pk_bf16(r1[2], r1[3]);
                    *(PG8_GAS u32x4*)(out + off0 + (size_t)(ai * HALF + m * 16) * 64 + (size_t)bj * 2 * BM * 64) = w;
                    ss = dot2_bf16(w.x, ss); ss = dot2_bf16(w.y, ss); ss = dot2_bf16(w.z, ss); ss = dot2_bf16(w.w, ss); }
                ssv[ai][m] = ss;
            }
        }
#pragma unroll
        for (int ai = 0; ai < 2; ++ai)
#pragma unroll
            for (int m = 0; m < 4; ++m) ssv[ai][m] += __int_as_float(__builtin_amdgcn_ds_bpermute(l1, __float_as_int(ssv[ai][m])));
#pragma unroll
        for (int ai = 0; ai < 2; ++ai)
#pragma unroll
            for (int m = 0; m < 4; ++m) ssv[ai][m] += __int_as_float(__builtin_amdgcn_ds_bpermute(l2, __float_as_int(ssv[ai][m])));
        if (fq == 0) {
#pragma unroll
            for (int ai = 0; ai < 2; ++ai)
#pragma unroll
                for (int m = 0; m < 4; ++m) (void)__hip_atomic_fetch_add((PG8_GAS rss_t*)rss_out + row0 + ai * HALF + m * 16, (rss_t)(ssv[ai][m] * 1048576.0f + 0.5f), __ATOMIC_RELAXED, __HIP_MEMORY_SCOPE_AGENT);
        }
    }
};
struct EpiF32Tile {
    static constexpr bool PERM = false, AFTER_DRAIN = false, ROWTAB = false;
    float* C;
    __device__ __forceinline__ void operator()(const f32x4 (&acc)[2][2][4][2], const Unit& u, int wr, int wc, int fr, int fq) const {
        float* base = C + (size_t)(u.pm * BM + wr * 64 + fr) * 256 + wc * 32 + 4 * fq;
#pragma unroll
        for (int ai = 0; ai < 2; ++ai)
#pragma unroll
            for (int m = 0; m < 4; ++m) { float* rowp = base + (size_t)(ai * HALF + m * 16) * 256;
#pragma unroll
                for (int bj = 0; bj < 2; ++bj)
#pragma unroll
                    for (int n = 0; n < 2; ++n) *(f32x4*)(rowp + bj * HALF + n * 16) = acc[ai][bj][m][n]; }
    }
};
template <int KIND> struct EpiBf16K {
    static constexpr bool PERM = true, AFTER_DRAIN = false, ROWTAB = (KIND == 0);
    bf16_t* O; const float* cs; float scale; int mrows; const rss_t* rss; float* gat; const float* gbias; PG8_LAS float* tab;
    __device__ __forceinline__ void fill_table(int pm, int par, int tid) const { if (tid < 256) tab[par * 256 + tid] = rms_scale(rss, pm * BM + tid); }
    __device__ __forceinline__ void operator()(const f32x4 (&acc)[2][2][4][2], const Unit& u, int wr, int wc, int fr, int fq, int par = 0) const {
        bf16_t* base; int ldc; const float* csp = nullptr;
        if (KIND == 0) { ldc = 5376; base = O + (size_t)u.pm * BM * ldc + u.pn * BM; }
        else if (KIND == 1) { ldc = 512; const int h = u.pn >> 1; base = O + ((size_t)h * mrows + (size_t)u.pm * BM) * 512 + (u.pn & 1) * BM; }
        else if (KIND == 2) { ldc = 256; const int h = u.pm >> 1; base = O + ((size_t)(h * 16 + u.pn) * 512 + (size_t)(u.pm & 1) * BM) * 256; }
        else if (KIND == 3) { ldc = 2048; const int g = u.pm >> 7, pl = u.pm & 127; base = O + (size_t)pl * BM * 2048 + g * BM; csp = cs + g * BM; }
        else if (KIND == 4) { ldc = 2048; const int z = u.pm >> 3, pl = u.pm & 7, h = z >> 4, b = z & 15; base = O + ((size_t)b * 2048 + (size_t)pl * BM) * 2048 + h * 512 + u.pn * BM; }
        else if (KIND == 5) { ldc = 2048; const int h = u.pm >> 4, b = u.pm & 15; base = O + (size_t)(b * 4 + h) * BM * 2048 + u.pn * BM; }
        else { ldc = 1024; const int h = u.pm >> 3, np = u.pm & 7; base = O + ((size_t)u.pn * 2048 + (size_t)np * BM) * 1024 + h * BM; }
        const int row0 = wr * 64 + fr, col0 = wc * 32 + 8 * fq;
        float rsv[2][4];
#pragma unroll
        for (int ai = 0; ai < 2; ++ai)
#pragma unroll
            for (int m = 0; m < 4; ++m) rsv[ai][m] = (KIND == 0) ? scale * tab[par * 256 + row0 + ai * HALF + m * 16] : ((KIND == 1 && rss) ? scale * rms_scale(rss, u.pm * BM + row0 + ai * HALF + m * 16) : scale);
        if (KIND == 0 && u.pn == 20) {
            if (wc == 0 && fq == 0) { const f32x4 bi = *(const f32x4*)gbias, bf = *(const f32x4*)(gbias + 4);
#pragma unroll
                for (int ai = 0; ai < 2; ++ai)
#pragma unroll
                    for (int m = 0; m < 4; ++m) { const f32x4 li = acc[ai][0][m][0] * rsv[ai][m] + bi, xf = acc[ai][0][m][1] * rsv[ai][m] + bf; f32x4 lf;
#pragma unroll
                        for (int j = 0; j < 4; ++j) lf[j] = fminf(xf[j], 0.f) - log1pf(expf(-fabsf(xf[j])));
                        float* gp = gat + (size_t)(u.pm * BM + row0 + ai * HALF + m * 16) * 8; *(f32x4*)gp = li; *(f32x4*)(gp + 4) = lf; } }
            return; }
        bf16_t* rowp = base + (size_t)row0 * ldc + col0; size_t rstep = (size_t)ldc, bjstep = HALF;
        if (KIND == 3) {
            const int g = u.pm >> 7, pl = u.pm & 127; rowp = O + ((size_t)(pl * 32 + 4 * g + (wc >> 1)) * BM + row0) * 64 + (wc & 1) * 32 + 8 * fq; rstep = 64; bjstep = (size_t)2 * BM * 64; }
#pragma unroll
        for (int bj = 0; bj < 2; ++bj) {
            f32x4 s0 = (f32x4){1.f, 1.f, 1.f, 1.f}, s1 = s0;
            if (KIND == 3) { s0 = *(const f32x4*)(csp + col0 + bj * HALF); s1 = *(const f32x4*)(csp + col0 + bj * HALF + 4); }
            bf16_t* rp = rowp + bj * bjstep;
#pragma unroll
            for (int ai = 0; ai < 2; ++ai) {
#pragma unroll
                for (int m = 0; m < 4; ++m) { const f32x4 v0 = acc[ai][bj][m][0] * s0 * rsv[ai][m], v1 = acc[ai][bj][m][1] * s1 * rsv[ai][m];
                    u32x4 w; w.x = cvt_pk_bf16(v0[0], v0[1]); w.y = cvt_pk_bf16(v0[2], v0[3]); w.z = cvt_pk_bf16(v1[0], v1[1]); w.w = cvt_pk_bf16(v1[2], v1[3]);
                    *(PG8_GAS u32x4*)rp = w; rp += 16 * rstep; asm volatile("" : "+v"(rp)); }
                rp += 64 * rstep; asm volatile("" : "+v"(rp)); }
        }
    }
};

struct EpiSoftmaxP {
    static constexpr bool PERM = true, AFTER_DRAIN = false, ROWTAB = false;
    bf16_t* P; const rss_t* rss; PG8_LAS float* scr;
    __device__ __forceinline__ void operator()(f32x4 (&acc)[2][2][4][2], const Unit& u, int wr, int wc, int fr, int fq) const {
        const int l1 = (((fq ^ 1) << 4) | fr) << 2, l2 = (((fq ^ 2) << 4) | fr) << 2, rowb = wr * 64 + fr;
        unsigned wo_ = (unsigned)(rowb * 4 + wc) * 4u, ro_ = (unsigned)(rowb * 4) * 4u; asm volatile("" : "+v"(wo_), "+v"(ro_));
        PG8_LAS float* wb = (PG8_LAS float*)((PG8_LAS unsigned char*)scr + wo_);
        const PG8_LAS float* rb = (const PG8_LAS float*)((const PG8_LAS unsigned char*)scr + ro_);
#pragma unroll
        for (int ai = 0; ai < 2; ++ai)
#pragma unroll
            for (int m = 0; m < 4; ++m) { const int row = rowb + ai * HALF + m * 16; const float rs = rms_scale(rss, u.pm * BM + row); float mx = -3.0e38f;
#pragma unroll
                for (int bj = 0; bj < 2; ++bj)
#pragma unroll
                    for (int n = 0; n < 2; ++n) { const f32x4 v = acc[ai][bj][m][n] * rs; acc[ai][bj][m][n] = v; mx = fmaxf(mx, fmaxf(fmaxf(v[0], v[1]), fmaxf(v[2], v[3]))); }
                mx = fmaxf(mx, __int_as_float(__builtin_amdgcn_ds_bpermute(l1, __float_as_int(mx)))); mx = fmaxf(mx, __int_as_float(__builtin_amdgcn_ds_bpermute(l2, __float_as_int(mx))));
                if (fq == 0) wb[(ai * HALF + m * 16) * 4] = mx; }
        asm volatile("s_waitcnt lgkmcnt(0)" ::: "memory"); __builtin_amdgcn_s_barrier(); asm volatile("" ::: "memory");
#pragma unroll
        for (int ai = 0; ai < 2; ++ai)
#pragma unroll
            for (int m = 0; m < 4; ++m) { const f32x4 mv = *(const PG8_LAS f32x4*)(rb + (ai * HALF + m * 16) * 4);
                const float rmax = fmaxf(fmaxf(mv[0], mv[1]), fmaxf(mv[2], mv[3])) * 1.4426950408889634f; float sm = 0.f;
#pragma unroll
                for (int bj = 0; bj < 2; ++bj)
#pragma unroll
                    for (int n = 0; n < 2; ++n) { f32x4 e;
#pragma unroll
                        for (int j = 0; j < 4; ++j) e[j] = __builtin_amdgcn_exp2f(acc[ai][bj][m][n][j] * 1.4426950408889634f - rmax);
                        acc[ai][bj][m][n] = e; sm += (e[0] + e[1]) + (e[2] + e[3]); }
                sm += __int_as_float(__builtin_amdgcn_ds_bpermute(l1, __float_as_int(sm))); sm += __int_as_float(__builtin_amdgcn_ds_bpermute(l2, __float_as_int(sm)));
                if (fq == 0) wb[1024 + (ai * HALF + m * 16) * 4] = sm; }
        asm volatile("s_waitcnt lgkmcnt(0)" ::: "memory"); __builtin_amdgcn_s_barrier(); asm volatile("" ::: "memory");
        bf16_t* rp = P + ((size_t)(u.pm * 16 + 4 * u.pn + (wc >> 1)) * BM + rowb) * 64 + (wc & 1) * 32 + 8 * fq;
#pragma unroll
        for (int ai = 0; ai < 2; ++ai) {
#pragma unroll
            for (int m = 0; m < 4; ++m) { const f32x4 sv = *(const PG8_LAS f32x4*)(rb + 1024 + (ai * HALF + m * 16) * 4); const float inv = 1.0f / ((sv[0] + sv[1]) + (sv[2] + sv[3]));
#pragma unroll
                for (int bj = 0; bj < 2; ++bj) { const f32x4 v0 = acc[ai][bj][m][0] * inv, v1 = acc[ai][bj][m][1] * inv;
                    u32x4 w; w.x = cvt_pk_bf16(v0[0], v0[1]); w.y = cvt_pk_bf16(v0[2], v0[3]); w.z = cvt_pk_bf16(v1[0], v1[1]); w.w = cvt_pk_bf16(v1[2], v1[3]);
                    *(PG8_GAS u32x4*)(rp + (size_t)bj * 2 * BM * 64) = w; }
                rp += (size_t)16 * 64; asm volatile("" : "+v"(rp)); }
            rp += (size_t)64 * 64; asm volatile("" : "+v"(rp)); }
    }
};

template <class Epi, class Sched, bool ALIGN_EPI = false, bool SP2 = false, bool PEEL = false>
__device__ __forceinline__ void gemm_phase(PG8_LAS unsigned char* lds, const Gemm g, const Sched& S, const Epi& E, int tid_in) {
    int tid_ = tid_in; asm volatile("" : "+v"(tid_));
    const int tid = tid_, wid = __builtin_amdgcn_readfirstlane(tid >> 6), lane = tid & 63, wr = wid >> 2, wc = wid & 3, fr = lane & 15, fq = lane >> 4;
    int K_ = g.K; asm volatile("" : "+s"(K_));
    const int K = K_, nt = K / BK;
    unsigned voffA[2], voffB[2];
#pragma unroll
    for (int i = 0; i < 2; ++i) { int R, C; stage_rc(tid * 16 + i * 8192, R, C); const int Rb = Epi::PERM ? ((R & ~31) + perm32(R & 31)) : R;
        voffA[i] = (unsigned)(R * (g.ablk ? BK : K) + C) * 2u; voffB[i] = (unsigned)(Rb * (g.bblk ? BK : K) + C) * 2u; }
    const size_t kstep = (size_t)(BK * 2);
    const size_t hstep = (size_t)HALF * K * 2;
    const size_t tstep = 2 * hstep;
    const size_t kstepB = g.bblk ? (size_t)(BM * BK * 2) : kstep, hstepB = g.bblk ? (size_t)(HALF * BK * 2) : hstep;
    const size_t kstepA = g.ablk ? (size_t)(BM * BK * 2) : kstep, hstepA = g.ablk ? (size_t)(HALF * BK * 2) : hstep;
    const unsigned ldsw = (unsigned)wid * 1024u;
    const int aoff = lds_byte(wr * 64 + fr, fq * 8), boff = lds_byte(wc * 32 + fr, fq * 8);
#define PG8_SA(b, h) (((b) * 2 + (h)) * HTB)
#define PG8_SB(b, h) ((4 + (b) * 2 + (h)) * HTB)
#define PG8_STAGE(bufoff, gbase, voff) do { _Pragma("unroll") for (int _i = 0; _i < 2; ++_i) { asm volatile("" : "+v"((voff)[_i])); \
        __builtin_amdgcn_global_load_lds((const unsigned*)((const char*)(gbase) + (voff)[_i]), (PG8_LAS unsigned*)(lds + (bufoff) + ldsw + _i * 8192), 16, 0, 0); } } while (0)
#define PG8_LDA(dst, b, h) do { _Pragma("unroll") for (int m = 0; m < 4; ++m) _Pragma("unroll") for (int k = 0; k < 2; ++k) dst[m][k] = *(const PG8_LAS bf16x8*)(lds + PG8_SA(b, h) + aoff + m * 2048 + k * 1024); } while (0)
#define PG8_LDB(dst, b, h) do { _Pragma("unroll") for (int n = 0; n < 2; ++n) _Pragma("unroll") for (int k = 0; k < 2; ++k) dst[n][k] = *(const PG8_LAS bf16x8*)(lds + PG8_SB(b, h) + boff + n * 2048 + k * 1024); } while (0)
#define PG8_MMA(ai, bj, At, Bt) do { __builtin_amdgcn_s_setprio(3); _Pragma("unroll") for (int m = 0; m < 4; ++m) _Pragma("unroll") for (int n = 0; n < 2; ++n) _Pragma("unroll") for (int k = 0; k < 2; ++k) \
        acc[ai][bj][m][n] = __builtin_amdgcn_mfma_f32_16x16x32_bf16(Bt[n][k], At[m][k], acc[ai][bj][m][n], 0, 0, 0); __builtin_amdgcn_s_setprio(0); } while (0)
#define PG8_MMAZ(ZC, ai, bj, At, Bt) do { __builtin_amdgcn_s_setprio(3); _Pragma("unroll") for (int m = 0; m < 4; ++m) _Pragma("unroll") for (int n = 0; n < 2; ++n) _Pragma("unroll") for (int k = 0; k < 2; ++k) \
        acc[ai][bj][m][n] = __builtin_amdgcn_mfma_f32_16x16x32_bf16(Bt[n][k], At[m][k], ((ZC) && k == 0) ? (f32x4){0.f, 0.f, 0.f, 0.f} : acc[ai][bj][m][n], 0, 0, 0); __builtin_amdgcn_s_setprio(0); } while (0)
#define PG8_WAIT_V(n) asm volatile("s_waitcnt vmcnt(" #n ")" ::: "memory")
#define PG8_WAIT_L(n) asm volatile("s_waitcnt lgkmcnt(" #n ")" ::: "memory")
#define PG8_BAR __builtin_amdgcn_s_barrier()
#define PG8_SCHED __builtin_amdgcn_sched_barrier(0)
#define PG8_BIDX(u) ((size_t)((g.nMz ? ((u).pm / g.nMz) * g.nN : 0) + (u).pn))
#define PG8_KITER(ZC) do { \
            const bool last = (t == nt - 2); \
            const char* a1 = cA + (size_t)(t + 1) * kstepA; \
            const char* a2 = last ? nA : cA + (size_t)(t + 2) * kstepA; const char* b2 = last ? nB : cB + (size_t)(t + 2) * kstepB; \
            const char* a3 = a2 + kstepA; const char* b3 = b2 + kstepB; \
            if (last && has_next) S.a_ready(nxt); \
            if constexpr (Epi::ROWTAB) { if (last && has_next && nxt.pm != cur.pm) E.fill_table(nxt.pm, rtpar ^ 1, tid); } \
            PG8_LDB(B0, 0, 0); PG8_LDB(B1, 0, 1); PG8_SCHED; PG8_LDA(At, 0, 0); PG8_STAGE(PG8_SA(1, 1), a1 + hstepA, voffA); \
            PG8_WAIT_V(8); PG8_WAIT_L(0); PG8_BAR; PG8_MMAZ(ZC, 0, 0, At, B0); PG8_MMAZ(ZC, 0, 1, At, B1); PG8_BAR; PG8_SCHED; \
            PG8_LDA(At, 0, 1); PG8_STAGE(PG8_SB(0, 0), b2, voffB); PG8_STAGE(PG8_SB(0, 1), b2 + hstepB, voffB); PG8_STAGE(PG8_SA(0, 0), a2, voffA); \
            PG8_WAIT_V(8); PG8_WAIT_L(0); PG8_BAR; PG8_MMAZ(ZC, 1, 0, At, B0); PG8_MMAZ(ZC, 1, 1, At, B1); PG8_BAR; PG8_SCHED; \
            PG8_LDB(B0, 1, 0); PG8_LDB(B1, 1, 1); PG8_SCHED; PG8_LDA(At, 1, 0); PG8_STAGE(PG8_SA(0, 1), a2 + hstepA, voffA); \
            PG8_WAIT_V(8); PG8_WAIT_L(0); PG8_BAR; PG8_MMA(0, 0, At, B0); PG8_MMA(0, 1, At, B1); PG8_BAR; PG8_SCHED; \
            PG8_LDA(At, 1, 1); PG8_STAGE(PG8_SB(1, 0), b3, voffB); PG8_STAGE(PG8_SB(1, 1), b3 + hstepB, voffB); PG8_STAGE(PG8_SA(1, 0), a3, voffA); \
            PG8_WAIT_V(8); PG8_WAIT_L(0); PG8_BAR; PG8_MMA(1, 0, At, B0); PG8_MMA(1, 1, At, B1); PG8_BAR; PG8_SCHED; \
        } while (0)
    Unit cur, nxt; int ui = 0;
    if (!S.next(0, cur)) return;
#define PG8_ZERO_ACC() do { f16x4_t z_ = (f16x4_t){(_Float16)0, (_Float16)0, (_Float16)0, (_Float16)0}; asm volatile("" : "+v"(z_)); \
          \
        acc[0][0][0][0] = __builtin_amdgcn_mfma_f32_4x4x4f16(z_, z_, (f32x4){0.f, 0.f, 0.f, 0.f}, 4, 0, 0); acc[0][0][0][1] = __builtin_amdgcn_mfma_f32_4x4x4f16(z_, z_, (f32x4){0.f, 0.f, 0.f, 0.f}, 4, 1, 0); \
        acc[0][0][1][0] = __builtin_amdgcn_mfma_f32_4x4x4f16(z_, z_, (f32x4){0.f, 0.f, 0.f, 0.f}, 4, 2, 0); acc[0][0][1][1] = __builtin_amdgcn_mfma_f32_4x4x4f16(z_, z_, (f32x4){0.f, 0.f, 0.f, 0.f}, 4, 3, 0); \
        acc[0][0][2][0] = __builtin_amdgcn_mfma_f32_4x4x4f16(z_, z_, (f32x4){0.f, 0.f, 0.f, 0.f}, 4, 4, 0); acc[0][0][2][1] = __builtin_amdgcn_mfma_f32_4x4x4f16(z_, z_, (f32x4){0.f, 0.f, 0.f, 0.f}, 4, 5, 0); \
        acc[0][0][3][0] = __builtin_amdgcn_mfma_f32_4x4x4f16(z_, z_, (f32x4){0.f, 0.f, 0.f, 0.f}, 4, 6, 0); acc[0][0][3][1] = __builtin_amdgcn_mfma_f32_4x4x4f16(z_, z_, (f32x4){0.f, 0.f, 0.f, 0.f}, 4, 7, 0); \
        acc[0][1][0][0] = __builtin_amdgcn_mfma_f32_4x4x4f16(z_, z_, (f32x4){0.f, 0.f, 0.f, 0.f}, 4, 8, 0); acc[0][1][0][1] = __builtin_amdgcn_mfma_f32_4x4x4f16(z_, z_, (f32x4){0.f, 0.f, 0.f, 0.f}, 4, 9, 0); \
        acc[0][1][1][0] = __builtin_amdgcn_mfma_f32_4x4x4f16(z_, z_, (f32x4){0.f, 0.f, 0.f, 0.f}, 4, 10, 0); acc[0][1][1][1] = __builtin_amdgcn_mfma_f32_4x4x4f16(z_, z_, (f32x4){0.f, 0.f, 0.f, 0.f}, 4, 11, 0); \
        acc[0][1][2][0] = __builtin_amdgcn_mfma_f32_4x4x4f16(z_, z_, (f32x4){0.f, 0.f, 0.f, 0.f}, 4, 12, 0); acc[0][1][2][1] = __builtin_amdgcn_mfma_f32_4x4x4f16(z_, z_, (f32x4){0.f, 0.f, 0.f, 0.f}, 4, 13, 0); \
        acc[0][1][3][0] = __builtin_amdgcn_mfma_f32_4x4x4f16(z_, z_, (f32x4){0.f, 0.f, 0.f, 0.f}, 4, 14, 0); acc[0][1][3][1] = __builtin_amdgcn_mfma_f32_4x4x4f16(z_, z_, (f32x4){0.f, 0.f, 0.f, 0.f}, 4, 15, 0); \
        acc[1][0][0][0] = __builtin_amdgcn_mfma_f32_4x4x4f16(z_, z_, (f32x4){0.f, 0.f, 0.f, 0.f}, 4, 0, 1); acc[1][0][0][1] = __builtin_amdgcn_mfma_f32_4x4x4f16(z_, z_, (f32x4){0.f, 0.f, 0.f, 0.f}, 4, 1, 1); \
        acc[1][0][1][0] = __builtin_amdgcn_mfma_f32_4x4x4f16(z_, z_, (f32x4){0.f, 0.f, 0.f, 0.f}, 4, 2, 1); acc[1][0][1][1] = __builtin_amdgcn_mfma_f32_4x4x4f16(z_, z_, (f32x4){0.f, 0.f, 0.f, 0.f}, 4, 3, 1); \
        acc[1][0][2][0] = __builtin_amdgcn_mfma_f32_4x4x4f16(z_, z_, (f32x4){0.f, 0.f, 0.f, 0.f}, 4, 4, 1); acc[1][0][2][1] = __builtin_amdgcn_mfma_f32_4x4x4f16(z_, z_, (f32x4){0.f, 0.f, 0.f, 0.f}, 4, 5, 1); \
        acc[1][0][3][0] = __builtin_amdgcn_mfma_f32_4x4x4f16(z_, z_, (f32x4){0.f, 0.f, 0.f, 0.f}, 4, 6, 1); acc[1][0][3][1] = __builtin_amdgcn_mfma_f32_4x4x4f16(z_, z_, (f32x4){0.f, 0.f, 0.f, 0.f}, 4, 7, 1); \
        acc[1][1][0][0] = __builtin_amdgcn_mfma_f32_4x4x4f16(z_, z_, (f32x4){0.f, 0.f, 0.f, 0.f}, 4, 8, 1); acc[1][1][0][1] = __builtin_amdgcn_mfma_f32_4x4x4f16(z_, z_, (f32x4){0.f, 0.f, 0.f, 0.f}, 4, 9, 1); \
        acc[1][1][1][0] = __builtin_amdgcn_mfma_f32_4x4x4f16(z_, z_, (f32x4){0.f, 0.f, 0.f, 0.f}, 4, 10, 1); acc[1][1][1][1] = __builtin_amdgcn_mfma_f32_4x4x4f16(z_, z_, (f32x4){0.f, 0.f, 0.f, 0.f}, 4, 11, 1); \
        acc[1][1][2][0] = __builtin_amdgcn_mfma_f32_4x4x4f16(z_, z_, (f32x4){0.f, 0.f, 0.f, 0.f}, 4, 12, 1); acc[1][1][2][1] = __builtin_amdgcn_mfma_f32_4x4x4f16(z_, z_, (f32x4){0.f, 0.f, 0.f, 0.f}, 4, 13, 1); \
        acc[1][1][3][0] = __builtin_amdgcn_mfma_f32_4x4x4f16(z_, z_, (f32x4){0.f, 0.f, 0.f, 0.f}, 4, 14, 1); acc[1][1][3][1] = __builtin_amdgcn_mfma_f32_4x4x4f16(z_, z_, (f32x4){0.f, 0.f, 0.f, 0.f}, 4, 15, 1); } while (0)
    f32x4 acc[2][2][4][2];
    if constexpr (!(PEEL && SP2)) PG8_ZERO_ACC();
    bf16x8 At[4][2], B0[2][2], B1[2][2];
    const char* cA = (const char*)g.A + (size_t)cur.pm * tstep; const char* cB = (const char*)g.Bt + PG8_BIDX(cur) * tstep;
    S.a_ready(cur);
    int rtpar = 0;
    if constexpr (Epi::ROWTAB) E.fill_table(cur.pm, 0, tid);
    if constexpr (SP2) {
        PG8_STAGE(PG8_SB(0, 0), cB, voffB); PG8_STAGE(PG8_SB(0, 1), cB + hstepB, voffB); PG8_STAGE(PG8_SA(0, 0), cA, voffA); PG8_STAGE(PG8_SA(0, 1), cA + hstepA, voffA);
        if (wr == 1) PG8_BAR;
        PG8_WAIT_V(2); PG8_BAR;
        PG8_STAGE(PG8_SB(1, 0), cB + kstepB, voffB); PG8_STAGE(PG8_SA(1, 0), cA + kstepA, voffA); PG8_STAGE(PG8_SB(1, 1), cB + hstepB + kstepB, voffB);
        PG8_WAIT_V(6); PG8_BAR;
    } else {
        PG8_STAGE(PG8_SB(0, 0), cB, voffB); PG8_STAGE(PG8_SA(0, 0), cA, voffA); PG8_STAGE(PG8_SB(0, 1), cB + hstepB, voffB); PG8_STAGE(PG8_SA(0, 1), cA + hstepA, voffA);
        if (wr == 1) PG8_BAR;
        PG8_WAIT_V(4); PG8_BAR;
        PG8_STAGE(PG8_SB(1, 0), cB + kstepB, voffB); PG8_STAGE(PG8_SA(1, 0), cA + kstepA, voffA); PG8_STAGE(PG8_SB(1, 1), cB + hstepB + kstepB, voffB);
        PG8_WAIT_V(6); PG8_BAR;
    }
    for (;;) {
        const bool has_next = S.next(ui + 1, nxt);
        const char* nA = has_next ? (const char*)g.A + (size_t)nxt.pm * tstep : cA; const char* nB = has_next ? (const char*)g.Bt + PG8_BIDX(nxt) * tstep : cB;
        if constexpr (PEEL && SP2) { int t = 0; PG8_KITER(true); for (t = 2; t < nt; t += 2) PG8_KITER(false); } else
        for (int t = 0; t < nt; t += 2) {
            const bool last = (t == nt - 2);
            const char* a1 = cA + (size_t)(t + 1) * kstepA;
            const char* a2 = last ? nA : cA + (size_t)(t + 2) * kstepA; const char* b2 = last ? nB : cB + (size_t)(t + 2) * kstepB;
            const char* a3 = a2 + kstepA; const char* b3 = b2 + kstepB;
            if (last && has_next) S.a_ready(nxt);
            if constexpr (Epi::ROWTAB) { if (last && has_next && nxt.pm != cur.pm) E.fill_table(nxt.pm, rtpar ^ 1, tid); }
            if constexpr (SP2) {
            PG8_LDB(B0, 0, 0); PG8_LDB(B1, 0, 1); PG8_SCHED; PG8_LDA(At, 0, 0); PG8_STAGE(PG8_SA(1, 1), a1 + hstepA, voffA);
            PG8_WAIT_V(8); PG8_WAIT_L(0); PG8_BAR; PG8_MMA(0, 0, At, B0); PG8_MMA(0, 1, At, B1); PG8_BAR; PG8_SCHED;
            PG8_LDA(At, 0, 1); PG8_STAGE(PG8_SB(0, 0), b2, voffB); PG8_STAGE(PG8_SB(0, 1), b2 + hstepB, voffB); PG8_STAGE(PG8_SA(0, 0), a2, voffA);
            PG8_WAIT_V(8); PG8_WAIT_L(0); PG8_BAR; PG8_MMA(1, 0, At, B0); PG8_MMA(1, 1, At, B1); PG8_BAR; PG8_SCHED;
            PG8_LDB(B0, 1, 0); PG8_LDB(B1, 1, 1); PG8_SCHED; PG8_LDA(At, 1, 0); PG8_STAGE(PG8_SA(0, 1), a2 + hstepA, voffA);
            PG8_WAIT_V(8); PG8_WAIT_L(0); PG8_BAR; PG8_MMA(0, 0, At, B0); PG8_MMA(0, 1, At, B1); PG8_BAR; PG8_SCHED;
            PG8_LDA(At, 1, 1); PG8_STAGE(PG8_SB(1, 0), b3, voffB); PG8_STAGE(PG8_SB(1, 1), b3 + hstepB, voffB); PG8_STAGE(PG8_SA(1, 0), a3, voffA);
            PG8_WAIT_V(8); PG8_WAIT_L(0); PG8_BAR; PG8_MMA(1, 0, At, B0); PG8_MMA(1, 1, At, B1); PG8_BAR; PG8_SCHED;
            } else {
            PG8_LDB(B0, 0, 0); PG8_SCHED; PG8_LDA(At, 0, 0); PG8_STAGE(PG8_SA(1, 1), a1 + hstepA, voffA);
            PG8_WAIT_L(8); PG8_BAR; PG8_WAIT_L(0); PG8_MMA(0, 0, At, B0); PG8_BAR; PG8_SCHED;
            PG8_LDB(B1, 0, 1); PG8_STAGE(PG8_SB(0, 0), b2, voffB);
            PG8_BAR; PG8_WAIT_L(0); PG8_MMA(0, 1, At, B1); PG8_BAR;
            PG8_LDA(At, 0, 1); PG8_STAGE(PG8_SA(0, 0), a2, voffA);
            PG8_BAR; PG8_WAIT_L(0); PG8_MMA(1, 0, At, B0); PG8_BAR; PG8_SCHED;
            PG8_STAGE(PG8_SB(0, 1), b2 + hstepB, voffB);
            PG8_WAIT_V(6); PG8_BAR; PG8_MMA(1, 1, At, B1); PG8_BAR;
            PG8_LDB(B0, 1, 0); PG8_SCHED; PG8_LDA(At, 1, 0); PG8_STAGE(PG8_SA(0, 1), a2 + hstepA, voffA);
            PG8_WAIT_L(8); PG8_BAR; PG8_WAIT_L(0); PG8_MMA(0, 0, At, B0); PG8_BAR; PG8_SCHED;
            PG8_LDB(B1, 1, 1); PG8_STAGE(PG8_SB(1, 0), b3, voffB);
            PG8_BAR; PG8_WAIT_L(0); PG8_MMA(0, 1, At, B1); PG8_BAR;
            PG8_LDA(At, 1, 1); PG8_STAGE(PG8_SA(1, 0), a3, voffA);
            PG8_BAR; PG8_WAIT_L(0); PG8_MMA(1, 0, At, B0); PG8_BAR; PG8_SCHED;
            PG8_STAGE(PG8_SB(1, 1), b3 + hstepB, voffB);
            PG8_WAIT_V(6); PG8_BAR; PG8_MMA(1, 1, At, B1); PG8_BAR;
            }
        }
        if constexpr (ALIGN_EPI) { if (wr == 0) PG8_BAR; }
        { int le_; asm volatile("v_mbcnt_lo_u32_b32 %0, -1, 0\n\tv_mbcnt_hi_u32_b32 %0, -1, %0" : "=v"(le_)); const int fre = le_ & 15, fqe = le_ >> 4;
          if constexpr (Epi::ROWTAB) E(acc, cur, wr, wc, fre, fqe, rtpar); else E(acc, cur, wr, wc, fre, fqe); }
        S.done(cur);
        if (!has_next) break;
        if constexpr (!(PEEL && SP2)) PG8_ZERO_ACC();
        if constexpr (Epi::ROWTAB) { if (nxt.pm != cur.pm) rtpar ^= 1; }
        cur = nxt; cA = nA; cB = nB; ++ui;
        if constexpr (ALIGN_EPI) { if (wr == 1) PG8_BAR; }
    }
    PG8_WAIT_V(0);
    if constexpr (!ALIGN_EPI) { if (wr == 0) PG8_BAR; }
    PG8_BAR;
#undef PG8_SA
#undef PG8_SB
#undef PG8_STAGE
#undef PG8_LDA
#undef PG8_LDB
#undef PG8_MMA
#undef PG8_WAIT_V
#undef PG8_WAIT_L
#undef PG8_BAR
#undef PG8_SCHED
#undef PG8_BIDX
#undef PG8_KITER
#undef PG8_MMAZ
#undef PG8_ZERO_ACC
}
}

#ifndef PG8_SP2
#define PG8_SP2 true
#endif
#ifndef PG8_ALIGN
#define PG8_ALIGN true
#endif

constexpr int NWAVES = 8;
constexpr int NB = 16, SEQ = 2048, D = 2048, M = NB * SEQ, DEPTH = 4, FF = 5632, NMEM = 256, MMEM = NB * NMEM;
constexpr int DIN = 5128, DINM = 5120, ZP = 5376;
constexpr float EPS = 1e-6f;
constexpr int N_PH = 12;
constexpr int N_RSS = 18;

constexpr size_t MiB = 1u << 20;
constexpr size_t WS_CTL = 0, WS_RSS = 1 * MiB, CTL_ZERO_BYTES = 8 * MiB;
static_assert(WS_RSS + (size_t)N_RSS * M * 8 <= CTL_ZERO_BYTES, "rss inside the memset region");
constexpr size_t WS_H    = 8 * MiB;
constexpr size_t WS_U    = WS_H + 256 * MiB;
constexpr size_t WS_BIG  = WS_U + 128 * MiB;
constexpr size_t WS_X1   = WS_BIG + 352 * MiB;
constexpr size_t WS_X2   = WS_X1 + 128 * MiB;
constexpr size_t WS_HM   = WS_X2 + 64 * MiB;
constexpr size_t WS_GAT  = WS_HM + 64 * MiB;
constexpr size_t WS_KB   = WS_GAT + 1 * MiB;
constexpr size_t WS_VT   = WS_KB + 16 * MiB;
constexpr size_t WS_MEMN = WS_VT + 16 * MiB;
constexpr size_t WS_WGU1 = WS_MEMN + 16 * MiB;
constexpr size_t WS_WD1  = WS_WGU1 + 44 * MiB;
constexpr size_t WS_WGU2 = WS_WD1 + 22 * MiB;
constexpr size_t WS_WD2  = WS_WGU2 + 44 * MiB;
constexpr size_t WS_WIN  = WS_WD2 + 22 * MiB;
constexpr size_t WS_WPOOL= WS_WIN + 21 * MiB;
constexpr size_t WS_WOUT = WS_WPOOL + 1 * MiB;
constexpr size_t WS_WQ   = WS_WOUT + 8 * MiB;
constexpr size_t WS_WKV  = WS_WQ + 8 * MiB;
constexpr size_t WS_WO   = WS_WKV + 16 * MiB;
constexpr size_t WS_END  = WS_WO + 8 * MiB;
constexpr size_t WS_GT = WS_H + 128 * MiB, WS_VWT = WS_H + 192 * MiB;
constexpr int CW_TMO = 0, CW_BAR = 4096, CW_SYNC = 16384;

constexpr int RING_OFF = 0, RING_BYTES = 131072;
constexpr int LDSCTL_OFF = RING_BYTES, MISC_OFF = 147456 - 128;
constexpr int LDS_BYTES = 147456;

#define GAS __attribute__((address_space(1)))
#define LAS __attribute__((address_space(3)))
typedef unsigned short bf16;
typedef unsigned v4u __attribute__((ext_vector_type(4)));
typedef unsigned v2u __attribute__((ext_vector_type(2)));
typedef unsigned u32x4v __attribute__((ext_vector_type(4)));
typedef float f32x4 __attribute__((ext_vector_type(4)));
typedef GAS unsigned gu32;
#define RLX_AGENT __ATOMIC_RELAXED, __HIP_MEMORY_SCOPE_AGENT
#define LDS_WAIT() asm volatile("s_waitcnt lgkmcnt(0)" ::: "memory")
__device__ __forceinline__ unsigned pk2(float lo, float hi) { return pg8::cvt_pk_bf16(lo, hi); }
__device__ __forceinline__ float bflo(unsigned w) { return __uint_as_float(w << 16); }
__device__ __forceinline__ float bfhi(unsigned w) { return __uint_as_float(w & 0xffff0000u); }
__device__ __forceinline__ size_t h16_off(int m, int c) { return ((size_t)((m >> 8) * 32 + (c >> 6)) * 256 + (m & 255)) * 64 + (c & 63); }

#define XB_TMO      128
#define XB_XCNT(j)  (256  + 64 * (j))
#define XB_XSUB(j)  (1280 + 64 * (j))
#define XB_XGEN(j)  (2304 + 64 * (j))
#define XB_TOP      3328
#define XB_TOPGEN   3392
#define XCD_BAR_WORDS 3456
#define XB_SPIN_CAP (1u << 18)

__device__ __forceinline__ unsigned xb_ld(unsigned* p)              { return __hip_atomic_load(p, __ATOMIC_RELAXED, __HIP_MEMORY_SCOPE_AGENT); }
__device__ __forceinline__ unsigned xb_add(unsigned* p, unsigned v) { return __hip_atomic_fetch_add(p, v, __ATOMIC_RELAXED, __HIP_MEMORY_SCOPE_AGENT); }
__device__ __forceinline__ unsigned xb_xcc_id() { return (unsigned)__builtin_amdgcn_s_getreg((3 << 11) | 20) & 0xFu; }
#define XB_SPIN(cond, bar) do { unsigned _sp = 0; while (cond) { __builtin_amdgcn_s_sleep(1); \
    if ((++_sp & 255u) == 0u) { if (xb_ld(&(bar)[XB_TMO])) break; if (_sp > XB_SPIN_CAP) { atomicAdd(&(bar)[XB_TMO], 1u); break; } } } } while (0)

struct XcdBarrier { unsigned* bar; unsigned x; volatile LAS unsigned* st; };

__device__ __forceinline__ XcdBarrier xcd_barrier_post(unsigned* bar, volatile LAS unsigned* st) {
    XcdBarrier b; b.bar = bar; b.x = xb_xcc_id(); b.st = st;
    if (threadIdx.x == 0) (void)xb_add(&bar[XB_XCNT(b.x)], 1u);
    return b;
}
__device__ __forceinline__ void xcd_barrier_complete(unsigned* bar, unsigned x, unsigned& nloc, unsigned& nx) {
    const unsigned G = gridDim.x * gridDim.y * gridDim.z;
    unsigned sum, cnt, mine, sp = 0u;
    for (;;) {
        sum = 0u; cnt = 0u; mine = 0u;
#pragma unroll
        for (unsigned j = 0; j < 16; ++j) { const unsigned c = xb_ld(&bar[XB_XCNT(j)]); sum += c; cnt += (c > 0u) ? 1u : 0u; mine = (j == x) ? c : mine; }
        if (sum == G) break;
        __builtin_amdgcn_s_sleep(1);
        if ((++sp & 255u) == 0u) { if (xb_ld(&bar[XB_TMO])) break; if (sp > XB_SPIN_CAP) { atomicAdd(&bar[XB_TMO], 1u); break; } }
    }
    nloc = mine > 0u ? mine : 1u; nx = cnt > 0u ? cnt : 1u;
}
__device__ __forceinline__ void xcd_barrier(const XcdBarrier& b, int tid) {
    asm volatile("s_waitcnt vmcnt(0)" ::: "memory");
    __syncthreads();
    if (tid == 0) {
        unsigned* bar = b.bar;
        __builtin_amdgcn_s_waitcnt(0);
        unsigned nloc = b.st[0], nx = b.st[1];
        if (nloc == 0u) { xcd_barrier_complete(bar, b.x, nloc, nx); b.st[0] = nloc; b.st[1] = nx; }
        const unsigned old = xb_add(&bar[XB_XSUB(b.x)], 1u);
        const unsigned gen = old / nloc;
        if (old + 1u == (gen + 1u) * nloc) {
            __builtin_amdgcn_fence(__ATOMIC_RELEASE, "agent");
            asm volatile("s_waitcnt vmcnt(0)" ::: "memory");
            const unsigned og = xb_add(&bar[XB_TOP], 1u);
            const unsigned tg = og / nx;
            if (og + 1u == (tg + 1u) * nx) xb_add(&bar[XB_TOPGEN], 1u);
            else XB_SPIN(xb_ld(&bar[XB_TOPGEN]) == tg, bar);
            __builtin_amdgcn_fence(__ATOMIC_ACQUIRE, "agent");
            xb_add(&bar[XB_XGEN(b.x)], 1u);
            asm volatile("s_waitcnt vmcnt(0)" ::: "memory");
        } else {
            XB_SPIN(xb_ld(&bar[XB_XGEN(b.x)]) == gen, bar);
            __builtin_amdgcn_fence(__ATOMIC_ACQUIRE, "agent");
            asm volatile("s_waitcnt vmcnt(0)" ::: "memory");
        }
    }
    __syncthreads();
}

__device__ __forceinline__ float shfl_xor_l(float v, int m, int lane) { return __int_as_float(__builtin_amdgcn_ds_bpermute((lane ^ m) << 2, __float_as_int(v))); }
__device__ __forceinline__ float shfl_up_l(float v, int o, int lane) { return __int_as_float(__builtin_amdgcn_ds_bpermute((lane - o) << 2, __float_as_int(v))); }
__device__ __forceinline__ float wave_sum(float v, int lane) {
#pragma unroll
    for (int o = 1; o < 64; o <<= 1) v += shfl_xor_l(v, o, lane);
    return v;
}
__device__ __forceinline__ float wave_max(float v, int lane) {
#pragma unroll
    for (int o = 1; o < 64; o <<= 1) v = fmaxf(v, shfl_xor_l(v, o, lane));
    return v;
}
__device__ __forceinline__ void transpose_item(const float* W, int ldw, int K, int N, bf16* WT, int mode, LAS float* scr, int item, int lane, const float* gain = nullptr) {
    const int nblk = N / 32, kb = item / nblk, nb = item % nblk, k0 = 64 * kb, n0 = 32 * nb;
    const int r0 = (mode == 0) ? n0 : ((n0 >> 7) * 256 + (mode == 2 ? 128 : 0) + (n0 & 127));
#pragma unroll 8
    for (int i = 0; i < 32; ++i) { const int kk = 2 * i + (lane >> 5); scr[kk * 33 + (lane & 31)] = W[(size_t)(k0 + kk) * ldw + n0 + (lane & 31)]; }
    LDS_WAIT(); asm volatile("" ::: "memory");
    const int c = lane & 7;
    f32x4 ga = (f32x4){1.f, 1.f, 1.f, 1.f}, gb = ga; if (gain) { ga = *(const f32x4*)(gain + k0 + 8 * c); gb = *(const f32x4*)(gain + k0 + 8 * c + 4); }
#pragma unroll
    for (int j = 0; j < 4; ++j) { const int n = (lane >> 3) + 8 * j; const LAS float* s = scr + (8 * c) * 33 + n;
        v4u o; o.x = pk2(s[0 * 33] * ga.x, s[1 * 33] * ga.y); o.y = pk2(s[2 * 33] * ga.z, s[3 * 33] * ga.w); o.z = pk2(s[4 * 33] * gb.x, s[5 * 33] * gb.y); o.w = pk2(s[6 * 33] * gb.z, s[7 * 33] * gb.w);
        *(GAS v4u*)(WT + (size_t)(r0 + n) * K + k0 + 8 * c) = o; }
    LDS_WAIT(); asm volatile("" ::: "memory");
}
struct CvtDesc { const float* W; int ldw, K, N; bf16* WT; int mode; const float* gain; int tile; };
__device__ __forceinline__ void cvt_load(const CvtDesc& d, f32x4 (&v)[16], int tid) {
    const int ntn = d.N >> 8, kb = d.tile / ntn, nb = d.tile - kb * ntn, k0 = kb * 128, n0 = nb * 256;
#pragma unroll
    for (int i = 0; i < 16; ++i) { const int idx = tid + 512 * i, k = idx >> 6, c4 = idx & 63; v[i] = __builtin_nontemporal_load((const GAS f32x4*)(d.W + (size_t)(k0 + k) * d.ldw + n0 + 4 * c4)); }
}
__device__ __forceinline__ void cvt_to_lds(const CvtDesc& d, const f32x4 (&v)[16], LAS unsigned char* lds, int tid) {
    const int ntn = d.N >> 8, kb = d.tile / ntn, k0 = kb * 128;
#pragma unroll
    for (int i = 0; i < 16; ++i) { const int idx = tid + 512 * i, k = idx >> 6, c4 = idx & 63; f32x4 x = v[i];
        if (d.gain) x = x * d.gain[k0 + k];
        v2u w; w.x = pk2(x.x, x.y); w.y = pk2(x.z, x.w);
        *(LAS v2u*)(lds + k * 520 + c4 * 8) = w; }
}
__device__ __forceinline__ void cvt_store(const CvtDesc& d, const LAS unsigned char* lds, int tid) {
    const int ntn = d.N >> 8, kb = d.tile / ntn, nb = d.tile - kb * ntn, k0 = kb * 128, n0 = nb * 256;
    const int n = tid & 255, half = tid >> 8, ng = n0 + n;
    const int drow = (d.mode == 0) ? ng : ((ng >> 7) * 256 + (d.mode == 2 ? 128 : 0) + (ng & 127));
    bf16* dst = (d.mode == 3) ? d.WT + ((size_t)(k0 >> 9) * 2048 + ng) * 512 + (k0 & 511)
                              : d.WT + ((size_t)((drow >> 8) * (d.K >> 6) + (k0 >> 6)) * 256 + (drow & 255)) * 64;
    const int kcs = (d.mode == 3) ? 8 : 8, kts = (d.mode == 3) ? 0 : 256 * 64 - 64;
#pragma unroll 2
    for (int j = 0; j < 8; ++j) { const int kc = 2 * j + half; const LAS unsigned short* sp = (const LAS unsigned short*)(lds + (8 * kc) * 520 + n * 2);
        v4u o; o.x = (unsigned)sp[0] | ((unsigned)sp[260] << 16); o.y = (unsigned)sp[2 * 260] | ((unsigned)sp[3 * 260] << 16); o.z = (unsigned)sp[4 * 260] | ((unsigned)sp[5 * 260] << 16); o.w = (unsigned)sp[6 * 260] | ((unsigned)sp[7 * 260] << 16);
        *(GAS v4u*)(dst + kcs * kc + (kc >> 3) * kts) = o; }
}
__device__ __forceinline__ void rms_row(const float* xrow, const float* g, bf16* orow, int lane, f32x4 (&v)[8]) {
    const GAS f32x4* xr = (const GAS f32x4*)xrow + lane;
    float s = 0.f;
#pragma unroll
    for (int j = 0; j < 8; ++j) { v[j] = xr[64 * j]; s += (v[j].x * v[j].x + v[j].y * v[j].y) + (v[j].z * v[j].z + v[j].w * v[j].w); }
    const float r = 1.0f / sqrtf(wave_sum(s, lane) * (1.f / 2048.f) + EPS);
    const GAS f32x4* gr = (const GAS f32x4*)g + lane;
    GAS v2u* o8 = (GAS v2u*)orow + lane;
#pragma unroll
    for (int j = 0; j < 8; ++j) { const f32x4 gv = gr[64 * j]; v[j] = v[j] * r * gv; v2u w; w.x = pk2(v[j].x, v[j].y); w.y = pk2(v[j].z, v[j].w); o8[64 * j] = w; }
}


#ifndef MLSTM_NAIVE
#define MLSTM_NAIVE 0
#endif
typedef short ml_bf16x8 __attribute__((ext_vector_type(8)));
typedef short ml_s16x4 __attribute__((ext_vector_type(4)));
constexpr int ML_QS = 0, ML_KS = 33792, ML_VS = 67584, ML_VW = 76800, ML_WS = 86016, ML_XCH = 95232, ML_NS = 111616, ML_SC = 112640, ML_GA = 114688, ML_GB = 122880, ML_GP = 131072, ML_GM = 139264, ML_PQ = 528, ML_PV = 144;
constexpr int SC_A2 = 0, SC_M2 = 64, SC_IW = 128, SC_NFL = 192, SC_WS = 256, SC_DEN = 320, SC_DECAY = 384;
static_assert(ML_GM + 256 <= LDS_BYTES - 128, "mLSTM LDS map below the barrier words");
__device__ __forceinline__ ml_bf16x8 ml_tr_read2(const LAS unsigned char* p0, const LAS unsigned char* p1) {
    const ml_s16x4 lo = __builtin_amdgcn_ds_read_tr16_b64_v4i16((LAS ml_s16x4*)p0), hi = __builtin_amdgcn_ds_read_tr16_b64_v4i16((LAS ml_s16x4*)p1);
    return __builtin_shufflevector(lo, hi, 0, 1, 2, 3, 4, 5, 6, 7);
}
__device__ __forceinline__ unsigned ml_pk2n(float lo, float hi) { unsigned r; asm volatile("v_cvt_pk_bf16_f32 %0, %1, %2\n\ts_nop 1" : "=v"(r) : "v"(lo), "v"(hi)); return r; }
#define ML_EXP(x) __builtin_amdgcn_exp2f((x) * 1.4426950408889634f)
#define ML_MFMA(a, b, c) __builtin_amdgcn_mfma_f32_16x16x32_bf16((a), (b), (c), 0, 0, 0)
__device__ __forceinline__ void mlstm_item(LAS unsigned char* lds, const bf16* QCp, const bf16* KCp, const bf16* Zp, const float* GATp, bf16* HMp, int item, int tid) {
    const int lane = tid & 63, w = __builtin_amdgcn_readfirstlane(tid >> 6), g = lane >> 4, i = lane & 15, dvb = w & 3, dkh = w >> 2;
    const int b = item >> 4, h = (item >> 2) & 3, jv = item & 3;
    LAS float* sc = (LAS float*)(lds + ML_SC); LAS float* nS = (LAS float*)(lds + ML_NS);
    LAS float* gA = (LAS float*)(lds + ML_GA); LAS float* gB = (LAS float*)(lds + ML_GB); LAS float* gP = (LAS float*)(lds + ML_GP); LAS float* gM = (LAS float*)(lds + ML_GM);
    f32x4 Cacc[8];
#pragma unroll
    for (int x = 0; x < 8; ++x) Cacc[x] = (f32x4){0.f, 0.f, 0.f, 0.f};
    if (tid < 256) nS[tid] = 0.f;
    const size_t tokb = (size_t)b * SEQ;
#pragma unroll 1
    for (int cc = w; cc < SEQ / 64; cc += 8) {
        const size_t t = tokb + (size_t)cc * 64 + lane; const float li = GATp[t * 8 + h], lf = GATp[t * 8 + 4 + h];
        float bc = lf;
#pragma unroll
        for (int o = 1; o < 64; o <<= 1) { const float y = shfl_up_l(bc, o, lane); if (lane >= o) bc += y; }
        const float a = li - bc; float pm = a;
#pragma unroll
        for (int o = 1; o < 64; o <<= 1) { const float y = shfl_up_l(pm, o, lane); if (lane >= o) pm = fmaxf(pm, y); }
        gA[cc * 64 + lane] = a; gB[cc * 64 + lane] = bc; gP[cc * 64 + lane] = pm;
    }
    __syncthreads();
    if (tid == 0) { float m = 0.f; gM[0] = 0.f;
        for (int cc = 0; cc < SEQ / 64; ++cc) { m = gB[cc * 64 + 63] + fmaxf(m, gP[cc * 64 + 63]); gM[cc + 1] = m; } }
    v4u qreg[4], kreg[4], vreg;
    const unsigned qoff = (unsigned)((tid >> 5) * 2048 + (tid & 31) * 16), voff = (unsigned)((tid >> 3) * (ZP * 2) + (tid & 7) * 16);
#define ML_FETCH(c) do { const size_t t0_ = tokb + (size_t)(c) * 64; unsigned qo_ = qoff, vo_ = voff; asm volatile("" : "+v"(qo_), "+v"(vo_)); \
        const char* qb_ = (const char*)(QCp + t0_ * 1024 + h * 256); const char* kb_ = (const char*)(KCp + t0_ * 1024 + h * 256); \
        _Pragma("unroll") for (int i4 = 0; i4 < 4; ++i4) { qreg[i4] = *(const GAS v4u*)(qb_ + (size_t)i4 * 32768 + qo_); kreg[i4] = *(const GAS v4u*)(kb_ + (size_t)i4 * 32768 + qo_); } \
        vreg = *(const GAS v4u*)((const char*)(Zp + t0_ * ZP + 3072 + h * 256 + jv * 64) + vo_); } while (0)
    ML_FETCH(0);
    __syncthreads();
    for (int c = 0; c < SEQ / 64; ++c) {
        const size_t t0 = tokb + (size_t)c * 64;
        unsigned trb_ = (unsigned)((8 * g + (i >> 2)) * ML_PV + (16 * dvb + 4 * (i & 3)) * 2), trk_ = (unsigned)(ML_KS + (8 * g + (i >> 2)) * ML_PQ + (128 * dkh + 4 * (i & 3)) * 2);
        asm volatile("" : "+v"(trb_), "+v"(trk_));
        const LAS unsigned char* trb = lds + trb_; const LAS unsigned char* trk = lds + trk_;
#pragma unroll
        for (int i4 = 0; i4 < 4; ++i4) { const int p = tid + 512 * i4; *(LAS v4u*)(lds + ML_QS + (p >> 5) * ML_PQ + (p & 31) * 16) = qreg[i4]; *(LAS v4u*)(lds + ML_KS + (p >> 5) * ML_PQ + (p & 31) * 16) = kreg[i4]; }
        if (w == 0) {
            const float mc = gM[c], a = gA[c * 64 + lane], bc = gB[c * 64 + lane], Mt = fmaxf(mc, gP[c * 64 + lane]), M63 = fmaxf(mc, gP[c * 64 + 63]);
            sc[SC_A2 + lane] = a * 1.4426950408889634f; sc[SC_M2 + lane] = Mt * 1.4426950408889634f; sc[SC_IW + lane] = ML_EXP(mc - Mt); sc[SC_NFL + lane] = ML_EXP(-(bc + Mt)); sc[SC_WS + lane] = ML_EXP(a - M63);
            if (lane == 0) sc[SC_DECAY] = ML_EXP(mc - M63);
        }
        __syncthreads();
        { const int row = tid >> 3, c8 = tid & 7; const float wsr = sc[SC_WS + row];
          *(LAS v4u*)(lds + ML_VS + row * ML_PV + c8 * 16) = vreg;
          v4u o; o.x = pk2(bflo(vreg.x) * wsr, bfhi(vreg.x) * wsr); o.y = pk2(bflo(vreg.y) * wsr, bfhi(vreg.y) * wsr); o.z = pk2(bflo(vreg.z) * wsr, bfhi(vreg.z) * wsr); o.w = pk2(bflo(vreg.w) * wsr, bfhi(vreg.w) * wsr);
          *(LAS v4u*)(lds + ML_VW + row * ML_PV + c8 * 16) = o; }
        {
            const int tb1 = w >> 1, sb0 = 2 * (w & 1);
            f32x4 S0 = (f32x4){0.f, 0.f, 0.f, 0.f}, S1 = S0;
#pragma unroll
            for (int kk = 0; kk < 8; ++kk) {
                const ml_bf16x8 af = *(const LAS ml_bf16x8*)(lds + ML_QS + (16 * tb1 + i) * ML_PQ + (32 * kk + 8 * g) * 2);
                const ml_bf16x8 b0 = *(const LAS ml_bf16x8*)(lds + ML_KS + (16 * sb0 + i) * ML_PQ + (32 * kk + 8 * g) * 2);
                const ml_bf16x8 b1 = *(const LAS ml_bf16x8*)(lds + ML_KS + (16 * (sb0 + 1) + i) * ML_PQ + (32 * kk + 8 * g) * 2);
                S0 = ML_MFMA(af, b0, S0); S1 = ML_MFMA(af, b1, S1);
            }
            const f32x4 M2v = *(const LAS f32x4*)(sc + SC_M2 + 16 * tb1 + 4 * g);
            const float a20 = sc[SC_A2 + 16 * sb0 + i], a21 = sc[SC_A2 + 16 * (sb0 + 1) + i];
#pragma unroll
            for (int r = 0; r < 4; ++r) { const int t = 16 * tb1 + 4 * g + r, s0 = 16 * sb0 + i, s1 = s0 + 16;
                const float w0 = (s0 <= t) ? __builtin_amdgcn_exp2f(fminf(a20 - M2v[r], 0.f)) * S0[r] : 0.f;
                const float w1 = (s1 <= t) ? __builtin_amdgcn_exp2f(fminf(a21 - M2v[r], 0.f)) * S1[r] : 0.f;
                *(LAS unsigned short*)(lds + ML_WS + t * ML_PV + s0 * 2) = (unsigned short)(pk2(w0, 0.f) & 0xffffu);
                *(LAS unsigned short*)(lds + ML_WS + t * ML_PV + s1 * 2) = (unsigned short)(pk2(w1, 0.f) & 0xffffu); }
        }
        f32x4 P0 = (f32x4){0.f, 0.f, 0.f, 0.f}, P1 = P0, P2 = P0, P3 = P0;
#pragma unroll
        for (int kk = 0; kk < 4; ++kk) {
            u32x4v bw; bw.x = ml_pk2n(Cacc[2 * kk][0], Cacc[2 * kk][1]); bw.y = ml_pk2n(Cacc[2 * kk][2], Cacc[2 * kk][3]); bw.z = ml_pk2n(Cacc[2 * kk + 1][0], Cacc[2 * kk + 1][1]); bw.w = ml_pk2n(Cacc[2 * kk + 1][2], Cacc[2 * kk + 1][3]);
            const ml_bf16x8 bfr = __builtin_bit_cast(ml_bf16x8, bw);
            const int dkb = 128 * dkh + 32 * kk;
#define ML_QFRAG(tb) ({ const v2u lo_ = *(const LAS v2u*)(lds + ML_QS + (16 * (tb) + i) * ML_PQ + (dkb + 4 * g) * 2), hi_ = *(const LAS v2u*)(lds + ML_QS + (16 * (tb) + i) * ML_PQ + (dkb + 16 + 4 * g) * 2); \
            u32x4v q_; q_.x = lo_.x; q_.y = lo_.y; q_.z = hi_.x; q_.w = hi_.y; __builtin_bit_cast(ml_bf16x8, q_); })
            P0 = ML_MFMA(ML_QFRAG(0), bfr, P0); P1 = ML_MFMA(ML_QFRAG(1), bfr, P1); P2 = ML_MFMA(ML_QFRAG(2), bfr, P2); P3 = ML_MFMA(ML_QFRAG(3), bfr, P3);
#undef ML_QFRAG
        }
        __syncthreads();
        if (c + 1 < SEQ / 64) ML_FETCH(c + 1);
        f32x4 H0 = (f32x4){0.f, 0.f, 0.f, 0.f}, H1 = H0;
#pragma unroll
        for (int kk = 0; kk < 2; ++kk) {
            const LAS unsigned char* va = trb + ML_VS + 32 * kk * ML_PV;
            const ml_bf16x8 bfr = ml_tr_read2(va, va + 4 * ML_PV);
            const ml_bf16x8 a0 = *(const LAS ml_bf16x8*)(lds + ML_WS + (16 * (2 * dkh) + i) * ML_PV + (32 * kk + 8 * g) * 2);
            const ml_bf16x8 a1 = *(const LAS ml_bf16x8*)(lds + ML_WS + (16 * (2 * dkh + 1) + i) * ML_PV + (32 * kk + 8 * g) * 2);
            H0 = ML_MFMA(a0, bfr, H0); H1 = ML_MFMA(a1, bfr, H1);
        }
        { const int t = tid >> 3, p = tid & 7; float qn = 0.f;
#pragma unroll
          for (int e = 0; e < 4; ++e) { const v4u qq = *(const LAS v4u*)(lds + ML_QS + t * ML_PQ + (32 * p + 8 * e) * 2); const f32x4 n0 = *(const LAS f32x4*)(nS + 32 * p + 8 * e), n1 = *(const LAS f32x4*)(nS + 32 * p + 8 * e + 4);
              qn += (bflo(qq.x) * n0.x + bfhi(qq.x) * n0.y) + (bflo(qq.y) * n0.z + bfhi(qq.y) * n0.w) + (bflo(qq.z) * n1.x + bfhi(qq.z) * n1.y) + (bflo(qq.w) * n1.z + bfhi(qq.w) * n1.w); }
          const v4u ww = *(const LAS v4u*)(lds + ML_WS + t * ML_PV + 8 * p * 2);
          float d = sc[SC_IW + t] * qn + ((bflo(ww.x) + bfhi(ww.x)) + (bflo(ww.y) + bfhi(ww.y)) + (bflo(ww.z) + bfhi(ww.z)) + (bflo(ww.w) + bfhi(ww.w)));
          d += shfl_xor_l(d, 1, lane); d += shfl_xor_l(d, 2, lane); d += shfl_xor_l(d, 4, lane);
          if (p == 0) sc[SC_DEN + t] = d; }
        { const f32x4 x0 = dkh ? P0 : P2, x1 = dkh ? P1 : P3;
          *(LAS f32x4*)(lds + ML_XCH + ((w * 2 + 0) * 64 + lane) * 16) = x0; *(LAS f32x4*)(lds + ML_XCH + ((w * 2 + 1) * 64 + lane) * 16) = x1; }
        __syncthreads();
        { const f32x4 o0 = dkh ? P2 : P0, o1 = dkh ? P3 : P1;
          const f32x4 p0 = *(const LAS f32x4*)(lds + ML_XCH + (((w ^ 4) * 2 + 0) * 64 + lane) * 16), p1 = *(const LAS f32x4*)(lds + ML_XCH + (((w ^ 4) * 2 + 1) * 64 + lane) * 16);
#pragma unroll
          for (int x = 0; x < 2; ++x) { const int tb = 2 * dkh + x; const f32x4 own = x ? o1 : o0, oth = x ? p1 : p0, hin = x ? H1 : H0;
              const f32x4 iwv = *(const LAS f32x4*)(sc + SC_IW + 16 * tb + 4 * g), dnv = *(const LAS f32x4*)(sc + SC_DEN + 16 * tb + 4 * g), nfv = *(const LAS f32x4*)(sc + SC_NFL + 16 * tb + 4 * g);
#pragma unroll
              for (int r = 0; r < 4; ++r) { const float num = iwv[r] * (own[r] + oth[r]) + hin[r]; const float hv = num / fmaxf(fabsf(dnv[r]), nfv[r]);
                  HMp[(t0 + 16 * tb + 4 * g + r) * 1024 + h * 256 + jv * 64 + 16 * dvb + i] = (bf16)(pk2(hv, 0.f) & 0xffffu); } } }
        const float decay = sc[SC_DECAY];
#pragma unroll
        for (int x = 0; x < 8; ++x) Cacc[x] = Cacc[x] * decay;
        f32x4 nacc0 = (f32x4){0.f, 0.f, 0.f, 0.f}, nacc1 = nacc0;
#pragma unroll
        for (int kk = 0; kk < 2; ++kk) {
            const LAS unsigned char* va = trb + ML_VW + 32 * kk * ML_PV;
            const ml_bf16x8 bfr = ml_tr_read2(va, va + 4 * ML_PV);
            const f32x4 wa = *(const LAS f32x4*)(sc + SC_WS + 32 * kk + 8 * g), wb = *(const LAS f32x4*)(sc + SC_WS + 32 * kk + 8 * g + 4);
            u32x4v ww; ww.x = ml_pk2n(wa[0], wa[1]); ww.y = ml_pk2n(wa[2], wa[3]); ww.z = ml_pk2n(wb[0], wb[1]); ww.w = ml_pk2n(wb[2], wb[3]);
            const ml_bf16x8 wfr = __builtin_bit_cast(ml_bf16x8, ww);
#pragma unroll
            for (int x = 0; x < 8; ++x) { const LAS unsigned char* ka = trk + 32 * kk * ML_PQ + 32 * x; const ml_bf16x8 afr = ml_tr_read2(ka, ka + 4 * ML_PQ);
                Cacc[x] = ML_MFMA(afr, bfr, Cacc[x]);
                if ((x >> 1) == dvb) { if (x & 1) nacc1 = ML_MFMA(afr, wfr, nacc1); else nacc0 = ML_MFMA(afr, wfr, nacc0); } }
        }
        if (i == 0) { LAS f32x4* np0 = (LAS f32x4*)(nS + 128 * dkh + 16 * (2 * dvb) + 4 * g); LAS f32x4* np1 = (LAS f32x4*)(nS + 128 * dkh + 16 * (2 * dvb + 1) + 4 * g);
            *np0 = *np0 * decay + nacc0; *np1 = *np1 * decay + nacc1; }
        __syncthreads();
    }
#undef ML_FETCH
}

struct Args { const float* in[24]; float* out; unsigned char* ws; int l_lo, l_hi, ph_lo, ph_hi, use_bar, do_init, do_final, pad; };
static_assert(sizeof(Args) == 26 * 8 + 8 * 4, "Args has no padding");

__global__ void __launch_bounds__(NWAVES * 64, 2) fwd(Args args) {
    extern __shared__ __attribute__((aligned(16))) unsigned char lds_raw[];
    LAS unsigned char* lds = (LAS unsigned char*)lds_raw;
    volatile LAS unsigned* MISC = (volatile LAS unsigned*)(lds + MISC_OFF);
    const int G = gridDim.x, bx = blockIdx.x, NGW = G * NWAVES;
    const int wave0 = __builtin_amdgcn_readfirstlane((int)threadIdx.x >> 6);
    { const int t0 = threadIdx.x;
      for (int u = t0; u < (LDS_BYTES - LDSCTL_OFF) / 4; u += NWAVES * 64) ((LAS unsigned*)(lds + LDSCTL_OFF))[u] = 0u; }
    __syncthreads();
    XcdBarrier bar; bar.bar = (unsigned*)(args.ws + WS_CTL) + CW_BAR; bar.x = 0; bar.st = nullptr;
    if (args.use_bar) bar = xcd_barrier_post((unsigned*)(args.ws + WS_CTL) + CW_BAR, MISC + 8);
#define GRID_BAR() do { if (args.use_bar) { int bt_; asm volatile("v_mbcnt_lo_u32_b32 %0, -1, 0\n\tv_mbcnt_hi_u32_b32 %0, -1, %0" : "=v"(bt_)); xcd_barrier(bar, bt_ + wave0 * 64); } } while (0)
#define PH_BEGIN() int tid_; asm volatile("v_mbcnt_lo_u32_b32 %0, -1, 0\n\tv_mbcnt_hi_u32_b32 %0, -1, %0" : "=v"(tid_)); tid_ += wave0 * 64; const int tid = tid_, lane = tid & 63, wave = __builtin_amdgcn_readfirstlane(tid >> 6), gw = bx * NWAVES + wave; \
    unsigned char* ws = args.ws; asm volatile("" : "+s"(ws)); unsigned char* BIG = ws + WS_BIG; (void)tid; (void)lane; (void)gw; (void)BIG; \
    bf16* U = (bf16*)(ws + WS_U); (void)U
#define INP(k) ({ int k_ = (k); asm volatile("" : "+s"(k_)); const float* p_ = args.in[k_]; p_; })
#define HID ((bf16*)BIG)
#define Z ((bf16*)BIG)
#define PB ((bf16*)BIG)
#define GT ((bf16*)(ws + WS_GT))
#define VWT ((bf16*)(ws + WS_VWT))
#define QC ((bf16*)(ws + WS_X1))
#define KC (QC + (size_t)M * 1024)
#define DP ((bf16*)(ws + WS_X2))
#define HM ((bf16*)(ws + WS_HM))
#define GAT ((float*)(ws + WS_GAT))
#define KB ((bf16*)(ws + WS_KB))
#define VB ((bf16*)(ws + WS_VT))
#define MEMN ((bf16*)(ws + WS_MEMN))
#define WGU1 ((bf16*)(ws + WS_WGU1))
#define WD1 ((bf16*)(ws + WS_WD1))
#define WGU2 ((bf16*)(ws + WS_WGU2))
#define WD2 ((bf16*)(ws + WS_WD2))
#define WIN ((bf16*)(ws + WS_WIN))
#define WPOOL ((bf16*)(ws + WS_WPOOL))
#define WOUT ((bf16*)(ws + WS_WOUT))
#define WQH ((bf16*)(ws + WS_WQ))
#define WKV ((bf16*)(ws + WS_WKV))
#define WOH ((bf16*)(ws + WS_WO))

    const int lo = args.ph_lo, hi = args.ph_hi;
#ifndef PHMASK
#define PHMASK 0xfff
#endif
#ifndef DUPMASK
#define DUPMASK 0
#endif
#define NREP(k) (1 + ((DUPMASK >> (k)) & 1))
#define IN(k) (((PHMASK >> (k)) & 1) && lo <= (k) && (k) < hi)
#define RSS(k) ((pg8::rss_t*)(ws + WS_RSS) + (size_t)(k) * M)
#define H16 ((bf16*)(ws + WS_H))
#define DUMMY16 ((bf16*)(ws + WS_X1))

    if (args.do_init) {
        PH_BEGIN();
        const float* x = INP(0);
        for (int m = gw; m < M; m += NGW) {
            const GAS f32x4* xr = (const GAS f32x4*)(x + (size_t)m * D) + lane; float ss = 0.f;
#pragma unroll
            for (int j = 0; j < 8; ++j) { const f32x4 v = __builtin_nontemporal_load(xr + 64 * j); v2u w; w.x = pk2(v.x, v.y); w.y = pk2(v.z, v.w); *(GAS v2u*)(H16 + h16_off(m, 256 * j + 4 * lane)) = w;
                const float a0 = bflo(w.x), a1 = bfhi(w.x), a2 = bflo(w.y), a3 = bfhi(w.y); ss += (a0 * a0 + a1 * a1) + (a2 * a2 + a3 * a3); }
            ss = wave_sum(ss, lane);
            if (lane == 0) RSS(0)[m] = (pg8::rss_t)(ss * 1048576.0f + 0.5f);
        }
        GRID_BAR();
    }
    for (int l = args.l_lo; l < args.l_hi; ++l) {
        if (IN(0)) for (int rep = 0; rep < NREP(0); ++rep) {
            PH_BEGIN();
            const float* wg1 = INP(3) + (size_t)l * D * FF; const float* wu1 = INP(4) + (size_t)l * D * FF; const float* wd1 = INP(5) + (size_t)l * FF * D;
            const float* wg2 = INP(20) + (size_t)l * D * FF; const float* wu2 = INP(21) + (size_t)l * D * FF; const float* wd2 = INP(22) + (size_t)l * FF * D;
            const float* win = INP(7) + (size_t)l * D * DIN; const float* wpool = INP(11) + (size_t)l * 4 * 65536; const float* wout = INP(13) + (size_t)l * D * D;
            const float* wq = INP(16) + (size_t)l * D * D; const float* wkv = INP(17) + (size_t)l * D * 2 * D; const float* wo = INP(18) + (size_t)l * D * D;
            const float* g1 = INP(2) + (size_t)l * D; const float* gm = INP(6) + (size_t)l * D; const float* gx = INP(14) + (size_t)l * D; const float* g2 = INP(19) + (size_t)l * D;
            constexpr int T_GU = (D / 128) * (FF / 256), T_DN = (FF / 128) * (D / 256), T_IN = (D / 128) * (DINM / 256), T_PL = 2, T_SQ = (D / 128) * (D / 256), T_KV = (D / 128) * (2 * D / 256);
            constexpr int NTILES = 4 * T_GU + 2 * T_DN + T_IN + 4 * T_PL + 2 * T_SQ + T_KV;
#define CVT_DESC(dst, it_) do { int r = (it_); \
                if (r < T_GU) { dst = CvtDesc{wg1, FF, D, FF, WGU1, 1, g1, r}; break; } r -= T_GU; \
                if (r < T_GU) { dst = CvtDesc{wu1, FF, D, FF, WGU1, 2, g1, r}; break; } r -= T_GU; \
                if (r < T_DN) { dst = CvtDesc{wd1, D, FF, D, WD1, 0, nullptr, r}; break; } r -= T_DN; \
                if (r < T_GU) { dst = CvtDesc{wg2, FF, D, FF, WGU2, 1, g2, r}; break; } r -= T_GU; \
                if (r < T_GU) { dst = CvtDesc{wu2, FF, D, FF, WGU2, 2, g2, r}; break; } r -= T_GU; \
                if (r < T_DN) { dst = CvtDesc{wd2, D, FF, D, WD2, 0, nullptr, r}; break; } r -= T_DN; \
                if (r < T_IN) { dst = CvtDesc{win, DIN, D, DINM, WIN, 0, gm, r}; break; } r -= T_IN; \
                if (r < 4 * T_PL) { const int g_ = r / T_PL; dst = CvtDesc{wpool + (size_t)g_ * 65536, 256, 256, 256, WPOOL + (size_t)g_ * 65536, 0, nullptr, r % T_PL}; break; } r -= 4 * T_PL; \
                if (r < T_SQ) { dst = CvtDesc{wout, D, D, D, WOUT, 0, nullptr, r}; break; } r -= T_SQ; \
                if (r < T_KV) { dst = CvtDesc{wkv, 2 * D, D, 2 * D, WKV, 0, nullptr, r}; break; } r -= T_KV; \
                dst = CvtDesc{wo, D, D, D, WOH, 3, nullptr, r}; } while (0)
            int it0 = bx; asm volatile("" : "+s"(it0));
            if (it0 < NTILES) {
                f32x4 cv[16]; CvtDesc cd; CVT_DESC(cd, it0); cvt_load(cd, cv, tid);
                int buf = 0;
#pragma unroll 1
                for (int it = it0; it < NTILES; it += G) {
                    LAS unsigned char* img = lds + RING_OFF + buf * 66560;
                    cvt_to_lds(cd, cv, img, tid);
                    __syncthreads();
                    CvtDesc cn = cd; const bool more = it + G < NTILES;
                    if (more) { CVT_DESC(cn, it + G); cvt_load(cn, cv, tid); }
                    cvt_store(cd, img, tid);
                    cd = cn; buf ^= 1;
                }
                __syncthreads();
            }
#undef CVT_DESC
            for (int e = bx * (NWAVES * 64) + tid; e < D * D / 8; e += G * NWAVES * 64) { const int k = e >> 8, n8 = (e & 255) * 8; const float sc = gx[k] * 0.044194173824159216f;
                const f32x4 a = __builtin_nontemporal_load((const GAS f32x4*)(wq + (size_t)k * D + n8)), b = __builtin_nontemporal_load((const GAS f32x4*)(wq + (size_t)k * D + n8 + 4));
                v4u o; o.x = pk2(a.x * sc, a.y * sc); o.y = pk2(a.z * sc, a.w * sc); o.z = pk2(b.x * sc, b.y * sc); o.w = pk2(b.z * sc, b.w * sc);
                *(GAS v4u*)(WQH + ((size_t)(n8 >> 9) * D + k) * 512 + (n8 & 511)) = o; }
            for (int e = bx * (NWAVES * 64) + tid; e < 256 * D; e += G * NWAVES * 64) { const int rr = e >> 11, k = e & (D - 1);
                const float v = (rr < 8) ? win[(size_t)k * DIN + DINM + rr] * gm[k] : 0.f; WIN[((size_t)(20 * 32 + (k >> 6)) * 256 + rr) * 64 + (k & 63)] = (bf16)(pk2(v, 0.f) & 0xffffu); }
            f32x4 v[8];
            for (int m = gw; m < MMEM; m += NGW) rms_row(INP(1) + (size_t)m * D, INP(15) + (size_t)l * D, MEMN + (size_t)m * D, lane, v);
            GRID_BAR();
        }
        if (IN(1)) for (int rep = 0; rep < NREP(1); ++rep) {
            PH_BEGIN();
            pg8::Gemm g{H16, WGU1, D, 0, 44, 1, 1}; pg8::StaticOrder S; S.init(128, 44, G, bx);
            pg8::EpiSwiGLU E{HID, 64, RSS(4 * l), (LAS float*)(lds + LDSCTL_OFF + 12288)};
            pg8::gemm_phase<pg8::EpiSwiGLU, pg8::StaticOrder, PG8_ALIGN, PG8_SP2, true>(lds + RING_OFF, g, S, E, tid);
            { pg8::Gemm g2{MEMN, WKV, D, 0, 16, 0, 1}; pg8::StaticOrder S2; S2.init(16, 16, G, bx);
              pg8::EpiBf16K<1> E2{KB, nullptr, 1.0f, MMEM, nullptr, nullptr, nullptr, nullptr};
              pg8::gemm_phase<pg8::EpiBf16K<1>, pg8::StaticOrder, PG8_ALIGN, PG8_SP2>(lds + RING_OFF, g2, S2, E2, tid); }
            GRID_BAR();
        }
        if (IN(2)) for (int rep = 0; rep < NREP(2); ++rep) {
            PH_BEGIN();
            const bool dummy = rep + 1 < NREP(2);
            pg8::Gemm g{HID, WD1, FF, 0, 8, 1, 1}; pg8::StaticOrder S; S.init(128, 8, G, bx);
            pg8::EpiResid16 E{H16, dummy ? DUMMY16 : H16, 0.5f, dummy ? RSS(17) : RSS(4 * l + 1)};
            pg8::gemm_phase<pg8::EpiResid16, pg8::StaticOrder, false, PG8_SP2, true>(lds + RING_OFF, g, S, E, tid);
            GRID_BAR();
        }
        if (IN(3)) for (int rep = 0; rep < NREP(3); ++rep) {
            PH_BEGIN();
            pg8::Gemm g{H16, WIN, D, 0, 21, 1, 1}; pg8::StaticOrder S; S.init(128, 21, G, bx);
            pg8::EpiBf16K<0> E{Z, nullptr, 1.0f, 0, RSS(4 * l + 1), GAT, INP(8) + l * 8, (LAS float*)(lds + LDSCTL_OFF + 12288)};
            pg8::gemm_phase<pg8::EpiBf16K<0>, pg8::StaticOrder, PG8_ALIGN, PG8_SP2>(lds + RING_OFF, g, S, E, tid);
            const bool lateWG = (G == 256) && bx >= 128;
#pragma unroll 1
            for (int part = 0; part < 2; ++part) {
                pg8::Gemm g2{KB, WQH, 512, 16, 8}; pg8::StaticOrder S2; S2.init(64, 8, G, bx);
                if (G == 256) { if (part == 0) S2.slice(0, 256, 256, bx); else S2.slice(256, 256, 128, lateWG ? bx - 128 : 256); } else if (part == 1) S2.slice(0, 0, G, 1);
                pg8::EpiBf16K<5> E2{GT, nullptr, 1.0f, 0, nullptr, nullptr, nullptr, nullptr};
                pg8::gemm_phase<pg8::EpiBf16K<5>, pg8::StaticOrder, PG8_ALIGN, PG8_SP2>(lds + RING_OFF, g2, S2, E2, tid);
                pg8::Gemm g3{WOH, VB, 512, 8, 16}; pg8::StaticOrder S3; S3.init(32, 16, G, bx);
                if (G == 256) { if (part == 0) S3.slice(0, 256, 256, bx); else S3.slice(256, 256, 128, lateWG ? bx - 128 : 256); } else if (part == 1) S3.slice(0, 0, G, 1);
                pg8::EpiBf16K<6> E3{VWT, nullptr, 1.0f, 0, nullptr, nullptr, nullptr, nullptr};
                pg8::gemm_phase<pg8::EpiBf16K<6>, pg8::StaticOrder, PG8_ALIGN, PG8_SP2>(lds + RING_OFF, g3, S3, E3, tid);
            }
            GRID_BAR();
        }
        if (IN(4)) for (int rep = 0; rep < NREP(4); ++rep) {
            PH_BEGIN();
            const float* cw = INP(9) + (size_t)l * 4 * 2048;
#define UNPK8(dst, zz) do { dst[0] = bflo(zz.x); dst[1] = bfhi(zz.x); dst[2] = bflo(zz.y); dst[3] = bfhi(zz.y); dst[4] = bflo(zz.z); dst[5] = bfhi(zz.z); dst[6] = bflo(zz.w); dst[7] = bfhi(zz.w); } while (0)
            for (int blk = bx; blk < 256; blk += G) {
                const int tokb = blk * 128;
                {
                    const int o = tid & 255, c0 = o * 8, t1 = tokb + 64 * (tid >> 8), s1 = t1 & (SEQ - 1);
                    f32x4 W0[2], W1[2], W2[2], W3[2], XA[2], XB[2], XC[2];
#pragma unroll
                    for (int h2 = 0; h2 < 2; ++h2) { W0[h2] = *(const f32x4*)(cw + c0 + 4 * h2); W1[h2] = *(const f32x4*)(cw + 2048 + c0 + 4 * h2); W2[h2] = *(const f32x4*)(cw + 4096 + c0 + 4 * h2); W3[h2] = *(const f32x4*)(cw + 6144 + c0 + 4 * h2); }
#define UNPKV(dst, zz) do { dst[0][0] = bflo(zz.x); dst[0][1] = bfhi(zz.x); dst[0][2] = bflo(zz.y); dst[0][3] = bfhi(zz.y); dst[1][0] = bflo(zz.z); dst[1][1] = bfhi(zz.z); dst[1][2] = bflo(zz.w); dst[1][3] = bfhi(zz.w); } while (0)
                    const bf16* zcol = Z + 1024 + c0;
                    { v4u z3 = (v4u){0u, 0u, 0u, 0u}, z2 = z3, z1 = z3;
                      if (s1 >= 3) z3 = *(const GAS v4u*)(zcol + (size_t)(t1 - 3) * ZP);
                      if (s1 >= 2) z2 = *(const GAS v4u*)(zcol + (size_t)(t1 - 2) * ZP);
                      if (s1 >= 1) z1 = *(const GAS v4u*)(zcol + (size_t)(t1 - 1) * ZP);
                      UNPKV(XA, z3); UNPKV(XB, z2); UNPKV(XC, z1); }
                    const float qs = (c0 < 1024) ? 0.0625f : 1.0f;
                    bf16* dcol = (c0 < 1024) ? (QC + c0) : (KC + (c0 - 1024));
                    v4u zr[8];
#pragma unroll
                    for (int u = 0; u < 8; ++u) zr[u] = *(const GAS v4u*)(zcol + (size_t)(t1 + u) * ZP);
                    for (int tt = 0; tt < 64; tt += 8) {
                        v4u zq[8];
#pragma unroll
                        for (int u = 0; u < 8; ++u) zq[u] = (tt + 8 < 64) ? *(const GAS v4u*)(zcol + (size_t)(t1 + tt + 8 + u) * ZP) : (v4u){0u, 0u, 0u, 0u};
#pragma unroll
                        for (int u = 0; u < 8; ++u) { f32x4 XD[2], Y[2]; UNPKV(XD, zr[u]);
#pragma unroll
                            for (int h2 = 0; h2 < 2; ++h2) { const f32x4 a = W0[h2] * XA[h2] + W1[h2] * XB[h2] + W2[h2] * XC[h2] + W3[h2] * XD[h2];
                                f32x4 e = a * -1.4426950408889634f;
#pragma unroll
                                for (int j = 0; j < 4; ++j) e[j] = __builtin_amdgcn_exp2f(e[j]);
                                e = e + 1.0f;
#pragma unroll
                                for (int j = 0; j < 4; ++j) e[j] = __builtin_amdgcn_rcpf(e[j]);
                                Y[h2] = (a * qs) * e; XA[h2] = XB[h2]; XB[h2] = XC[h2]; XC[h2] = XD[h2]; }
                            v4u wv; wv.x = pk2(Y[0][0], Y[0][1]); wv.y = pk2(Y[0][2], Y[0][3]); wv.z = pk2(Y[1][0], Y[1][1]); wv.w = pk2(Y[1][2], Y[1][3]);
                            *(GAS v4u*)(dcol + (size_t)(t1 + tt + u) * 1024) = wv; }
#pragma unroll
                        for (int u = 0; u < 8; ++u) zr[u] = zq[u];
                    }
                }
                {
                    const int o = tid & 127, c0 = o * 8, g = o >> 5, wdw = 2 << g, t1 = tokb + 32 * (tid >> 7), s1 = t1 & (SEQ - 1);
                    const bf16* zcol = Z + c0;
                    f32x4 S[2]; S[0] = (f32x4){0.f, 0.f, 0.f, 0.f}; S[1] = S[0];
                    for (int j = 1; j <= wdw; ++j) if (s1 - j >= 0) { const v4u zz = *(const GAS v4u*)(zcol + (size_t)(t1 - j) * ZP); f32x4 x[2]; UNPKV(x, zz); S[0] += x[0]; S[1] += x[1]; }
                    bf16* dcol = DP + (size_t)g * M * 256 + (c0 & 255);
                    for (int tt = 0; tt < 32; tt += 8) {
                        v4u zn[8], zo[8];
#pragma unroll
                        for (int u = 0; u < 8; ++u) { const int t = t1 + tt + u, sq = s1 + tt + u; zn[u] = *(const GAS v4u*)(zcol + (size_t)t * ZP);
                            zo[u] = (v4u){0u, 0u, 0u, 0u}; if (sq >= wdw) zo[u] = *(const GAS v4u*)(zcol + (size_t)(t - wdw) * ZP); }
#pragma unroll
                        for (int u = 0; u < 8; ++u) { const int sq = s1 + tt + u; f32x4 xn[2], xo[2], d[2]; UNPKV(xn, zn[u]); UNPKV(xo, zo[u]);
                            const float inv = __builtin_amdgcn_rcpf((float)((sq + 1 < wdw) ? (sq + 1) : wdw));
#pragma unroll
                            for (int h2 = 0; h2 < 2; ++h2) { S[h2] += xn[h2] - xo[h2]; d[h2] = S[h2] * inv - xn[h2]; }
                            v4u wv; wv.x = pk2(d[0][0], d[0][1]); wv.y = pk2(d[0][2], d[0][3]); wv.z = pk2(d[1][0], d[1][1]); wv.w = pk2(d[1][2], d[1][3]);
                            *(GAS v4u*)(dcol + (size_t)(t1 + tt + u) * 256) = wv; }
                    }
                }
            }
#undef UNPK8
#undef UNPKV
            GRID_BAR();
        }
        if (IN(5)) for (int rep = 0; rep < NREP(5); ++rep) {
            PH_BEGIN();
            {
                pg8::Gemm g{DP, WPOOL, 256, 128, 1, 0, 1}; pg8::StaticOrder S; S.init(512, 1, G, bx);
                pg8::EpiBf16K<3> E{U, INP(12) + (size_t)l * 1024, 1.0f, 0, nullptr, nullptr, nullptr, nullptr};
                pg8::gemm_phase<pg8::EpiBf16K<3>, pg8::StaticOrder, PG8_ALIGN, PG8_SP2>(lds + RING_OFF, g, S, E, tid);
            }
            __syncthreads();
            for (int wgi = bx; wgi < 256; wgi += G) { const int item = (G == 256) ? ((((wgi & 7) + 8 * (wgi >> 5)) << 2) | ((wgi >> 3) & 3)) : wgi;
                mlstm_item(lds + RING_OFF, QC, KC, Z, GAT, HM, item, tid); }
            GRID_BAR();
        }
        if (IN(6)) for (int rep = 0; rep < NREP(6); ++rep) {
            PH_BEGIN();
            const float* hn = INP(10) + (size_t)l * 1024;
            const int hq = lane >> 4, i16 = lane & 15, col = hq * 256 + 16 * i16;
            f32x4 gn[4];
#pragma unroll
            for (int q = 0; q < 4; ++q) gn[q] = *(const GAS f32x4*)(hn + col + 4 * q);
            for (int m0 = 2 * gw; m0 < M; m0 += 2 * NGW) {
                v4u hh[2][2], og[2][2];
#pragma unroll
                for (int r2 = 0; r2 < 2; ++r2) { const size_t m = (size_t)(m0 + r2);
                    hh[r2][0] = *(const GAS v4u*)(HM + m * 1024 + col); hh[r2][1] = *(const GAS v4u*)(HM + m * 1024 + col + 8);
                    og[r2][0] = *(const GAS v4u*)(Z + m * ZP + 4096 + col); og[r2][1] = *(const GAS v4u*)(Z + m * ZP + 4096 + col + 8); }
#pragma unroll
                for (int r2 = 0; r2 < 2; ++r2) { const size_t m = (size_t)(m0 + r2);
                    f32x4 av[4], ov[4]; const v4u z0 = hh[r2][0], z1 = hh[r2][1], q0 = og[r2][0], q1 = og[r2][1];
#define UNPQ(dst, lo, hi) do { dst[0] = bflo(lo); dst[1] = bfhi(lo); dst[2] = bflo(hi); dst[3] = bfhi(hi); } while (0)
                    UNPQ(av[0], z0.x, z0.y); UNPQ(av[1], z0.z, z0.w); UNPQ(av[2], z1.x, z1.y); UNPQ(av[3], z1.z, z1.w);
                    UNPQ(ov[0], q0.x, q0.y); UNPQ(ov[1], q0.z, q0.w); UNPQ(ov[2], q1.x, q1.y); UNPQ(ov[3], q1.z, q1.w);
#undef UNPQ
                    float ss = 0.f;
                    ss = pg8::dot2_bf16(z0.x, ss); ss = pg8::dot2_bf16(z0.y, ss); ss = pg8::dot2_bf16(z0.z, ss); ss = pg8::dot2_bf16(z0.w, ss);
                    ss = pg8::dot2_bf16(z1.x, ss); ss = pg8::dot2_bf16(z1.y, ss); ss = pg8::dot2_bf16(z1.z, ss); ss = pg8::dot2_bf16(z1.w, ss);
                    ss += shfl_xor_l(ss, 1, lane); ss += shfl_xor_l(ss, 2, lane); ss += shfl_xor_l(ss, 4, lane); ss += shfl_xor_l(ss, 8, lane);
                    const float r = __builtin_amdgcn_rsqf(ss * (1.f / 256.f) + EPS);
                    f32x4 yv[4];
#pragma unroll
                    for (int q = 0; q < 4; ++q) { f32x4 e = ov[q] * -1.4426950408889634f;
#pragma unroll
                        for (int j = 0; j < 4; ++j) e[j] = __builtin_amdgcn_exp2f(e[j]);
                        e = e + 1.0f;
#pragma unroll
                        for (int j = 0; j < 4; ++j) e[j] = __builtin_amdgcn_rcpf(e[j]);
                        yv[q] = (av[q] * gn[q]) * r * e; }
                    v4u w0, w1; w0.x = pk2(yv[0][0], yv[0][1]); w0.y = pk2(yv[0][2], yv[0][3]); w0.z = pk2(yv[1][0], yv[1][1]); w0.w = pk2(yv[1][2], yv[1][3]);
                    w1.x = pk2(yv[2][0], yv[2][1]); w1.y = pk2(yv[2][2], yv[2][3]); w1.z = pk2(yv[3][0], yv[3][1]); w1.w = pk2(yv[3][2], yv[3][3]);
                    bf16* up = U + h16_off((int)m, 1024 + col); *(GAS v4u*)up = w0; *(GAS v4u*)(up + 8) = w1; }
            }
            GRID_BAR();
        }
        if (IN(7)) for (int rep = 0; rep < NREP(7); ++rep) {
            PH_BEGIN();
            const bool dummy = rep + 1 < NREP(7);
            pg8::Gemm g{U, WOUT, D, 0, 8, 1, 1}; pg8::StaticOrder S; S.init(128, 8, G, bx);
            pg8::EpiResid16 E{H16, dummy ? DUMMY16 : H16, 1.0f, dummy ? RSS(17) : RSS(4 * l + 2)};
            pg8::gemm_phase<pg8::EpiResid16, pg8::StaticOrder, false, PG8_SP2, true>(lds + RING_OFF, g, S, E, tid);
            GRID_BAR();
        }
        if (IN(8)) for (int rep = 0; rep < NREP(8); ++rep) {
            PH_BEGIN();
            pg8::Gemm g{H16, GT, D, 8, 4, 1}; pg8::StaticOrder S; S.init(128, 4, G, bx);
            pg8::EpiSoftmaxP E{PB, RSS(4 * l + 2), (LAS float*)(lds + LDSCTL_OFF + 1024)};
            pg8::gemm_phase<pg8::EpiSoftmaxP, pg8::StaticOrder, true, PG8_SP2, true>(lds + RING_OFF, g, S, E, tid);
            GRID_BAR();
        }
        if (IN(9)) for (int rep = 0; rep < NREP(9); ++rep) {
            PH_BEGIN();
            const bool dummy = rep + 1 < NREP(9);
            pg8::Gemm g{PB, VWT, 1024, 8, 8, 1}; pg8::StaticOrder S; S.init(128, 8, G, bx);
            pg8::EpiResid16 E{H16, dummy ? DUMMY16 : H16, 1.0f, dummy ? RSS(17) : RSS(4 * l + 3)};
            pg8::gemm_phase<pg8::EpiResid16, pg8::StaticOrder, false, PG8_SP2, true>(lds + RING_OFF, g, S, E, tid);
            GRID_BAR();
        }
        if (IN(10)) for (int rep = 0; rep < NREP(10); ++rep) {
            PH_BEGIN();
            pg8::Gemm g{H16, WGU2, D, 0, 44, 1, 1}; pg8::StaticOrder S; S.init(128, 44, G, bx);
            pg8::EpiSwiGLU E{HID, 64, RSS(4 * l + 3), (LAS float*)(lds + LDSCTL_OFF + 12288)};
            pg8::gemm_phase<pg8::EpiSwiGLU, pg8::StaticOrder, PG8_ALIGN, PG8_SP2, true>(lds + RING_OFF, g, S, E, tid);
            GRID_BAR();
        }
        if (IN(11)) for (int rep = 0; rep < NREP(11); ++rep) {
            PH_BEGIN();
            const bool dummy = rep + 1 < NREP(11);
            pg8::Gemm g{HID, WD2, FF, 0, 8, 1, 1}; pg8::StaticOrder S; S.init(128, 8, G, bx);
            pg8::EpiResid16 E{H16, dummy ? DUMMY16 : H16, 0.5f, dummy ? RSS(17) : RSS(4 * l + 4)};
            pg8::gemm_phase<pg8::EpiResid16, pg8::StaticOrder, false, PG8_SP2, true>(lds + RING_OFF, g, S, E, tid);
            GRID_BAR();
        }
    }
    if (args.do_final) {
        PH_BEGIN();
        const float* gf = INP(23);
        for (int m = gw; m < M; m += NGW) {
            const float r = pg8::rms_scale(RSS(16), m);
            GAS f32x4* orow = (GAS f32x4*)(args.out + (size_t)m * D) + lane;
#pragma unroll
            for (int j = 0; j < 8; ++j) { const v2u w = *(const GAS v2u*)(H16 + h16_off(m, 256 * j + 4 * lane)); const f32x4 gv = *((const GAS f32x4*)gf + lane + 64 * j);
                __builtin_nontemporal_store((f32x4){bflo(w.x) * r * gv.x, bfhi(w.x) * r * gv.y, bflo(w.y) * r * gv.z, bfhi(w.y) * r * gv.w}, orow + 64 * j); }
        }
    }
#undef IN
#undef GRID_BAR
}

extern "C" void kernel_launch(void* const* d_in, const int* in_sizes, int n_in, void* d_out, int out_size, void* d_ws, size_t ws_size, hipStream_t stream) {
    static int grid = 0;
    if (grid == 0) {
        if (n_in != 24 || in_sizes[0] != M * D || out_size != M * D || ws_size < WS_END) { fprintf(stderr, "kernel_launch: unexpected shapes / workspace (n_in %d, ws %zu, need %zu)\n", n_in, ws_size, (size_t)WS_END); grid = -1; return; }
        int dev = 0, cus = 0;
        if (hipGetDevice(&dev) != hipSuccess || hipDeviceGetAttribute(&cus, hipDeviceAttributeMultiprocessorCount, dev) != hipSuccess) { grid = -1; return; }
        if (hipFuncSetAttribute((const void*)fwd, hipFuncAttributeMaxDynamicSharedMemorySize, LDS_BYTES) != hipSuccess) { fprintf(stderr, "kernel_launch: hipFuncSetAttribute failed\n"); grid = -1; return; }
        int per_cu = 0;
        if (hipOccupancyMaxActiveBlocksPerMultiprocessor(&per_cu, (const void*)fwd, NWAVES * 64, LDS_BYTES) != hipSuccess || per_cu < 1) { fprintf(stderr, "kernel_launch: occupancy query says %d\n", per_cu); }
        (void)hipGetLastError();
        grid = cus;
    }
    if (grid < 0) return;
    (void)hipMemsetAsync((char*)d_ws + WS_CTL, 0, CTL_ZERO_BYTES, stream);
    Args a{};
    for (int i = 0; i < 24; ++i) a.in[i] = (const float*)d_in[i];
    a.out = (float*)d_out; a.ws = (unsigned char*)d_ws;
#if MK_ONE_LAUNCH
    a.l_lo = 0; a.l_hi = DEPTH; a.ph_lo = 0; a.ph_hi = N_PH; a.use_bar = 1; a.do_init = 1; a.do_final = 1;
    hipLaunchKernelGGL(fwd, dim3(grid), dim3(NWAVES * 64), LDS_BYTES, stream, a);
#else
    a.l_lo = 0; a.l_hi = 0; a.ph_lo = 0; a.ph_hi = 0; a.use_bar = 0; a.do_init = 1; a.do_final = 0;
    hipLaunchKernelGGL(fwd, dim3(grid), dim3(NWAVES * 64), LDS_BYTES, stream, a);
    for (int l = 0; l < DEPTH; ++l)
        for (int ph = 0; ph < N_PH; ++ph) {
            a.l_lo = l; a.l_hi = l + 1; a.ph_lo = ph; a.ph_hi = ph + 1; a.use_bar = 0; a.do_init = 0; a.do_final = 0;
            hipLaunchKernelGGL(fwd, dim3(grid), dim3(NWAVES * 64), LDS_BYTES, stream, a);
        }
    a.l_lo = 0; a.l_hi = 0; a.ph_lo = 0; a.ph_hi = 0; a.use_bar = 0; a.do_init = 0; a.do_final = 1;
    hipLaunchKernelGGL(fwd, dim3(grid), dim3(NWAVES * 64), LDS_BYTES, stream, a);
#endif
}
```

```cpp
#include <hip/hip_runtime.h>
#include <cstdio>
#include <cstdint>

#ifndef MK_ONE_LAUNCH
#define MK_ONE_LAUNCH 1
#endif

namespace pg8 {
typedef _Float16 f16x4_t __attribute__((ext_vector_type(4)));
#define PG8_LAS __attribute__((address_space(3)))
typedef unsigned short bf16_t;
typedef short bf16x8 __attribute__((ext_vector_type(8)));
typedef float f32x4 __attribute__((ext_vector_type(4)));
typedef unsigned u32x4 __attribute__((ext_vector_type(4)));
constexpr int FFH = 5632;
constexpr int BM = 256, BK = 64, HALF = 128, HTB = HALF * BK * 2  , STAGE_BYTES = 8 * HTB, NXCD = 8, WGM = 8;

__host__ __device__ __forceinline__ int lds_byte(int r, int c) { const int st = (r >> 4) * 2 + (c >> 5), rr = r & 15, cc = c & 31, ob = rr * 64 + cc * 2; return st * 1024 + (ob ^ (((ob >> 9) & 1) << 5)); }
__host__ __device__ __forceinline__ void stage_rc(int b, int& R, int& C) { const int st = b / 1024, sb = b % 1024, swz = sb ^ (((sb >> 9) & 1) << 5); R = (st >> 1) * 16 + swz / 64; C = (st & 1) * 32 + (swz % 64) / 2; }
__host__ __device__ __forceinline__ int perm32(int rho) { const int n = rho >> 4, i = rho & 15; return 8 * (i >> 2) + 4 * n + (i & 3); }

struct Unit { int pm, pn; };
struct Gemm { const bf16_t* A; const bf16_t* Bt; int K; int nMz; int nN; int ablk = 0, bblk = 0; };

struct StaticOrder {
    int nM, nN, nwg, G, c, base, count;
    __host__ __device__ void init(int nM_, int nN_, int G_, int c_) { nM = nM_; nN = nN_; nwg = nM * nN; G = G_; c = c_; base = 0; count = nwg; }
    __host__ __device__ void slice(int base_, int count_, int G_, int c_) { base = base_; count = count_; G = G_; c = c_; }
    __host__ __device__ bool next(int i, Unit& u) const {
        const long Lr = (long)i * G + c; if (Lr >= count) return false; const long L = base + Lr;
        int wgid = (int)L; { const int q = nwg / NXCD, r = nwg % NXCD, xcd = wgid % NXCD, off = wgid / NXCD; wgid = (xcd < r ? xcd * (q + 1) : r * (q + 1) + (xcd - r) * q) + off; }
        const int nig = WGM * nN, gid = wgid / nig, fm = gid * WGM, gsz = (nM - fm) < WGM ? (nM - fm) : WGM;
        u.pm = fm + ((wgid % nig) % gsz); u.pn = (wgid % nig) / gsz; return true;
    }
    __device__ __forceinline__ void a_ready(const Unit&) const {}
    __device__ __forceinline__ void done(const Unit&) const {}
};

struct SyncOrder : StaticOrder {
    unsigned* cnt; unsigned members; int w0;
    __device__ __forceinline__ void done(const Unit&) const {
        if (w0) {
            unsigned ln; asm volatile("v_mbcnt_lo_u32_b32 %0, -1, 0\n\tv_mbcnt_hi_u32_b32 %0, -1, %0" : "=v"(ln));
            unsigned old = 0u; if (ln == 0u) old = __hip_atomic_fetch_add(cnt, 1u, __ATOMIC_RELAXED, __HIP_MEMORY_SCOPE_AGENT);
            old = (unsigned)__builtin_amdgcn_readfirstlane((int)old);
            const unsigned target = (old / members + 1u) * members; unsigned sp = 0u;
            while ((unsigned)__builtin_amdgcn_readfirstlane((int)__hip_atomic_load(cnt, __ATOMIC_RELAXED, __HIP_MEMORY_SCOPE_AGENT)) < target) { __builtin_amdgcn_s_sleep(1); if (++sp > (1u << 16)) break; }
        }
        asm volatile("" ::: "memory"); __builtin_amdgcn_s_barrier(); asm volatile("" ::: "memory");
    }
};

__device__ __forceinline__ unsigned cvt_pk_bf16(float lo, float hi) { unsigned r; asm volatile("v_cvt_pk_bf16_f32 %0, %1, %2" : "=v"(r) : "v"(lo), "v"(hi)); return r; }

__device__ __forceinline__ float silu_f(float x) { return x * __builtin_amdgcn_rcpf(1.0f + __builtin_amdgcn_exp2f(-1.4426950408889634f * x)); }

typedef unsigned long long rss_t;
#define PG8_GAS __attribute__((address_space(1)))
__device__ __forceinline__ float rms_from_ss(rss_t v) { return __builtin_amdgcn_rsqf((float)v * (1.0f / (2048.0f * 1048576.0f)) + 1e-6f); }
__device__ __forceinline__ float rms_scale(const rss_t* rss, int row) { return rms_from_ss(((const PG8_GAS rss_t*)rss)[row]); }
struct EpiSwiGLU {
    static constexpr bool PERM = true, AFTER_DRAIN = false, ROWTAB = true;
    bf16_t* O; int ldc; const rss_t* rss; PG8_LAS float* tab;
    __device__ __forceinline__ void fill_table(int pm, int par, int tid) const { if (tid < 256) tab[par * 256 + tid] = rms_scale(rss, pm * BM + tid); }
    __device__ __forceinline__ void operator()(const f32x4 (&acc)[2][2][4][2], const Unit& u, int wr, int wc, int fr, int fq, int par) const {
        bf16_t* rowp = O + ((size_t)(u.pm * (FFH / 64) + 2 * u.pn + (wc >> 1)) * BM + wr * 64 + fr) * 64 + (wc & 1) * 32 + 8 * fq;
        float sv[2][4];
#pragma unroll
        for (int ai = 0; ai < 2; ++ai)
#pragma unroll
            for (int m = 0; m < 4; ++m) sv[ai][m] = tab[par * 256 + wr * 64 + fr + ai * HALF + m * 16];
#pragma unroll
        for (int ai = 0; ai < 2; ++ai) {
#pragma unroll
            for (int m = 0; m < 4; ++m) { const float rs = sv[ai][m], rsn = rs * -1.4426950408889634f, rs2 = rs * rs;
                f32x4 e0 = acc[ai][0][m][0] * rsn, e1 = acc[ai][0][m][1] * rsn;
#pragma unroll
                for (int j = 0; j < 4; ++j) { e0[j] = __builtin_amdgcn_exp2f(e0[j]); e1[j] = __builtin_amdgcn_exp2f(e1[j]); }
                e0 = e0 + 1.0f; e1 = e1 + 1.0f;
#pragma unroll
                for (int j = 0; j < 4; ++j) { e0[j] = __builtin_amdgcn_rcpf(e0[j]); e1[j] = __builtin_amdgcn_rcpf(e1[j]); }
                const f32x4 v0 = (acc[ai][0][m][0] * acc[ai][1][m][0]) * rs2 * e0, v1 = (acc[ai][0][m][1] * acc[ai][1][m][1]) * rs2 * e1;
                u32x4 w; w.x = cvt_pk_bf16(v0[0], v0[1]); w.y = cvt_pk_bf16(v0[2], v0[3]); w.z = cvt_pk_bf16(v1[0], v1[1]); w.w = cvt_pk_bf16(v1[2], v1[3]);
                *(PG8_GAS u32x4*)rowp = w; rowp += (size_t)16 * ldc; asm volatile("" : "+v"(rowp)); }
            rowp += (size_t)64 * ldc; asm volatile("" : "+v"(rowp)); }
    }
};
typedef __bf16 bf16x2_t __attribute__((ext_vector_type(2)));
__device__ __forceinline__ float dot2_bf16(unsigned w, float acc) { const bf16x2_t v = __builtin_bit_cast(bf16x2_t, w); return __builtin_amdgcn_fdot2_f32_bf16(v, v, acc, false); }
struct EpiResid16 {
    static constexpr bool PERM = true, AFTER_DRAIN = false, ROWTAB = false;
    const bf16_t* base; bf16_t* out; float scale; rss_t* rss_out;
    __device__ __forceinline__ void operator()(const f32x4 (&acc)[2][2][4][2], const Unit& u, int wr, int wc, int fr, int fq) const {
        const int row0 = u.pm * BM + wr * 64 + fr;
        const size_t off0 = ((size_t)(u.pm * 32 + 4 * u.pn + (wc >> 1)) * BM + wr * 64 + fr) * 64 + (wc & 1) * 32 + 8 * fq;
        const int l1 = (((fq ^ 1) << 4) | fr) << 2, l2 = (((fq ^ 2) << 4) | fr) << 2;
        u32x4 bs2[2][4][2];
#pragma unroll
        for (int ai = 0; ai < 2; ++ai)
#pragma unroll
            for (int m = 0; m < 4; ++m)
#pragma unroll
                for (int bj = 0; bj < 2; ++bj) bs2[ai][m][bj] = *(const PG8_GAS u32x4*)(base + off0 + (size_t)(ai * HALF + m * 16) * 64 + (size_t)bj * 2 * BM * 64);
        float ssv[2][4];
#pragma unroll
        for (int ai = 0; ai < 2; ++ai) {
#pragma unroll
            for (int m = 0; m < 4; ++m) {
                float ss = 0.f;
#pragma unroll
                for (int bj = 0; bj < 2; ++bj) { const u32x4 b4 = bs2[ai][m][bj];
                    f32x4 b0, b1; b0[0] = __uint_as_float(b4.x << 16); b0[1] = __uint_as_float(b4.x & 0xffff0000u); b0[2] = __uint_as_float(b4.y << 16); b0[3] = __uint_as_float(b4.y & 0xffff0000u);
                    b1[0] = __uint_as_float(b4.z << 16); b1[1] = __uint_as_float(b4.z & 0xffff0000u); b1[2] = __uint_as_float(b4.w << 16); b1[3] = __uint_as_float(b4.w & 0xffff0000u);
                    const f32x4 r0 = acc[ai][bj][m][0] * scale + b0, r1 = acc[ai][bj][m][1] * scale + b1;
                    u32x4 w; w.x = cvt_pk_bf16(r0[0], r0[1]); w.y = cvt_pk_bf16(r0[2], r0[3]); w.z = cvt_pk_bf16(r1[0], r1[1]); w.w = cvt_pk_bf16(r1[2], r1[3]);
                    *(PG8_GAS u32x4*)(out + off0 + (size_t)(ai * HALF + m * 16) * 64 + (size_t)bj * 2 * BM * 64) = w;
                    ss = dot2_bf16(w.x, ss); ss = dot2_bf16(w.y, ss); ss = dot2_bf16(w.z, ss); ss = dot2_bf16(w.w, ss); }
                ssv[ai][m] = ss;
            }
        }
#pragma unroll
        for (int ai = 0; ai < 2; ++ai)
#pragma unroll
            for (int m = 0; m < 4; ++m) ssv[ai][m] += __int_as_float(__builtin_amdgcn_ds_bpermute(l1, __float_as_int(ssv[ai][m])));
#pragma unroll
        for (int ai = 0; ai < 2; ++ai)
#pragma unroll
            for (int m = 0; m < 4; ++m) ssv[ai][m] += __int_as_float(__builtin_amdgcn_ds_bpermute(l2, __float_as_int(ssv[ai][m])));
        if (fq == 0) {
#pragma unroll
            for (int ai = 0; ai < 2; ++ai)
#pragma unroll
                for (int m = 0; m < 4; ++m) (void)__hip_atomic_fetch_add((PG8_GAS rss_t*)rss_out + row0 + ai * HALF + m * 16, (rss_t)(ssv[ai][m] * 1048576.0f + 0.5f), __ATOMIC_RELAXED, __HIP_MEMORY_SCOPE_AGENT);
        }
    }
};
struct EpiF32Tile {
    static constexpr bool PERM = false, AFTER_DRAIN = false, ROWTAB = false;
    float* C;
    __device__ __forceinline__ void operator()(const f32x4 (&acc)[2][2][4][2], const Unit& u, int wr, int wc, int fr, int fq) const {
        float* base = C + (size_t)(u.pm * BM + wr * 64 + fr) * 256 + wc * 32 + 4 * fq;
#pragma unroll
        for (int ai = 0; ai < 2; ++ai)
#pragma unroll
            for (int m = 0; m < 4; ++m) { float* rowp = base + (size_t)(ai * HALF + m * 16) * 256;
#pragma unroll
                for (int bj = 0; bj < 2; ++bj)
#pragma unroll
                    for (int n = 0; n < 2; ++n) *(f32x4*)(rowp + bj * HALF + n * 16) = acc[ai][bj][m][n]; }
    }
};
template <int KIND> struct EpiBf16K {
    static constexpr bool PERM = true, AFTER_DRAIN = false, ROWTAB = (KIND == 0);
    bf16_t* O; const float* cs; float scale; int mrows; const rss_t* rss; float* gat; const float* gbias; PG8_LAS float* tab;
    __device__ __forceinline__ void fill_table(int pm, int par, int tid) const { if (tid < 256) tab[par * 256 + tid] = rms_scale(rss, pm * BM + tid); }
    __device__ __forceinline__ void operator()(const f32x4 (&acc)[2][2][4][2], const Unit& u, int wr, int wc, int fr, int fq, int par = 0) const {
        bf16_t* base; int ldc; const float* csp = nullptr;
        if (KIND == 0) { ldc = 5376; base = O + (size_t)u.pm * BM * ldc + u.pn * BM; }
        else if (KIND == 1) { ldc = 512; const int h = u.pn >> 1; base = O + ((size_t)h * mrows + (size_t)u.pm * BM) * 512 + (u.pn & 1) * BM; }
        else if (KIND == 2) { ldc = 256; const int h = u.pm >> 1; base = O + ((size_t)(h * 16 + u.pn) * 512 + (size_t)(u.pm & 1) * BM) * 256; }
        else if (KIND == 3) { ldc = 2048; const int g = u.pm >> 7, pl = u.pm & 127; base = O + (size_t)pl * BM * 2048 + g * BM; csp = cs + g * BM; }
        else if (KIND == 4) { ldc = 2048; const int z = u.pm >> 3, pl = u.pm & 7, h = z >> 4, b = z & 15; base = O + ((size_t)b * 2048 + (size_t)pl * BM) * 2048 + h * 512 + u.pn * BM; }
        else if (KIND == 5) { ldc = 2048; const int h = u.pm >> 4, b = u.pm & 15; base = O + (size_t)(b * 4 + h) * BM * 2048 + u.pn * BM; }
        else { ldc = 1024; const int h = u.pm >> 3, np = u.pm & 7; base = O + ((size_t)u.pn * 2048 + (size_t)np * BM) * 1024 + h * BM; }
        const int row0 = wr * 64 + fr, col0 = wc * 32 + 8 * fq;
        float rsv[2][4];
#pragma unroll
        for (int ai = 0; ai < 2; ++ai)
#pragma unroll
            for (int m = 0; m < 4; ++m) rsv[ai][m] = (KIND == 0) ? scale * tab[par * 256 + row0 + ai * HALF + m * 16] : ((KIND == 1 && rss) ? scale * rms_scale(rss, u.pm * BM + row0 + ai * HALF + m * 16) : scale);
        if (KIND == 0 && u.pn == 20) {
            if (wc == 0 && fq == 0) { const f32x4 bi = *(const f32x4*)gbias, bf = *(const f32x4*)(gbias + 4);
#pragma unroll
                for (int ai = 0; ai < 2; ++ai)
#pragma unroll
                    for (int m = 0; m < 4; ++m) { const f32x4 li = acc[ai][0][m][0] * rsv[ai][m] + bi, xf = acc[ai][0][m][1] * rsv[ai][m] + bf; f32x4 lf;
#pragma unroll
                        for (int j = 0; j < 4; ++j) lf[j] = fminf(xf[j], 0.f) - log1pf(expf(-fabsf(xf[j])));
                        float* gp = gat + (size_t)(u.pm * BM + row0 + ai * HALF + m * 16) * 8; *(f32x4*)gp = li; *(f32x4*)(gp + 4) = lf; } }
            return; }
        bf16_t* rowp = base + (size_t)row0 * ldc + col0; size_t rstep = (size_t)ldc, bjstep = HALF;
        if (KIND == 3) {
            const int g = u.pm >> 7, pl = u.pm & 127; rowp = O + ((size_t)(pl * 32 + 4 * g + (wc >> 1)) * BM + row0) * 64 + (wc & 1) * 32 + 8 * fq; rstep = 64; bjstep = (size_t)2 * BM * 64; }
#pragma unroll
        for (int bj = 0; bj < 2; ++bj) {
            f32x4 s0 = (f32x4){1.f, 1.f, 1.f, 1.f}, s1 = s0;
            if (KIND == 3) { s0 = *(const f32x4*)(csp + col0 + bj * HALF); s1 = *(const f32x4*)(csp + col0 + bj * HALF + 4); }
            bf16_t* rp = rowp + bj * bjstep;
#pragma unroll
            for (int ai = 0; ai < 2; ++ai) {
#pragma unroll
                for (int m = 0; m < 4; ++m) { const f32x4 v0 = acc[ai][bj][m][0] * s0 * rsv[ai][m], v1 = acc[ai][bj][m][1] * s1 * rsv[ai][m];
                    u32x4 w; w.x = cvt_pk_bf16(v0[0], v0[1]); w.y = cvt_pk_bf16(v0[2], v0[3]); w.z = cvt_pk_bf16(v1[0], v1[1]); w.w = cvt_pk_bf16(v1[2], v1[3]);
                    *(PG8_GAS u32x4*)rp = w; rp += 16 * rstep; asm volatile("" : "+v"(rp)); }
                rp += 64 * rstep; asm volatile("" : "+v"(rp)); }
        }
    }
};

struct EpiSoftmaxP {
    static constexpr bool PERM = true, AFTER_DRAIN = false, ROWTAB = false;
    bf16_t* P; const rss_t* rss; PG8_LAS float* scr;
    __device__ __forceinline__ void operator()(f32x4 (&acc)[2][2][4][2], const Unit& u, int wr, int wc, int fr, int fq) const {
        const int l1 = (((fq ^ 1) << 4) | fr) << 2, l2 = (((fq ^ 2) << 4) | fr) << 2, rowb = wr * 64 + fr;
        unsigned wo_ = (unsigned)(rowb * 4 + wc) * 4u, ro_ = (unsigned)(rowb * 4) * 4u; asm volatile("" : "+v"(wo_), "+v"(ro_));
        PG8_LAS float* wb = (PG8_LAS float*)((PG8_LAS unsigned char*)scr + wo_);
        const PG8_LAS float* rb = (const PG8_LAS float*)((const PG8_LAS unsigned char*)scr + ro_);
#pragma unroll
        for (int ai = 0; ai < 2; ++ai)
#pragma unroll
            for (int m = 0; m < 4; ++m) { const int row = rowb + ai * HALF + m * 16; const float rs = rms_scale(rss, u.pm * BM + row); float mx = -3.0e38f;
#pragma unroll
                for (int bj = 0; bj < 2; ++bj)
#pragma unroll
                    for (int n = 0; n < 2; ++n) { const f32x4 v = acc[ai][bj][m][n] * rs; acc[ai][bj][m][n] = v; mx = fmaxf(mx, fmaxf(fmaxf(v[0], v[1]), fmaxf(v[2], v[3]))); }
                mx = fmaxf(mx, __int_as_float(__builtin_amdgcn_ds_bpermute(l1, __float_as_int(mx)))); mx = fmaxf(mx, __int_as_float(__builtin_amdgcn_ds_bpermute(l2, __float_as_int(mx))));
                if (fq == 0) wb[(ai * HALF + m * 16) * 4] = mx; }
        asm volatile("s_waitcnt lgkmcnt(0)" ::: "memory"); __builtin_amdgcn_s_barrier(); asm volatile("" ::: "memory");
#pragma unroll
        for (int ai = 0; ai < 2; ++ai)
#pragma unroll
            for (int m = 0; m < 4; ++m) { const f32x4 mv = *(const PG8_LAS f32x4*)(rb + (ai * HALF + m * 16) * 4);
                const float rmax = fmaxf(fmaxf(mv[0], mv[1]), fmaxf(mv[2], mv[3])) * 1.4426950408889634f; float sm = 0.f;
#pragma unroll
                for (int bj = 0; bj < 2; ++bj)
#pragma unroll
                    for (int n = 0; n < 2; ++n) { f32x4 e;
#pragma unroll
                        for (int j = 0; j < 4; ++j) e[j] = __builtin_amdgcn_exp2f(acc[ai][bj][m][n][j] * 1.4426950408889634f - rmax);
                        acc[ai][bj][m][n] = e; sm += (e[0] + e[1]) + (e[2] + e[3]); }
                sm += __int_as_float(__builtin_amdgcn_ds_bpermute(l1, __float_as_int(sm))); sm += __int_as_float(__builtin_amdgcn_ds_bpermute(l2, __float_as_int(sm)));
                if (fq == 0) wb[1024 + (ai * HALF + m * 16) * 4] = sm; }
        asm volatile("s_waitcnt lgkmcnt(0)" ::: "memory"); __builtin_amdgcn_s_barrier(); asm volatile("" ::: "memory");
        bf16_t* rp = P + ((size_t)(u.pm * 16 + 4 * u.pn + (wc >> 1)) * BM + rowb) * 64 + (wc & 1) * 32 + 8 * fq;
#pragma unroll
        for (int ai = 0; ai < 2; ++ai) {
#pragma unroll
            for (int m = 0; m < 4; ++m) { const f32x4 sv = *(const PG8_LAS f32x4*)(rb + 1024 + (ai * HALF + m * 16) * 4); const float inv = 1.0f / ((sv[0] + sv[1]) + (sv[2] + sv[3]));
#pragma unroll
                for (int bj = 0; bj < 2; ++bj) { const f32x4 v0 = acc[ai][bj][m][0] * inv, v1 = acc[ai][bj][m][1] * inv;
                    u32x4 w; w.x = cvt_pk_bf16(v0[0], v0[1]); w.y = cvt_pk_bf16(v0[2], v0[3]); w.z = cvt_pk_bf16(v1[0], v1[1]); w.w = cvt_pk_bf16(v1[2], v1[3]);
                    *(PG8_GAS u32x4*)(rp + (size_t)bj * 2 * BM * 64) = w; }
                rp += (size_t)16 * 64; asm volatile("" : "+v"(rp)); }
            rp += (size_t)64 * 64; asm volatile("" : "+v"(rp)); }
    }
};

template <class Epi, class Sched, bool ALIGN_EPI = false, bool SP2 = false, bool PEEL = false>
__device__ __forceinline__ void gemm_phase(PG8_LAS unsigned char* lds, const Gemm g, const Sched& S, const Epi& E, int tid_in) {
    int tid_ = tid_in; asm volatile("" : "+v"(tid_));
    const int tid = tid_, wid = __builtin_amdgcn_readfirstlane(tid >> 6), lane = tid & 63, wr = wid >> 2, wc = wid & 3, fr = lane & 15, fq = lane >> 4;
    int K_ = g.K; asm volatile("" : "+s"(K_));
    const int K = K_, nt = K / BK;
    unsigned voffA[2], voffB[2];
#pragma unroll
    for (int i = 0; i < 2; ++i) { int R, C; stage_rc(tid * 16 + i * 8192, R, C); const int Rb = Epi::PERM ? ((R & ~31) + perm32(R & 31)) : R;
        voffA[i] = (unsigned)(R * (g.ablk ? BK : K) + C) * 2u; voffB[i] = (unsigned)(Rb * (g.bblk ? BK : K) + C) * 2u; }
    const size_t kstep = (size_t)(BK * 2);
    const size_t hstep = (size_t)HALF * K * 2;
    const size_t tstep = 2 * hstep;
    const size_t kstepB = g.bblk ? (size_t)(BM * BK * 2) : kstep, hstepB = g.bblk ? (size_t)(HALF * BK * 2) : hstep;
    const size_t kstepA = g.ablk ? (size_t)(BM * BK * 2) : kstep, hstepA = g.ablk ? (size_t)(HALF * BK * 2) : hstep;
    const unsigned ldsw = (unsigned)wid * 1024u;
    const int aoff = lds_byte(wr * 64 + fr, fq * 8), boff = lds_byte(wc * 32 + fr, fq * 8);
#define PG8_SA(b, h) (((b) * 2 + (h)) * HTB)
#define PG8_SB(b, h) ((4 + (b) * 2 + (h)) * HTB)
#define PG8_STAGE(bufoff, gbase, voff) do { _Pragma("unroll") for (int _i = 0; _i < 2; ++_i) { asm volatile("" : "+v"((voff)[_i])); \
        __builtin_amdgcn_global_load_lds((const unsigned*)((const char*)(gbase) + (voff)[_i]), (PG8_LAS unsigned*)(lds + (bufoff) + ldsw + _i * 8192), 16, 0, 0); } } while (0)
#define PG8_LDA(dst, b, h) do { _Pragma("unroll") for (int m = 0; m < 4; ++m) _Pragma("unroll") for (int k = 0; k < 2; ++k) dst[m][k] = *(const PG8_LAS bf16x8*)(lds + PG8_SA(b, h) + aoff + m * 2048 + k * 1024); } while (0)
#define PG8_LDB(dst, b, h) do { _Pragma("unroll") for (int n = 0; n < 2; ++n) _Pragma("unroll") for (int k = 0; k < 2; ++k) dst[n][k] = *(const PG8_LAS bf16x8*)(lds + PG8_SB(b, h) + boff + n * 2048 + k * 1024); } while (0)
#define PG8_MMA(ai, bj, At, Bt) do { __builtin_amdgcn_s_setprio(1); _Pragma("unroll") for (int m = 0; m < 4; ++m) _Pragma("unroll") for (int n = 0; n < 2; ++n) _Pragma("unroll") for (int k = 0; k < 2; ++k) \
        acc[ai][bj][m][n] = __builtin_amdgcn_mfma_f32_16x16x32_bf16(Bt[n][k], At[m][k], acc[ai][bj][m][n], 0, 0, 0); __builtin_amdgcn_s_setprio(0); } while (0)
#define PG8_MMAZ(ZC, ai, bj, At, Bt) do { __builtin_amdgcn_s_setprio(1); _Pragma("unroll") for (int m = 0; m < 4; ++m) _Pragma("unroll") for (int n = 0; n < 2; ++n) _Pragma("unroll") for (int k = 0; k < 2; ++k) \
        acc[ai][bj][m][n] = __builtin_amdgcn_mfma_f32_16x16x32_bf16(Bt[n][k], At[m][k], ((ZC) && k == 0) ? (f32x4){0.f, 0.f, 0.f, 0.f} : acc[ai][bj][m][n], 0, 0, 0); __builtin_amdgcn_s_setprio(0); } while (0)
#define PG8_WAIT_V(n) asm volatile("s_waitcnt vmcnt(" #n ")" ::: "memory")
#define PG8_WAIT_L(n) asm volatile("s_waitcnt lgkmcnt(" #n ")" ::: "memory")
#define PG8_BAR __builtin_amdgcn_s_barrier()
#define PG8_SCHED __builtin_amdgcn_sched_barrier(0)
#define PG8_BIDX(u) ((size_t)((g.nMz ? ((u).pm / g.nMz) * g.nN : 0) + (u).pn))
#define PG8_KITER(ZC) do { \
            const bool last = (t == nt - 2); \
            const char* a1 = cA + (size_t)(t + 1) * kstepA; \
            const char* a2 = last ? nA : cA + (size_t)(t + 2) * kstepA; const char* b2 = last ? nB : cB + (size_t)(t + 2) * kstepB; \
            const char* a3 = a2 + kstepA; const char* b3 = b2 + kstepB; \
            if (last && has_next) S.a_ready(nxt); \
            if constexpr (Epi::ROWTAB) { if (last && has_next && nxt.pm != cur.pm) E.fill_table(nxt.pm, rtpar ^ 1, tid); } \
            PG8_LDB(B0, 0, 0); PG8_LDB(B1, 0, 1); PG8_SCHED; PG8_LDA(At, 0, 0); PG8_STAGE(PG8_SA(1, 1), a1 + hstepA, voffA); \
            PG8_WAIT_V(8); PG8_WAIT_L(0); PG8_BAR; PG8_MMAZ(ZC, 0, 0, At, B0); PG8_MMAZ(ZC, 0, 1, At, B1); PG8_BAR; PG8_SCHED; \
            PG8_LDA(At, 0, 1); PG8_STAGE(PG8_SB(0, 0), b2, voffB); PG8_STAGE(PG8_SB(0, 1), b2 + hstepB, voffB); PG8_STAGE(PG8_SA(0, 0), a2, voffA); \
            PG8_WAIT_V(8); PG8_WAIT_L(0); PG8_BAR; PG8_MMAZ(ZC, 1, 0, At, B0); PG8_MMAZ(ZC, 1, 1, At, B1); PG8_BAR; PG8_SCHED; \
            PG8_LDB(B0, 1, 0); PG8_LDB(B1, 1, 1); PG8_SCHED; PG8_LDA(At, 1, 0); PG8_STAGE(PG8_SA(0, 1), a2 + hstepA, voffA); \
            PG8_WAIT_V(8); PG8_WAIT_L(0); PG8_BAR; PG8_MMA(0, 0, At, B0); PG8_MMA(0, 1, At, B1); PG8_BAR; PG8_SCHED; \
            PG8_LDA(At, 1, 1); PG8_STAGE(PG8_SB(1, 0), b3, voffB); PG8_STAGE(PG8_SB(1, 1), b3 + hstepB, voffB); PG8_STAGE(PG8_SA(1, 0), a3, voffA); \
            PG8_WAIT_V(8); PG8_WAIT_L(0); PG8_BAR; PG8_MMA(1, 0, At, B0); PG8_MMA(1, 1, At, B1); PG8_BAR; PG8_SCHED; \
        } while (0)
    Unit cur, nxt; int ui = 0;
    if (!S.next(0, cur)) return;
#define PG8_ZERO_ACC() do { f16x4_t z_ = (f16x4_t){(_Float16)0, (_Float16)0, (_Float16)0, (_Float16)0}; asm volatile("" : "+v"(z_)); \
          \
        acc[0][0][0][0] = __builtin_amdgcn_mfma_f32_4x4x4f16(z_, z_, (f32x4){0.f, 0.f, 0.f, 0.f}, 4, 0, 0); acc[0][0][0][1] = __builtin_amdgcn_mfma_f32_4x4x4f16(z_, z_, (f32x4){0.f, 0.f, 0.f, 0.f}, 4, 1, 0); \
        acc[0][0][1][0] = __builtin_amdgcn_mfma_f32_4x4x4f16(z_, z_, (f32x4){0.f, 0.f, 0.f, 0.f}, 4, 2, 0); acc[0][0][1][1] = __builtin_amdgcn_mfma_f32_4x4x4f16(z_, z_, (f32x4){0.f, 0.f, 0.f, 0.f}, 4, 3, 0); \
        acc[0][0][2][0] = __builtin_amdgcn_mfma_f32_4x4x4f16(z_, z_, (f32x4){0.f, 0.f, 0.f, 0.f}, 4, 4, 0); acc[0][0][2][1] = __builtin_amdgcn_mfma_f32_4x4x4f16(z_, z_, (f32x4){0.f, 0.f, 0.f, 0.f}, 4, 5, 0); \
        acc[0][0][3][0] = __builtin_amdgcn_mfma_f32_4x4x4f16(z_, z_, (f32x4){0.f, 0.f, 0.f, 0.f}, 4, 6, 0); acc[0][0][3][1] = __builtin_amdgcn_mfma_f32_4x4x4f16(z_, z_, (f32x4){0.f, 0.f, 0.f, 0.f}, 4, 7, 0); \
        acc[0][1][0][0] = __builtin_amdgcn_mfma_f32_4x4x4f16(z_, z_, (f32x4){0.f, 0.f, 0.f, 0.f}, 4, 8, 0); acc[0][1][0][1] = __builtin_amdgcn_mfma_f32_4x4x4f16(z_, z_, (f32x4){0.f, 0.f, 0.f, 0.f}, 4, 9, 0); \
        acc[0][1][1][0] = __builtin_amdgcn_mfma_f32_4x4x4f16(z_, z_, (f32x4){0.f, 0.f, 0.f, 0.f}, 4, 10, 0); acc[0][1][1][1] = __builtin_amdgcn_mfma_f32_4x4x4f16(z_, z_, (f32x4){0.f, 0.f, 0.f, 0.f}, 4, 11, 0); \
        acc[0][1][2][0] = __builtin_amdgcn_mfma_f32_4x4x4f16(z_, z_, (f32x4){0.f, 0.f, 0.f, 0.f}, 4, 12, 0); acc[0][1][2][1] = __builtin_amdgcn_mfma_f32_4x4x4f16(z_, z_, (f32x4){0.f, 0.f, 0.f, 0.f}, 4, 13, 0); \
        acc[0][1][3][0] = __builtin_amdgcn_mfma_f32_4x4x4f16(z_, z_, (f32x4){0.f, 0.f, 0.f, 0.f}, 4, 14, 0); acc[0][1][3][1] = __builtin_amdgcn_mfma_f32_4x4x4f16(z_, z_, (f32x4){0.f, 0.f, 0.f, 0.f}, 4, 15, 0); \
        acc[1][0][0][0] = __builtin_amdgcn_mfma_f32_4x4x4f16(z_, z_, (f32x4){0.f, 0.f, 0.f, 0.f}, 4, 0, 1); acc[1][0][0][1] = __builtin_amdgcn_mfma_f32_4x4x4f16(z_, z_, (f32x4){0.f, 0.f, 0.f, 0.f}, 4, 1, 1); \
        acc[1][0][1][0] = __builtin_amdgcn_mfma_f32_4x4x4f16(z_, z_, (f32x4){0.f, 0.f, 0.f, 0.f}, 4, 2, 1); acc[1][0][1][1] = __builtin_amdgcn_mfma_f32_4x4x4f16(z_, z_, (f32x4){0.f, 0.f, 0.f, 0.f}, 4, 3, 1); \
        acc[1][0][2][0] = __builtin_amdgcn_mfma_f32_4x4x4f16(z_, z_, (f32x4){0.f, 0.f, 0.f, 0.f}, 4, 4, 1); acc[1][0][2][1] = __builtin_amdgcn_mfma_f32_4x4x4f16(z_, z_, (f32x4){0.f, 0.f, 0.f, 0.f}, 4, 5, 1); \
        acc[1][0][3][0] = __builtin_amdgcn_mfma_f32_4x4x4f16(z_, z_, (f32x4){0.f, 0.f, 0.f, 0.f}, 4, 6, 1); acc[1][0][3][1] = __builtin_amdgcn_mfma_f32_4x4x4f16(z_, z_, (f32x4){0.f, 0.f, 0.f, 0.f}, 4, 7, 1); \
        acc[1][1][0][0] = __builtin_amdgcn_mfma_f32_4x4x4f16(z_, z_, (f32x4){0.f, 0.f, 0.f, 0.f}, 4, 8, 1); acc[1][1][0][1] = __builtin_amdgcn_mfma_f32_4x4x4f16(z_, z_, (f32x4){0.f, 0.f, 0.f, 0.f}, 4, 9, 1); \
        acc[1][1][1][0] = __builtin_amdgcn_mfma_f32_4x4x4f16(z_, z_, (f32x4){0.f, 0.f, 0.f, 0.f}, 4, 10, 1); acc[1][1][1][1] = __builtin_amdgcn_mfma_f32_4x4x4f16(z_, z_, (f32x4){0.f, 0.f, 0.f, 0.f}, 4, 11, 1); \
        acc[1][1][2][0] = __builtin_amdgcn_mfma_f32_4x4x4f16(z_, z_, (f32x4){0.f, 0.f, 0.f, 0.f}, 4, 12, 1); acc[1][1][2][1] = __builtin_amdgcn_mfma_f32_4x4x4f16(z_, z_, (f32x4){0.f, 0.f, 0.f, 0.f}, 4, 13, 1); \
        acc[1][1][3][0] = __builtin_amdgcn_mfma_f32_4x4x4f16(z_, z_, (f32x4){0.f, 0.f, 0.f, 0.f}, 4, 14, 1); acc[1][1][3][1] = __builtin_amdgcn_mfma_f32_4x4x4f16(z_, z_, (f32x4){0.f, 0.f, 0.f, 0.f}, 4, 15, 1); } while (0)
    f32x4 acc[2][2][4][2];
    if constexpr (!(PEEL && SP2)) PG8_ZERO_ACC();
    bf16x8 At[4][2], B0[2][2], B1[2][2];
    const char* cA = (const char*)g.A + (size_t)cur.pm * tstep; const char* cB = (const char*)g.Bt + PG8_BIDX(cur) * tstep;
    S.a_ready(cur);
    int rtpar = 0;
    if constexpr (Epi::ROWTAB) E.fill_table(cur.pm, 0, tid);
    if constexpr (SP2) {
        PG8_STAGE(PG8_SB(0, 0), cB, voffB); PG8_STAGE(PG8_SB(0, 1), cB + hstepB, voffB); PG8_STAGE(PG8_SA(0, 0), cA, voffA); PG8_STAGE(PG8_SA(0, 1), cA + hstepA, voffA);
        if (wr == 1) PG8_BAR;
        PG8_WAIT_V(2); PG8_BAR;
        PG8_STAGE(PG8_SB(1, 0), cB + kstepB, voffB); PG8_STAGE(PG8_SA(1, 0), cA + kstepA, voffA); PG8_STAGE(PG8_SB(1, 1), cB + hstepB + kstepB, voffB);
        PG8_WAIT_V(6); PG8_BAR;
    } else {
        PG8_STAGE(PG8_SB(0, 0), cB, voffB); PG8_STAGE(PG8_SA(0, 0), cA, voffA); PG8_STAGE(PG8_SB(0, 1), cB + hstepB, voffB); PG8_STAGE(PG8_SA(0, 1), cA + hstepA, voffA);
        if (wr == 1) PG8_BAR;
        PG8_WAIT_V(4); PG8_BAR;
        PG8_STAGE(PG8_SB(1, 0), cB + kstepB, voffB); PG8_STAGE(PG8_SA(1, 0), cA + kstepA, voffA); PG8_STAGE(PG8_SB(1, 1), cB + hstepB + kstepB, voffB);
        PG8_WAIT_V(6); PG8_BAR;
    }
    for (;;) {
        const bool has_next = S.next(ui + 1, nxt);
        const char* nA = has_next ? (const char*)g.A + (size_t)nxt.pm * tstep : cA; const char* nB = has_next ? (const char*)g.Bt + PG8_BIDX(nxt) * tstep : cB;
        if constexpr (PEEL && SP2) { int t = 0; PG8_KITER(true); for (t = 2; t < nt; t += 2) PG8_KITER(false); } else
        for (int t = 0; t < nt; t += 2) {
            const bool last = (t == nt - 2);
            const char* a1 = cA + (size_t)(t + 1) * kstepA;
            const char* a2 = last ? nA : cA + (size_t)(t + 2) * kstepA; const char* b2 = last ? nB : cB + (size_t)(t + 2) * kstepB;
            const char* a3 = a2 + kstepA; const char* b3 = b2 + kstepB;
            if (last && has_next) S.a_ready(nxt);
            if constexpr (Epi::ROWTAB) { if (last && has_next && nxt.pm != cur.pm) E.fill_table(nxt.pm, rtpar ^ 1, tid); }
            if constexpr (SP2) {
            PG8_LDB(B0, 0, 0); PG8_LDB(B1, 0, 1); PG8_SCHED; PG8_LDA(At, 0, 0); PG8_STAGE(PG8_SA(1, 1), a1 + hstepA, voffA);
            PG8_WAIT_V(8); PG8_WAIT_L(0); PG8_BAR; PG8_MMA(0, 0, At, B0); PG8_MMA(0, 1, At, B1); PG8_BAR; PG8_SCHED;
            PG8_LDA(At, 0, 1); PG8_STAGE(PG8_SB(0, 0), b2, voffB); PG8_STAGE(PG8_SB(0, 1), b2 + hstepB, voffB); PG8_STAGE(PG8_SA(0, 0), a2, voffA);
            PG8_WAIT_V(8); PG8_WAIT_L(0); PG8_BAR; PG8_MMA(1, 0, At, B0); PG8_MMA(1, 1, At, B1); PG8_BAR; PG8_SCHED;
            PG8_LDB(B0, 1, 0); PG8_LDB(B1, 1, 1); PG8_SCHED; PG8_LDA(At, 1, 0); PG8_STAGE(PG8_SA(0, 1), a2 + hstepA, voffA);
            PG8_WAIT_V(8); PG8_WAIT_L(0); PG8_BAR; PG8_MMA(0, 0, At, B0); PG8_MMA(0, 1, At, B1); PG8_BAR; PG8_SCHED;
            PG8_LDA(At, 1, 1); PG8_STAGE(PG8_SB(1, 0), b3, voffB); PG8_STAGE(PG8_SB(1, 1), b3 + hstepB, voffB); PG8_STAGE(PG8_SA(1, 0), a3, voffA);
            PG8_WAIT_V(8); PG8_WAIT_L(0); PG8_BAR; PG8_MMA(1, 0, At, B0); PG8_MMA(1, 1, At, B1); PG8_BAR; PG8_SCHED;
            } else {
            PG8_LDB(B0, 0, 0); PG8_SCHED; PG8_LDA(At, 0, 0); PG8_STAGE(PG8_SA(1, 1), a1 + hstepA, voffA);
            PG8_WAIT_L(8); PG8_BAR; PG8_WAIT_L(0); PG8_MMA(0, 0, At, B0); PG8_BAR; PG8_SCHED;
            PG8_LDB(B1, 0, 1); PG8_STAGE(PG8_SB(0, 0), b2, voffB);
            PG8_BAR; PG8_WAIT_L(0); PG8_MMA(0, 1, At, B1); PG8_BAR;
            PG8_LDA(At, 0, 1); PG8_STAGE(PG8_SA(0, 0), a2, voffA);
            PG8_BAR; PG8_WAIT_L(0); PG8_MMA(1, 0, At, B0); PG8_BAR; PG8_SCHED;
            PG8_STAGE(PG8_SB(0, 1), b2 + hstepB, voffB);
            PG8_WAIT_V(6); PG8_BAR; PG8_MMA(1, 1, At, B1); PG8_BAR;
            PG8_LDB(B0, 1, 0); PG8_SCHED; PG8_LDA(At, 1, 0); PG8_STAGE(PG8_SA(0, 1), a2 + hstepA, voffA);
            PG8_WAIT_L(8); PG8_BAR; PG8_WAIT_L(0); PG8_MMA(0, 0, At, B0); PG8_BAR; PG8_SCHED;
            PG8_LDB(B1, 1, 1); PG8_STAGE(PG8_SB(1, 0), b3, voffB);
            PG8_BAR; PG8_WAIT_L(0); PG8_MMA(0, 1, At, B1); PG8_BAR;
            PG8_LDA(At, 1, 1); PG8_STAGE(PG8_SA(1, 0), a3, voffA);
            PG8_BAR; PG8_WAIT_L(0); PG8_MMA(1, 0, At, B0); PG8_BAR; PG8_SCHED;
            PG8_STAGE(PG8_SB(1, 1), b3 + hstepB, voffB);
            PG8_WAIT_V(6); PG8_BAR; PG8_MMA(1, 1, At, B1); PG8_BAR;
            }
        }
        if constexpr (ALIGN_EPI) { if (wr == 0) PG8_BAR; }
        { int le_; asm volatile("v_mbcnt_lo_u32_b32 %0, -1, 0\n\tv_mbcnt_hi_u32_b32 %0, -1, %0" : "=v"(le_)); const int fre = le_ & 15, fqe = le_ >> 4;
          if constexpr (Epi::ROWTAB) E(acc, cur, wr, wc, fre, fqe, rtpar); else E(acc, cur, wr, wc, fre, fqe); }
        S.done(cur);
        if (!has_next) break;
        if constexpr (!(PEEL && SP2)) PG8_ZERO_ACC();
        if constexpr (Epi::ROWTAB) { if (nxt.pm != cur.pm) rtpar ^= 1; }
        cur = nxt; cA = nA; cB = nB; ++ui;
        if constexpr (ALIGN_EPI) { if (wr == 1) PG8_BAR; }
    }
    PG8_WAIT_V(0);
    if constexpr (!ALIGN_EPI) { if (wr == 0) PG8_BAR; }
    PG8_BAR;
#undef PG8_SA
#undef PG8_SB
#undef PG8_STAGE
#undef PG8_LDA
#undef PG8_LDB
#undef PG8_MMA
#undef PG8_WAIT_V
#undef PG8_WAIT_L
#undef PG8_BAR
#undef PG8_SCHED
#undef PG8_BIDX
#undef PG8_KITER
#undef PG8_MMAZ
#undef PG8_ZERO_ACC
}
}

#ifndef PG8_SP2
#define PG8_SP2 true
#endif
#ifndef PG8_ALIGN
#define PG8_ALIGN true
#endif

constexpr int NWAVES = 8;
constexpr int NB = 16, SEQ = 2048, D = 2048, M = NB * SEQ, DEPTH = 4, FF = 5632, NMEM = 256, MMEM = NB * NMEM;
constexpr int DIN = 5128, DINM = 5120, ZP = 5376;
constexpr float EPS = 1e-6f;
constexpr int N_PH = 12;
constexpr int N_RSS = 18;

constexpr size_t MiB = 1u << 20;
constexpr size_t WS_CTL = 0, WS_RSS = 1 * MiB, CTL_ZERO_BYTES = 8 * MiB;
static_assert(WS_RSS + (size_t)N_RSS * M * 8 <= CTL_ZERO_BYTES, "rss inside the memset region");
constexpr size_t WS_H    = 8 * MiB;
constexpr size_t WS_U    = WS_H + 256 * MiB;
constexpr size_t WS_BIG  = WS_U + 128 * MiB;
constexpr size_t WS_X1   = WS_BIG + 352 * MiB;
constexpr size_t WS_X2   = WS_X1 + 128 * MiB;
constexpr size_t WS_HM   = WS_X2 + 64 * MiB;
constexpr size_t WS_GAT  = WS_HM + 64 * MiB;
constexpr size_t WS_KB   = WS_GAT + 1 * MiB;
constexpr size_t WS_VT   = WS_KB + 16 * MiB;
constexpr size_t WS_MEMN = WS_VT + 16 * MiB;
constexpr size_t WS_WGU1 = WS_MEMN + 16 * MiB;
constexpr size_t WS_WD1  = WS_WGU1 + 44 * MiB;
constexpr size_t WS_WGU2 = WS_WD1 + 22 * MiB;
constexpr size_t WS_WD2  = WS_WGU2 + 44 * MiB;
constexpr size_t WS_WIN  = WS_WD2 + 22 * MiB;
constexpr size_t WS_WPOOL= WS_WIN + 21 * MiB;
constexpr size_t WS_WOUT = WS_WPOOL + 1 * MiB;
constexpr size_t WS_WQ   = WS_WOUT + 8 * MiB;
constexpr size_t WS_WKV  = WS_WQ + 8 * MiB;
constexpr size_t WS_WO   = WS_WKV + 16 * MiB;
constexpr size_t WS_END  = WS_WO + 8 * MiB;
constexpr size_t WS_GT = WS_H + 128 * MiB, WS_VWT = WS_H + 192 * MiB;
constexpr int CW_TMO = 0, CW_BAR = 4096, CW_SYNC = 16384;

constexpr int RING_OFF = 0, RING_BYTES = 131072;
constexpr int LDSCTL_OFF = RING_BYTES, MISC_OFF = 147456 - 128;
constexpr int LDS_BYTES = 147456;

#define GAS __attribute__((address_space(1)))
#define LAS __attribute__((address_space(3)))
typedef unsigned short bf16;
typedef unsigned v4u __attribute__((ext_vector_type(4)));
typedef unsigned v2u __attribute__((ext_vector_type(2)));
typedef unsigned u32x4v __attribute__((ext_vector_type(4)));
typedef float f32x4 __attribute__((ext_vector_type(4)));
typedef GAS unsigned gu32;
#define RLX_AGENT __ATOMIC_RELAXED, __HIP_MEMORY_SCOPE_AGENT
#define LDS_WAIT() asm volatile("s_waitcnt lgkmcnt(0)" ::: "memory")
__device__ __forceinline__ unsigned pk2(float lo, float hi) { return pg8::cvt_pk_bf16(lo, hi); }
__device__ __forceinline__ float bflo(unsigned w) { return __uint_as_float(w << 16); }
__device__ __forceinline__ float bfhi(unsigned w) { return __uint_as_float(w & 0xffff0000u); }
__device__ __forceinline__ size_t h16_off(int m, int c) { return ((size_t)((m >> 8) * 32 + (c >> 6)) * 256 + (m & 255)) * 64 + (c & 63); }

#define XB_TMO      128
#define XB_XCNT(j)  (256  + 64 * (j))
#define XB_XSUB(j)  (1280 + 64 * (j))
#define XB_XGEN(j)  (2304 + 64 * (j))
#define XB_TOP      3328
#define XB_TOPGEN   3392
#define XCD_BAR_WORDS 3456
#define XB_SPIN_CAP (1u << 18)

__device__ __forceinline__ unsigned xb_ld(unsigned* p)              { return __hip_atomic_load(p, __ATOMIC_RELAXED, __HIP_MEMORY_SCOPE_AGENT); }
__device__ __forceinline__ unsigned xb_add(unsigned* p, unsigned v) { return __hip_atomic_fetch_add(p, v, __ATOMIC_RELAXED, __HIP_MEMORY_SCOPE_AGENT); }
__device__ __forceinline__ unsigned xb_xcc_id() { return (unsigned)__builtin_amdgcn_s_getreg((3 << 11) | 20) & 0xFu; }
#define XB_SPIN(cond, bar) do { unsigned _sp = 0; while (cond) { __builtin_amdgcn_s_sleep(1); \
    if ((++_sp & 255u) == 0u) { if (xb_ld(&(bar)[XB_TMO])) break; if (_sp > XB_SPIN_CAP) { atomicAdd(&(bar)[XB_TMO], 1u); break; } } } } while (0)

struct XcdBarrier { unsigned* bar; unsigned x; volatile LAS unsigned* st; };

__device__ __forceinline__ XcdBarrier xcd_barrier_post(unsigned* bar, volatile LAS unsigned* st) {
    XcdBarrier b; b.bar = bar; b.x = xb_xcc_id(); b.st = st;
    if (threadIdx.x == 0) (void)xb_add(&bar[XB_XCNT(b.x)], 1u);
    return b;
}
__device__ __forceinline__ void xcd_barrier_complete(unsigned* bar, unsigned x, unsigned& nloc, unsigned& nx) {
    const unsigned G = gridDim.x * gridDim.y * gridDim.z;
    unsigned sum, cnt, mine, sp = 0u;
    for (;;) {
        sum = 0u; cnt = 0u; mine = 0u;
#pragma unroll
        for (unsigned j = 0; j < 16; ++j) { const unsigned c = xb_ld(&bar[XB_XCNT(j)]); sum += c; cnt += (c > 0u) ? 1u : 0u; mine = (j == x) ? c : mine; }
        if (sum == G) break;
        __builtin_amdgcn_s_sleep(1);
        if ((++sp & 255u) == 0u) { if (xb_ld(&bar[XB_TMO])) break; if (sp > XB_SPIN_CAP) { atomicAdd(&bar[XB_TMO], 1u); break; } }
    }
    nloc = mine > 0u ? mine : 1u; nx = cnt > 0u ? cnt : 1u;
}
__device__ __forceinline__ void xcd_barrier(const XcdBarrier& b, int tid) {
    asm volatile("s_waitcnt vmcnt(0)" ::: "memory");
    __syncthreads();
    if (tid == 0) {
        unsigned* bar = b.bar;
        __builtin_amdgcn_s_waitcnt(0);
        unsigned nloc = b.st[0], nx = b.st[1];
        if (nloc == 0u) { xcd_barrier_complete(bar, b.x, nloc, nx); b.st[0] = nloc; b.st[1] = nx; }
        const unsigned old = xb_add(&bar[XB_XSUB(b.x)], 1u);
        const unsigned gen = old / nloc;
        if (old + 1u == (gen + 1u) * nloc) {
            __builtin_amdgcn_fence(__ATOMIC_RELEASE, "agent");
            asm volatile("s_waitcnt vmcnt(0)" ::: "memory");
            const unsigned og = xb_add(&bar[XB_TOP], 1u);
            const unsigned tg = og / nx;
            if (og + 1u == (tg + 1u) * nx) xb_add(&bar[XB_TOPGEN], 1u);
            else XB_SPIN(xb_ld(&bar[XB_TOPGEN]) == tg, bar);
            __builtin_amdgcn_fence(__ATOMIC_ACQUIRE, "agent");
            xb_add(&bar[XB_XGEN(b.x)], 1u);
            asm volatile("s_waitcnt vmcnt(0)" ::: "memory");
        } else {
            XB_SPIN(xb_ld(&bar[XB_XGEN(b.x)]) == gen, bar);
            __builtin_amdgcn_fence(__ATOMIC_ACQUIRE, "agent");
            asm volatile("s_waitcnt vmcnt(0)" ::: "memory");
        }
    }
    __syncthreads();
}

__device__ __forceinline__ float shfl_xor_l(float v, int m, int lane) { return __int_as_float(__builtin_amdgcn_ds_bpermute((lane ^ m) << 2, __float_as_int(v))); }
__device__ __forceinline__ float shfl_up_l(float v, int o, int lane) { return __int_as_float(__builtin_amdgcn_ds_bpermute((lane - o) << 2, __float_as_int(v))); }
__device__ __forceinline__ float wave_sum(float v, int lane) {
#pragma unroll
    for (int o = 1; o < 64; o <<= 1) v += shfl_xor_l(v, o, lane);
    return v;
}
__device__ __forceinline__ float wave_max(float v, int lane) {
#pragma unroll
    for (int o = 1; o < 64; o <<= 1) v = fmaxf(v, shfl_xor_l(v, o, lane));
    return v;
}
__device__ __forceinline__ void transpose_item(const float* W, int ldw, int K, int N, bf16* WT, int mode, LAS float* scr, int item, int lane, const float* gain = nullptr) {
    const int nblk = N / 32, kb = item / nblk, nb = item % nblk, k0 = 64 * kb, n0 = 32 * nb;
    const int r0 = (mode == 0) ? n0 : ((n0 >> 7) * 256 + (mode == 2 ? 128 : 0) + (n0 & 127));
#pragma unroll 8
    for (int i = 0; i < 32; ++i) { const int kk = 2 * i + (lane >> 5); scr[kk * 33 + (lane & 31)] = W[(size_t)(k0 + kk) * ldw + n0 + (lane & 31)]; }
    LDS_WAIT(); asm volatile("" ::: "memory");
    const int c = lane & 7;
    f32x4 ga = (f32x4){1.f, 1.f, 1.f, 1.f}, gb = ga; if (gain) { ga = *(const f32x4*)(gain + k0 + 8 * c); gb = *(const f32x4*)(gain + k0 + 8 * c + 4); }
#pragma unroll
    for (int j = 0; j < 4; ++j) { const int n = (lane >> 3) + 8 * j; const LAS float* s = scr + (8 * c) * 33 + n;
        v4u o; o.x = pk2(s[0 * 33] * ga.x, s[1 * 33] * ga.y); o.y = pk2(s[2 * 33] * ga.z, s[3 * 33] * ga.w); o.z = pk2(s[4 * 33] * gb.x, s[5 * 33] * gb.y); o.w = pk2(s[6 * 33] * gb.z, s[7 * 33] * gb.w);
        *(GAS v4u*)(WT + (size_t)(r0 + n) * K + k0 + 8 * c) = o; }
    LDS_WAIT(); asm volatile("" ::: "memory");
}
struct CvtDesc { const float* W; int ldw, K, N; bf16* WT; int mode; const float* gain; int tile; };
__device__ __forceinline__ void cvt_load(const CvtDesc& d, f32x4 (&v)[16], int tid) {
    const int ntn = d.N >> 8, kb = d.tile / ntn, nb = d.tile - kb * ntn, k0 = kb * 128, n0 = nb * 256;
#pragma unroll
    for (int i = 0; i < 16; ++i) { const int idx = tid + 512 * i, k = idx >> 6, c4 = idx & 63; v[i] = __builtin_nontemporal_load((const GAS f32x4*)(d.W + (size_t)(k0 + k) * d.ldw + n0 + 4 * c4)); }
}
__device__ __forceinline__ void cvt_to_lds(const CvtDesc& d, const f32x4 (&v)[16], LAS unsigned char* lds, int tid) {
    const int ntn = d.N >> 8, kb = d.tile / ntn, k0 = kb * 128;
#pragma unroll
    for (int i = 0; i < 16; ++i) { const int idx = tid + 512 * i, k = idx >> 6, c4 = idx & 63; f32x4 x = v[i];
        if (d.gain) x = x * d.gain[k0 + k];
        v2u w; w.x = pk2(x.x, x.y); w.y = pk2(x.z, x.w);
        *(LAS v2u*)(lds + k * 520 + c4 * 8) = w; }
}
__device__ __forceinline__ void cvt_store(const CvtDesc& d, const LAS unsigned char* lds, int tid) {
    const int ntn = d.N >> 8, kb = d.tile / ntn, nb = d.tile - kb * ntn, k0 = kb * 128, n0 = nb * 256;
    const int n = tid & 255, half = tid >> 8, ng = n0 + n;
    const int drow = (d.mode == 0) ? ng : ((ng >> 7) * 256 + (d.mode == 2 ? 128 : 0) + (ng & 127));
    bf16* dst = (d.mode == 3) ? d.WT + ((size_t)(k0 >> 9) * 2048 + ng) * 512 + (k0 & 511)
                              : d.WT + ((size_t)((drow >> 8) * (d.K >> 6) + (k0 >> 6)) * 256 + (drow & 255)) * 64;
    const int kcs = (d.mode == 3) ? 8 : 8, kts = (d.mode == 3) ? 0 : 256 * 64 - 64;
#pragma unroll 2
    for (int j = 0; j < 8; ++j) { const int kc = 2 * j + half; const LAS unsigned short* sp = (const LAS unsigned short*)(lds + (8 * kc) * 520 + n * 2);
        v4u o; o.x = (unsigned)sp[0] | ((unsigned)sp[260] << 16); o.y = (unsigned)sp[2 * 260] | ((unsigned)sp[3 * 260] << 16); o.z = (unsigned)sp[4 * 260] | ((unsigned)sp[5 * 260] << 16); o.w = (unsigned)sp[6 * 260] | ((unsigned)sp[7 * 260] << 16);
        *(GAS v4u*)(dst + kcs * kc + (kc >> 3) * kts) = o; }
}
__device__ __forceinline__ void rms_row(const float* xrow, const float* g, bf16* orow, int lane, f32x4 (&v)[8]) {
    const GAS f32x4* xr = (const GAS f32x4*)xrow + lane;
    float s = 0.f;
#pragma unroll
    for (int j = 0; j < 8; ++j) { v[j] = xr[64 * j]; s += (v[j].x * v[j].x + v[j].y * v[j].y) + (v[j].z * v[j].z + v[j].w * v[j].w); }
    const float r = 1.0f / sqrtf(wave_sum(s, lane) * (1.f / 2048.f) + EPS);
    const GAS f32x4* gr = (const GAS f32x4*)g + lane;
    GAS v2u* o8 = (GAS v2u*)orow + lane;
#pragma unroll
    for (int j = 0; j < 8; ++j) { const f32x4 gv = gr[64 * j]; v[j] = v[j] * r * gv; v2u w; w.x = pk2(v[j].x, v[j].y); w.y = pk2(v[j].z, v[j].w); o8[64 * j] = w; }
}


#ifndef MLSTM_NAIVE
#define MLSTM_NAIVE 0
#endif
typedef short ml_bf16x8 __attribute__((ext_vector_type(8)));
typedef short ml_s16x4 __attribute__((ext_vector_type(4)));
constexpr int ML_QS = 0, ML_KS = 33792, ML_VS = 67584, ML_VW = 76800, ML_WS = 86016, ML_XCH = 95232, ML_NS = 111616, ML_SC = 112640, ML_GA = 114688, ML_GB = 122880, ML_GP = 131072, ML_GM = 139264, ML_PQ = 528, ML_PV = 144;
constexpr int SC_A2 = 0, SC_M2 = 64, SC_IW = 128, SC_NFL = 192, SC_WS = 256, SC_DEN = 320, SC_DECAY = 384;
static_assert(ML_GM + 256 <= LDS_BYTES - 128, "mLSTM LDS map below the barrier words");
__device__ __forceinline__ ml_bf16x8 ml_tr_read2(const LAS unsigned char* p0, const LAS unsigned char* p1) {
    const ml_s16x4 lo = __builtin_amdgcn_ds_read_tr16_b64_v4i16((LAS ml_s16x4*)p0), hi = __builtin_amdgcn_ds_read_tr16_b64_v4i16((LAS ml_s16x4*)p1);
    return __builtin_shufflevector(lo, hi, 0, 1, 2, 3, 4, 5, 6, 7);
}
__device__ __forceinline__ unsigned ml_pk2n(float lo, float hi) { unsigned r; asm volatile("v_cvt_pk_bf16_f32 %0, %1, %2\n\ts_nop 1" : "=v"(r) : "v"(lo), "v"(hi)); return r; }
#define ML_EXP(x) __builtin_amdgcn_exp2f((x) * 1.4426950408889634f)
#define ML_MFMA(a, b, c) __builtin_amdgcn_mfma_f32_16x16x32_bf16((a), (b), (c), 0, 0, 0)
__device__ __forceinline__ void mlstm_item(LAS unsigned char* lds, const bf16* QCp, const bf16* KCp, const bf16* Zp, const float* GATp, bf16* HMp, int item, int tid) {
    const int lane = tid & 63, w = __builtin_amdgcn_readfirstlane(tid >> 6), g = lane >> 4, i = lane & 15, dvb = w & 3, dkh = w >> 2;
    const int b = item >> 4, h = (item >> 2) & 3, jv = item & 3;
    LAS float* sc = (LAS float*)(lds + ML_SC); LAS float* nS = (LAS float*)(lds + ML_NS);
    LAS float* gA = (LAS float*)(lds + ML_GA); LAS float* gB = (LAS float*)(lds + ML_GB); LAS float* gP = (LAS float*)(lds + ML_GP); LAS float* gM = (LAS float*)(lds + ML_GM);
    f32x4 Cacc[8];
#pragma unroll
    for (int x = 0; x < 8; ++x) Cacc[x] = (f32x4){0.f, 0.f, 0.f, 0.f};
    if (tid < 256) nS[tid] = 0.f;
    const size_t tokb = (size_t)b * SEQ;
#pragma unroll 1
    for (int cc = w; cc < SEQ / 64; cc += 8) {
        const size_t t = tokb + (size_t)cc * 64 + lane; const float li = GATp[t * 8 + h], lf = GATp[t * 8 + 4 + h];
        float bc = lf;
#pragma unroll
        for (int o = 1; o < 64; o <<= 1) { const float y = shfl_up_l(bc, o, lane); if (lane >= o) bc += y; }
        const float a = li - bc; float pm = a;
#pragma unroll
        for (int o = 1; o < 64; o <<= 1) { const float y = shfl_up_l(pm, o, lane); if (lane >= o) pm = fmaxf(pm, y); }
        gA[cc * 64 + lane] = a; gB[cc * 64 + lane] = bc; gP[cc * 64 + lane] = pm;
    }
    __syncthreads();
    if (tid == 0) { float m = 0.f; gM[0] = 0.f;
        for (int cc = 0; cc < SEQ / 64; ++cc) { m = gB[cc * 64 + 63] + fmaxf(m, gP[cc * 64 + 63]); gM[cc + 1] = m; } }
    v4u qreg[4], kreg[4], vreg;
    const unsigned qoff = (unsigned)((tid >> 5) * 2048 + (tid & 31) * 16), voff = (unsigned)((tid >> 3) * (ZP * 2) + (tid & 7) * 16);
#define ML_FETCH(c) do { const size_t t0_ = tokb + (size_t)(c) * 64; unsigned qo_ = qoff, vo_ = voff; asm volatile("" : "+v"(qo_), "+v"(vo_)); \
        const char* qb_ = (const char*)(QCp + t0_ * 1024 + h * 256); const char* kb_ = (const char*)(KCp + t0_ * 1024 + h * 256); \
        _Pragma("unroll") for (int i4 = 0; i4 < 4; ++i4) { qreg[i4] = *(const GAS v4u*)(qb_ + (size_t)i4 * 32768 + qo_); kreg[i4] = *(const GAS v4u*)(kb_ + (size_t)i4 * 32768 + qo_); } \
        vreg = *(const GAS v4u*)((const char*)(Zp + t0_ * ZP + 3072 + h * 256 + jv * 64) + vo_); } while (0)
    ML_FETCH(0);
    __syncthreads();
    for (int c = 0; c < SEQ / 64; ++c) {
        const size_t t0 = tokb + (size_t)c * 64;
        unsigned trb_ = (unsigned)((8 * g + (i >> 2)) * ML_PV + (16 * dvb + 4 * (i & 3)) * 2), trk_ = (unsigned)(ML_KS + (8 * g + (i >> 2)) * ML_PQ + (128 * dkh + 4 * (i & 3)) * 2);
        asm volatile("" : "+v"(trb_), "+v"(trk_));
        const LAS unsigned char* trb = lds + trb_; const LAS unsigned char* trk = lds + trk_;
#pragma unroll
        for (int i4 = 0; i4 < 4; ++i4) { const int p = tid + 512 * i4; *(LAS v4u*)(lds + ML_QS + (p >> 5) * ML_PQ + (p & 31) * 16) = qreg[i4]; *(LAS v4u*)(lds + ML_KS + (p >> 5) * ML_PQ + (p & 31) * 16) = kreg[i4]; }
        if (w == 0) {
            const float mc = gM[c], a = gA[c * 64 + lane], bc = gB[c * 64 + lane], Mt = fmaxf(mc, gP[c * 64 + lane]), M63 = fmaxf(mc, gP[c * 64 + 63]);
            sc[SC_A2 + lane] = a * 1.4426950408889634f; sc[SC_M2 + lane] = Mt * 1.4426950408889634f; sc[SC_IW + lane] = ML_EXP(mc - Mt); sc[SC_NFL + lane] = ML_EXP(-(bc + Mt)); sc[SC_WS + lane] = ML_EXP(a - M63);
            if (lane == 0) sc[SC_DECAY] = ML_EXP(mc - M63);
        }
        __syncthreads();
        { const int row = tid >> 3, c8 = tid & 7; const float wsr = sc[SC_WS + row];
          *(LAS v4u*)(lds + ML_VS + row * ML_PV + c8 * 16) = vreg;
          v4u o; o.x = pk2(bflo(vreg.x) * wsr, bfhi(vreg.x) * wsr); o.y = pk2(bflo(vreg.y) * wsr, bfhi(vreg.y) * wsr); o.z = pk2(bflo(vreg.z) * wsr, bfhi(vreg.z) * wsr); o.w = pk2(bflo(vreg.w) * wsr, bfhi(vreg.w) * wsr);
          *(LAS v4u*)(lds + ML_VW + row * ML_PV + c8 * 16) = o; }
        {
            const int tb1 = w >> 1, sb0 = 2 * (w & 1);
            f32x4 S0 = (f32x4){0.f, 0.f, 0.f, 0.f}, S1 = S0;
#pragma unroll
            for (int kk = 0; kk < 8; ++kk) {
                const ml_bf16x8 af = *(const LAS ml_bf16x8*)(lds + ML_QS + (16 * tb1 + i) * ML_PQ + (32 * kk + 8 * g) * 2);
                const ml_bf16x8 b0 = *(const LAS ml_bf16x8*)(lds + ML_KS + (16 * sb0 + i) * ML_PQ + (32 * kk + 8 * g) * 2);
                const ml_bf16x8 b1 = *(const LAS ml_bf16x8*)(lds + ML_KS + (16 * (sb0 + 1) + i) * ML_PQ + (32 * kk + 8 * g) * 2);
                S0 = ML_MFMA(af, b0, S0); S1 = ML_MFMA(af, b1, S1);
            }
            const f32x4 M2v = *(const LAS f32x4*)(sc + SC_M2 + 16 * tb1 + 4 * g);
            const float a20 = sc[SC_A2 + 16 * sb0 + i], a21 = sc[SC_A2 + 16 * (sb0 + 1) + i];
#pragma unroll
            for (int r = 0; r < 4; ++r) { const int t = 16 * tb1 + 4 * g + r, s0 = 16 * sb0 + i, s1 = s0 + 16;
                const float w0 = (s0 <= t) ? __builtin_amdgcn_exp2f(fminf(a20 - M2v[r], 0.f)) * S0[r] : 0.f;
                const float w1 = (s1 <= t) ? __builtin_amdgcn_exp2f(fminf(a21 - M2v[r], 0.f)) * S1[r] : 0.f;
                *(LAS unsigned short*)(lds + ML_WS + t * ML_PV + s0 * 2) = (unsigned short)(pk2(w0, 0.f) & 0xffffu);
                *(LAS unsigned short*)(lds + ML_WS + t * ML_PV + s1 * 2) = (unsigned short)(pk2(w1, 0.f) & 0xffffu); }
        }
        f32x4 P0 = (f32x4){0.f, 0.f, 0.f, 0.f}, P1 = P0, P2 = P0, P3 = P0;
#pragma unroll
        for (int kk = 0; kk < 4; ++kk) {
            u32x4v bw; bw.x = ml_pk2n(Cacc[2 * kk][0], Cacc[2 * kk][1]); bw.y = ml_pk2n(Cacc[2 * kk][2], Cacc[2 * kk][3]); bw.z = ml_pk2n(Cacc[2 * kk + 1][0], Cacc[2 * kk + 1][1]); bw.w = ml_pk2n(Cacc[2 * kk + 1][2], Cacc[2 * kk + 1][3]);
            const ml_bf16x8 bfr = __builtin_bit_cast(ml_bf16x8, bw);
            const int dkb = 128 * dkh + 32 * kk;
#define ML_QFRAG(tb) ({ const v2u lo_ = *(const LAS v2u*)(lds + ML_QS + (16 * (tb) + i) * ML_PQ + (dkb + 4 * g) * 2), hi_ = *(const LAS v2u*)(lds + ML_QS + (16 * (tb) + i) * ML_PQ + (dkb + 16 + 4 * g) * 2); \
            u32x4v q_; q_.x = lo_.x; q_.y = lo_.y; q_.z = hi_.x; q_.w = hi_.y; __builtin_bit_cast(ml_bf16x8, q_); })
            P0 = ML_MFMA(ML_QFRAG(0), bfr, P0); P1 = ML_MFMA(ML_QFRAG(1), bfr, P1); P2 = ML_MFMA(ML_QFRAG(2), bfr, P2); P3 = ML_MFMA(ML_QFRAG(3), bfr, P3);
#undef ML_QFRAG
        }
        __syncthreads();
        if (c + 1 < SEQ / 64) ML_FETCH(c + 1);
        f32x4 H0 = (f32x4){0.f, 0.f, 0.f, 0.f}, H1 = H0;
#pragma unroll
        for (int kk = 0; kk < 2; ++kk) {
            const LAS unsigned char* va = trb + ML_VS + 32 * kk * ML_PV;
            const ml_bf16x8 bfr = ml_tr_read2(va, va + 4 * ML_PV);
            const ml_bf16x8 a0 = *(const LAS ml_bf16x8*)(lds + ML_WS + (16 * (2 * dkh) + i) * ML_PV + (32 * kk + 8 * g) * 2);
            const ml_bf16x8 a1 = *(const LAS ml_bf16x8*)(lds + ML_WS + (16 * (2 * dkh + 1) + i) * ML_PV + (32 * kk + 8 * g) * 2);
            H0 = ML_MFMA(a0, bfr, H0); H1 = ML_MFMA(a1, bfr, H1);
        }
        { const int t = tid >> 3, p = tid & 7; float qn = 0.f;
#pragma unroll
          for (int e = 0; e < 4; ++e) { const v4u qq = *(const LAS v4u*)(lds + ML_QS + t * ML_PQ + (32 * p + 8 * e) * 2); const f32x4 n0 = *(const LAS f32x4*)(nS + 32 * p + 8 * e), n1 = *(const LAS f32x4*)(nS + 32 * p + 8 * e + 4);
              qn += (bflo(qq.x) * n0.x + bfhi(qq.x) * n0.y) + (bflo(qq.y) * n0.z + bfhi(qq.y) * n0.w) + (bflo(qq.z) * n1.x + bfhi(qq.z) * n1.y) + (bflo(qq.w) * n1.z + bfhi(qq.w) * n1.w); }
          const v4u ww = *(const LAS v4u*)(lds + ML_WS + t * ML_PV + 8 * p * 2);
          float d = sc[SC_IW + t] * qn + ((bflo(ww.x) + bfhi(ww.x)) + (bflo(ww.y) + bfhi(ww.y)) + (bflo(ww.z) + bfhi(ww.z)) + (bflo(ww.w) + bfhi(ww.w)));
          d += shfl_xor_l(d, 1, lane); d += shfl_xor_l(d, 2, lane); d += shfl_xor_l(d, 4, lane);
          if (p == 0) sc[SC_DEN + t] = d; }
        { const f32x4 x0 = dkh ? P0 : P2, x1 = dkh ? P1 : P3;
          *(LAS f32x4*)(lds + ML_XCH + ((w * 2 + 0) * 64 + lane) * 16) = x0; *(LAS f32x4*)(lds + ML_XCH + ((w * 2 + 1) * 64 + lane) * 16) = x1; }
        __syncthreads();
        { const f32x4 o0 = dkh ? P2 : P0, o1 = dkh ? P3 : P1;
          const f32x4 p0 = *(const LAS f32x4*)(lds + ML_XCH + (((w ^ 4) * 2 + 0) * 64 + lane) * 16), p1 = *(const LAS f32x4*)(lds + ML_XCH + (((w ^ 4) * 2 + 1) * 64 + lane) * 16);
#pragma unroll
          for (int x = 0; x < 2; ++x) { const int tb = 2 * dkh + x; const f32x4 own = x ? o1 : o0, oth = x ? p1 : p0, hin = x ? H1 : H0;
              const f32x4 iwv = *(const LAS f32x4*)(sc + SC_IW + 16 * tb + 4 * g), dnv = *(const LAS f32x4*)(sc + SC_DEN + 16 * tb + 4 * g), nfv = *(const LAS f32x4*)(sc + SC_NFL + 16 * tb + 4 * g);
#pragma unroll
              for (int r = 0; r < 4; ++r) { const float num = iwv[r] * (own[r] + oth[r]) + hin[r]; const float hv = num / fmaxf(fabsf(dnv[r]), nfv[r]);
                  HMp[(t0 + 16 * tb + 4 * g + r) * 1024 + h * 256 + jv * 64 + 16 * dvb + i] = (bf16)(pk2(hv, 0.f) & 0xffffu); } } }
        const float decay = sc[SC_DECAY];
#pragma unroll
        for (int x = 0; x < 8; ++x) Cacc[x] = Cacc[x] * decay;
        f32x4 nacc0 = (f32x4){0.f, 0.f, 0.f, 0.f}, nacc1 = nacc0;
#pragma unroll
        for (int kk = 0; kk < 2; ++kk) {
            const LAS unsigned char* va = trb + ML_VW + 32 * kk * ML_PV;
            const ml_bf16x8 bfr = ml_tr_read2(va, va + 4 * ML_PV);
            const f32x4 wa = *(const LAS f32x4*)(sc + SC_WS + 32 * kk + 8 * g), wb = *(const LAS f32x4*)(sc + SC_WS + 32 * kk + 8 * g + 4);
            u32x4v ww; ww.x = ml_pk2n(wa[0], wa[1]); ww.y = ml_pk2n(wa[2], wa[3]); ww.z = ml_pk2n(wb[0], wb[1]); ww.w = ml_pk2n(wb[2], wb[3]);
            const ml_bf16x8 wfr = __builtin_bit_cast(ml_bf16x8, ww);
#pragma unroll
            for (int x = 0; x < 8; ++x) { const LAS unsigned char* ka = trk + 32 * kk * ML_PQ + 32 * x; const ml_bf16x8 afr = ml_tr_read2(ka, ka + 4 * ML_PQ);
                Cacc[x] = ML_MFMA(afr, bfr, Cacc[x]);
                if ((x >> 1) == dvb) { if (x & 1) nacc1 = ML_MFMA(afr, wfr, nacc1); else nacc0 = ML_MFMA(afr, wfr, nacc0); } }
        }
        if (i == 0) { LAS f32x4* np0 = (LAS f32x4*)(nS + 128 * dkh + 16 * (2 * dvb) + 4 * g); LAS f32x4* np1 = (LAS f32x4*)(nS + 128 * dkh + 16 * (2 * dvb + 1) + 4 * g);
            *np0 = *np0 * decay + nacc0; *np1 = *np1 * decay + nacc1; }
        __syncthreads();
    }
#undef ML_FETCH
}

struct Args { const float* in[24]; float* out; unsigned char* ws; int l_lo, l_hi, ph_lo, ph_hi, use_bar, do_init, do_final, pad; };
static_assert(sizeof(Args) == 26 * 8 + 8 * 4, "Args has no padding");

__global__ void __launch_bounds__(NWAVES * 64, 2) fwd(Args args) {
    extern __shared__ __attribute__((aligned(16))) unsigned char lds_raw[];
    LAS unsigned char* lds = (LAS unsigned char*)lds_raw;
    volatile LAS unsigned* MISC = (volatile LAS unsigned*)(lds + MISC_OFF);
    const int G = gridDim.x, bx = blockIdx.x, NGW = G * NWAVES;
    const int wave0 = __builtin_amdgcn_readfirstlane((int)threadIdx.x >> 6);
    { const int t0 = threadIdx.x;
      for (int u = t0; u < (LDS_BYTES - LDSCTL_OFF) / 4; u += NWAVES * 64) ((LAS unsigned*)(lds + LDSCTL_OFF))[u] = 0u; }
    __syncthreads();
    XcdBarrier bar; bar.bar = (unsigned*)(args.ws + WS_CTL) + CW_BAR; bar.x = 0; bar.st = nullptr;
    if (args.use_bar) bar = xcd_barrier_post((unsigned*)(args.ws + WS_CTL) + CW_BAR, MISC + 8);
#define GRID_BAR() do { if (args.use_bar) { int bt_; asm volatile("v_mbcnt_lo_u32_b32 %0, -1, 0\n\tv_mbcnt_hi_u32_b32 %0, -1, %0" : "=v"(bt_)); xcd_barrier(bar, bt_ + wave0 * 64); } } while (0)
#define PH_BEGIN() int tid_; asm volatile("v_mbcnt_lo_u32_b32 %0, -1, 0\n\tv_mbcnt_hi_u32_b32 %0, -1, %0" : "=v"(tid_)); tid_ += wave0 * 64; const int tid = tid_, lane = tid & 63, wave = __builtin_amdgcn_readfirstlane(tid >> 6), gw = bx * NWAVES + wave; \
    unsigned char* ws = args.ws; asm volatile("" : "+s"(ws)); unsigned char* BIG = ws + WS_BIG; (void)tid; (void)lane; (void)gw; (void)BIG; \
    bf16* U = (bf16*)(ws + WS_U); (void)U
#define INP(k) ({ int k_ = (k); asm volatile("" : "+s"(k_)); const float* p_ = args.in[k_]; p_; })
#define HID ((bf16*)BIG)
#define Z ((bf16*)BIG)
#define PB ((bf16*)BIG)
#define GT ((bf16*)(ws + WS_GT))
#define VWT ((bf16*)(ws + WS_VWT))
#define QC ((bf16*)(ws + WS_X1))
#define KC (QC + (size_t)M * 1024)
#define DP ((bf16*)(ws + WS_X2))
#define HM ((bf16*)(ws + WS_HM))
#define GAT ((float*)(ws + WS_GAT))
#define KB ((bf16*)(ws + WS_KB))
#define VB ((bf16*)(ws + WS_VT))
#define MEMN ((bf16*)(ws + WS_MEMN))
#define WGU1 ((bf16*)(ws + WS_WGU1))
#define WD1 ((bf16*)(ws + WS_WD1))
#define WGU2 ((bf16*)(ws + WS_WGU2))
#define WD2 ((bf16*)(ws + WS_WD2))
#define WIN ((bf16*)(ws + WS_WIN))
#define WPOOL ((bf16*)(ws + WS_WPOOL))
#define WOUT ((bf16*)(ws + WS_WOUT))
#define WQH ((bf16*)(ws + WS_WQ))
#define WKV ((bf16*)(ws + WS_WKV))
#define WOH ((bf16*)(ws + WS_WO))

    const int lo = args.ph_lo, hi = args.ph_hi;
#ifndef PHMASK
#define PHMASK 0xfff
#endif
#ifndef DUPMASK
#define DUPMASK 0
#endif
#define NREP(k) (1 + ((DUPMASK >> (k)) & 1))
#define IN(k) (((PHMASK >> (k)) & 1) && lo <= (k) && (k) < hi)
#define RSS(k) ((pg8::rss_t*)(ws + WS_RSS) + (size_t)(k) * M)
#define H16 ((bf16*)(ws + WS_H))
#define DUMMY16 ((bf16*)(ws + WS_X1))

    if (args.do_init) {
        PH_BEGIN();
        const float* x = INP(0);
        for (int m = gw; m < M; m += NGW) {
            const GAS f32x4* xr = (const GAS f32x4*)(x + (size_t)m * D) + lane; float ss = 0.f;
#pragma unroll
            for (int j = 0; j < 8; ++j) { const f32x4 v = __builtin_nontemporal_load(xr + 64 * j); v2u w; w.x = pk2(v.x, v.y); w.y = pk2(v.z, v.w); *(GAS v2u*)(H16 + h16_off(m, 256 * j + 4 * lane)) = w;
                const float a0 = bflo(w.x), a1 = bfhi(w.x), a2 = bflo(w.y), a3 = bfhi(w.y); ss += (a0 * a0 + a1 * a1) + (a2 * a2 + a3 * a3); }
            ss = wave_sum(ss, lane);
            if (lane == 0) RSS(0)[m] = (pg8::rss_t)(ss * 1048576.0f + 0.5f);
        }
        GRID_BAR();
    }
    for (int l = args.l_lo; l < args.l_hi; ++l) {
        if (IN(0)) for (int rep = 0; rep < NREP(0); ++rep) {
            PH_BEGIN();
            const float* wg1 = INP(3) + (size_t)l * D * FF; const float* wu1 = INP(4) + (size_t)l * D * FF; const float* wd1 = INP(5) + (size_t)l * FF * D;
            const float* wg2 = INP(20) + (size_t)l * D * FF; const float* wu2 = INP(21) + (size_t)l * D * FF; const float* wd2 = INP(22) + (size_t)l * FF * D;
            const float* win = INP(7) + (size_t)l * D * DIN; const float* wpool = INP(11) + (size_t)l * 4 * 65536; const float* wout = INP(13) + (size_t)l * D * D;
            const float* wq = INP(16) + (size_t)l * D * D; const float* wkv = INP(17) + (size_t)l * D * 2 * D; const float* wo = INP(18) + (size_t)l * D * D;
            const float* g1 = INP(2) + (size_t)l * D; const float* gm = INP(6) + (size_t)l * D; const float* gx = INP(14) + (size_t)l * D; const float* g2 = INP(19) + (size_t)l * D;
            constexpr int T_GU = (D / 128) * (FF / 256), T_DN = (FF / 128) * (D / 256), T_IN = (D / 128) * (DINM / 256), T_PL = 2, T_SQ = (D / 128) * (D / 256), T_KV = (D / 128) * (2 * D / 256);
            constexpr int NTILES = 4 * T_GU + 2 * T_DN + T_IN + 4 * T_PL + 2 * T_SQ + T_KV;
#define CVT_DESC(dst, it_) do { int r = (it_); \
                if (r < T_GU) { dst = CvtDesc{wg1, FF, D, FF, WGU1, 1, g1, r}; break; } r -= T_GU; \
                if (r < T_GU) { dst = CvtDesc{wu1, FF, D, FF, WGU1, 2, g1, r}; break; } r -= T_GU; \
                if (r < T_DN) { dst = CvtDesc{wd1, D, FF, D, WD1, 0, nullptr, r}; break; } r -= T_DN; \
                if (r < T_GU) { dst = CvtDesc{wg2, FF, D, FF, WGU2, 1, g2, r}; break; } r -= T_GU; \
                if (r < T_GU) { dst = CvtDesc{wu2, FF, D, FF, WGU2, 2, g2, r}; break; } r -= T_GU; \
                if (r < T_DN) { dst = CvtDesc{wd2, D, FF, D, WD2, 0, nullptr, r}; break; } r -= T_DN; \
                if (r < T_IN) { dst = CvtDesc{win, DIN, D, DINM, WIN, 0, gm, r}; break; } r -= T_IN; \
                if (r < 4 * T_PL) { const int g_ = r / T_PL; dst = CvtDesc{wpool + (size_t)g_ * 65536, 256, 256, 256, WPOOL + (size_t)g_ * 65536, 0, nullptr, r % T_PL}; break; } r -= 4 * T_PL; \
                if (r < T_SQ) { dst = CvtDesc{wout, D, D, D, WOUT, 0, nullptr, r}; break; } r -= T_SQ; \
                if (r < T_KV) { dst = CvtDesc{wkv, 2 * D, D, 2 * D, WKV, 0, nullptr, r}; break; } r -= T_KV; \
                dst = CvtDesc{wo, D, D, D, WOH, 3, nullptr, r}; } while (0)
            int it0 = bx; asm volatile("" : "+s"(it0));
            if (it0 < NTILES) {
                f32x4 cv[16]; CvtDesc cd; CVT_DESC(cd, it0); cvt_load(cd, cv, tid);
                int buf = 0;
#pragma unroll 1
                for (int it = it0; it < NTILES; it += G) {
                    LAS unsigned char* img = lds + RING_OFF + buf * 66560;
                    cvt_to_lds(cd, cv, img, tid);
                    __syncthreads();
                    CvtDesc cn = cd; const bool more = it + G < NTILES;
                    if (more) { CVT_DESC(cn, it + G); cvt_load(cn, cv, tid); }
                    cvt_store(cd, img, tid);
                    cd = cn; buf ^= 1;
                }
                __syncthreads();
            }
#undef CVT_DESC
            for (int e = bx * (NWAVES * 64) + tid; e < D * D / 8; e += G * NWAVES * 64) { const int k = e >> 8, n8 = (e & 255) * 8; const float sc = gx[k] * 0.044194173824159216f;
                const f32x4 a = __builtin_nontemporal_load((const GAS f32x4*)(wq + (size_t)k * D + n8)), b = __builtin_nontemporal_load((const GAS f32x4*)(wq + (size_t)k * D + n8 + 4));
                v4u o; o.x = pk2(a.x * sc, a.y * sc); o.y = pk2(a.z * sc, a.w * sc); o.z = pk2(b.x * sc, b.y * sc); o.w = pk2(b.z * sc, b.w * sc);
                *(GAS v4u*)(WQH + ((size_t)(n8 >> 9) * D + k) * 512 + (n8 & 511)) = o; }
            for (int e = bx * (NWAVES * 64) + tid; e < 256 * D; e += G * NWAVES * 64) { const int rr = e >> 11, k = e & (D - 1);
                const float v = (rr < 8) ? win[(size_t)k * DIN + DINM + rr] * gm[k] : 0.f; WIN[((size_t)(20 * 32 + (k >> 6)) * 256 + rr) * 64 + (k & 63)] = (bf16)(pk2(v, 0.f) & 0xffffu); }
            f32x4 v[8];
            for (int m = gw; m < MMEM; m += NGW) rms_row(INP(1) + (size_t)m * D, INP(15) + (size_t)l * D, MEMN + (size_t)m * D, lane, v);
            GRID_BAR();
        }
        if (IN(1)) for (int rep = 0; rep < NREP(1); ++rep) {
            PH_BEGIN();
            pg8::Gemm g{H16, WGU1, D, 0, 44, 1, 1}; pg8::StaticOrder S; S.init(128, 44, G, bx);
            pg8::EpiSwiGLU E{HID, 64, RSS(4 * l), (LAS float*)(lds + LDSCTL_OFF + 12288)};
            pg8::gemm_phase<pg8::EpiSwiGLU, pg8::StaticOrder, PG8_ALIGN, PG8_SP2, true>(lds + RING_OFF, g, S, E, tid);
            { pg8::Gemm g2{MEMN, WKV, D, 0, 16, 0, 1}; pg8::StaticOrder S2; S2.init(16, 16, G, bx);
              pg8::EpiBf16K<1> E2{KB, nullptr, 1.0f, MMEM, nullptr, nullptr, nullptr, nullptr};
              pg8::gemm_phase<pg8::EpiBf16K<1>, pg8::StaticOrder, PG8_ALIGN, PG8_SP2>(lds + RING_OFF, g2, S2, E2, tid); }
            GRID_BAR();
        }
        if (IN(2)) for (int rep = 0; rep < NREP(2); ++rep) {
            PH_BEGIN();
            const bool dummy = rep + 1 < NREP(2);
            pg8::Gemm g{HID, WD1, FF, 0, 8, 1, 1}; pg8::StaticOrder S; S.init(128, 8, G, bx);
            pg8::EpiResid16 E{H16, dummy ? DUMMY16 : H16, 0.5f, dummy ? RSS(17) : RSS(4 * l + 1)};
            pg8::gemm_phase<pg8::EpiResid16, pg8::StaticOrder, false, PG8_SP2, true>(lds + RING_OFF, g, S, E, tid);
            GRID_BAR();
        }
        if (IN(3)) for (int rep = 0; rep < NREP(3); ++rep) {
            PH_BEGIN();
            pg8::Gemm g{H16, WIN, D, 0, 21, 1, 1}; pg8::StaticOrder S; S.init(128, 21, G, bx);
            pg8::EpiBf16K<0> E{Z, nullptr, 1.0f, 0, RSS(4 * l + 1), GAT, INP(8) + l * 8, (LAS float*)(lds + LDSCTL_OFF + 12288)};
            pg8::gemm_phase<pg8::EpiBf16K<0>, pg8::StaticOrder, PG8_ALIGN, PG8_SP2>(lds + RING_OFF, g, S, E, tid);
            const bool lateWG = (G == 256) && bx >= 128;
#pragma unroll 1
            for (int part = 0; part < 2; ++part) {
                pg8::Gemm g2{KB, WQH, 512, 16, 8}; pg8::StaticOrder S2; S2.init(64, 8, G, bx);
                if (G == 256) { if (part == 0) S2.slice(0, 256, 256, bx); else S2.slice(256, 256, 128, lateWG ? bx - 128 : 256); } else if (part == 1) S2.slice(0, 0, G, 1);
                pg8::EpiBf16K<5> E2{GT, nullptr, 1.0f, 0, nullptr, nullptr, nullptr, nullptr};
                pg8::gemm_phase<pg8::EpiBf16K<5>, pg8::StaticOrder, PG8_ALIGN, PG8_SP2>(lds + RING_OFF, g2, S2, E2, tid);
                pg8::Gemm g3{WOH, VB, 512, 8, 16}; pg8::StaticOrder S3; S3.init(32, 16, G, bx);
                if (G == 256) { if (part == 0) S3.slice(0, 256, 256, bx); else S3.slice(256, 256, 128, lateWG ? bx - 128 : 256); } else if (part == 1) S3.slice(0, 0, G, 1);
                pg8::EpiBf16K<6> E3{VWT, nullptr, 1.0f, 0, nullptr, nullptr, nullptr, nullptr};
                pg8::gemm_phase<pg8::EpiBf16K<6>, pg8::StaticOrder, PG8_ALIGN, PG8_SP2>(lds + RING_OFF, g3, S3, E3, tid);
            }
            GRID_BAR();
        }
        if (IN(4)) for (int rep = 0; rep < NREP(4); ++rep) {
            PH_BEGIN();
            const float* cw = INP(9) + (size_t)l * 4 * 2048;
#define UNPK8(dst, zz) do { dst[0] = bflo(zz.x); dst[1] = bfhi(zz.x); dst[2] = bflo(zz.y); dst[3] = bfhi(zz.y); dst[4] = bflo(zz.z); dst[5] = bfhi(zz.z); dst[6] = bflo(zz.w); dst[7] = bfhi(zz.w); } while (0)
            for (int blk = bx; blk < 256; blk += G) {
                const int tokb = blk * 128;
                {
                    const int o = tid & 255, c0 = o * 8, t1 = tokb + 64 * (tid >> 8), s1 = t1 & (SEQ - 1);
                    f32x4 W0[2], W1[2], W2[2], W3[2], XA[2], XB[2], XC[2];
#pragma unroll
                    for (int h2 = 0; h2 < 2; ++h2) { W0[h2] = *(const f32x4*)(cw + c0 + 4 * h2); W1[h2] = *(const f32x4*)(cw + 2048 + c0 + 4 * h2); W2[h2] = *(const f32x4*)(cw + 4096 + c0 + 4 * h2); W3[h2] = *(const f32x4*)(cw + 6144 + c0 + 4 * h2); }
#define UNPKV(dst, zz) do { dst[0][0] = bflo(zz.x); dst[0][1] = bfhi(zz.x); dst[0][2] = bflo(zz.y); dst[0][3] = bfhi(zz.y); dst[1][0] = bflo(zz.z); dst[1][1] = bfhi(zz.z); dst[1][2] = bflo(zz.w); dst[1][3] = bfhi(zz.w); } while (0)
                    const bf16* zcol = Z + 1024 + c0;
                    { v4u z3 = (v4u){0u, 0u, 0u, 0u}, z2 = z3, z1 = z3;
                      if (s1 >= 3) z3 = *(const GAS v4u*)(zcol + (size_t)(t1 - 3) * ZP);
                      if (s1 >= 2) z2 = *(const GAS v4u*)(zcol + (size_t)(t1 - 2) * ZP);
                      if (s1 >= 1) z1 = *(const GAS v4u*)(zcol + (size_t)(t1 - 1) * ZP);
                      UNPKV(XA, z3); UNPKV(XB, z2); UNPKV(XC, z1); }
                    const float qs = (c0 < 1024) ? 0.0625f : 1.0f;
                    bf16* dcol = (c0 < 1024) ? (QC + c0) : (KC + (c0 - 1024));
                    v4u zr[8];
#pragma unroll
                    for (int u = 0; u < 8; ++u) zr[u] = *(const GAS v4u*)(zcol + (size_t)(t1 + u) * ZP);
                    for (int tt = 0; tt < 64; tt += 8) {
                        v4u zq[8];
#pragma unroll
                        for (int u = 0; u < 8; ++u) zq[u] = (tt + 8 < 64) ? *(const GAS v4u*)(zcol + (size_t)(t1 + tt + 8 + u) * ZP) : (v4u){0u, 0u, 0u, 0u};
#pragma unroll
                        for (int u = 0; u < 8; ++u) { f32x4 XD[2], Y[2]; UNPKV(XD, zr[u]);
#pragma unroll
                            for (int h2 = 0; h2 < 2; ++h2) { const f32x4 a = W0[h2] * XA[h2] + W1[h2] * XB[h2] + W2[h2] * XC[h2] + W3[h2] * XD[h2];
                                f32x4 e = a * -1.4426950408889634f;
#pragma unroll
                                for (int j = 0; j < 4; ++j) e[j] = __builtin_amdgcn_exp2f(e[j]);
                                e = e + 1.0f;
#pragma unroll
                                for (int j = 0; j < 4; ++j) e[j] = __builtin_amdgcn_rcpf(e[j]);
                                Y[h2] = (a * qs) * e; XA[h2] = XB[h2]; XB[h2] = XC[h2]; XC[h2] = XD[h2]; }
                            v4u wv; wv.x = pk2(Y[0][0], Y[0][1]); wv.y = pk2(Y[0][2], Y[0][3]); wv.z = pk2(Y[1][0], Y[1][1]); wv.w = pk2(Y[1][2], Y[1][3]);
                            *(GAS v4u*)(dcol + (size_t)(t1 + tt + u) * 1024) = wv; }
#pragma unroll
                        for (int u = 0; u < 8; ++u) zr[u] = zq[u];
                    }
                }
                {
                    const int o = tid & 127, c0 = o * 8, g = o >> 5, wdw = 2 << g, t1 = tokb + 32 * (tid >> 7), s1 = t1 & (SEQ - 1);
                    const bf16* zcol = Z + c0;
                    f32x4 S[2]; S[0] = (f32x4){0.f, 0.f, 0.f, 0.f}; S[1] = S[0];
                    for (int j = 1; j <= wdw; ++j) if (s1 - j >= 0) { const v4u zz = *(const GAS v4u*)(zcol + (size_t)(t1 - j) * ZP); f32x4 x[2]; UNPKV(x, zz); S[0] += x[0]; S[1] += x[1]; }
                    bf16* dcol = DP + (size_t)g * M * 256 + (c0 & 255);
                    for (int tt = 0; tt < 32; tt += 8) {
                        v4u zn[8], zo[8];
#pragma unroll
                        for (int u = 0; u < 8; ++u) { const int t = t1 + tt + u, sq = s1 + tt + u; zn[u] = *(const GAS v4u*)(zcol + (size_t)t * ZP);
                            zo[u] = (v4u){0u, 0u, 0u, 0u}; if (sq >= wdw) zo[u] = *(const GAS v4u*)(zcol + (size_t)(t - wdw) * ZP); }
#pragma unroll
                        for (int u = 0; u < 8; ++u) { const int sq = s1 + tt + u; f32x4 xn[2], xo[2], d[2]; UNPKV(xn, zn[u]); UNPKV(xo, zo[u]);
                            const float inv = __builtin_amdgcn_rcpf((float)((sq + 1 < wdw) ? (sq + 1) : wdw));
#pragma unroll
                            for (int h2 = 0; h2 < 2; ++h2) { S[h2] += xn[h2] - xo[h2]; d[h2] = S[h2] * inv - xn[h2]; }
                            v4u wv; wv.x = pk2(d[0][0], d[0][1]); wv.y = pk2(d[0][2], d[0][3]); wv.z = pk2(d[1][0], d[1][1]); wv.w = pk2(d[1][2], d[1][3]);
                            *(GAS v4u*)(dcol + (size_t)(t1 + tt + u) * 256) = wv; }
                    }
                }
            }
#undef UNPK8
#undef UNPKV
            GRID_BAR();
        }
        if (IN(5)) for (int rep = 0; rep < NREP(5); ++rep) {
            PH_BEGIN();
            {
                pg8::Gemm g{DP, WPOOL, 256, 128, 1, 0, 1}; pg8::StaticOrder S; S.init(512, 1, G, bx);
                pg8::EpiBf16K<3> E{U, INP(12) + (size_t)l * 1024, 1.0f, 0, nullptr, nullptr, nullptr, nullptr};
                pg8::gemm_phase<pg8::EpiBf16K<3>, pg8::StaticOrder, PG8_ALIGN, PG8_SP2>(lds + RING_OFF, g, S, E, tid);
            }
            __syncthreads();
            for (int wgi = bx; wgi < 256; wgi += G) { const int item = (G == 256) ? ((((wgi & 7) + 8 * (wgi >> 5)) << 2) | ((wgi >> 3) & 3)) : wgi;
                mlstm_item(lds + RING_OFF, QC, KC, Z, GAT, HM, item, tid); }
            GRID_BAR();
        }
        if (IN(6)) for (int rep = 0; rep < NREP(6); ++rep) {
            PH_BEGIN();
            const float* hn = INP(10) + (size_t)l * 1024;
            const int hq = lane >> 4, i16 = lane & 15, col = hq * 256 + 16 * i16;
            f32x4 gn[4];
#pragma unroll
            for (int q = 0; q < 4; ++q) gn[q] = *(const GAS f32x4*)(hn + col + 4 * q);
            for (int m0 = gw; m0 < M; m0 += NGW) {
                v4u hh[1][2], og[1][2];
#pragma unroll
                for (int r2 = 0; r2 < 1; ++r2) { const size_t m = (size_t)(m0 + r2);
                    hh[r2][0] = *(const GAS v4u*)(HM + m * 1024 + col); hh[r2][1] = *(const GAS v4u*)(HM + m * 1024 + col + 8);
                    og[r2][0] = *(const GAS v4u*)(Z + m * ZP + 4096 + col); og[r2][1] = *(const GAS v4u*)(Z + m * ZP + 4096 + col + 8); }
#pragma unroll
                for (int r2 = 0; r2 < 1; ++r2) { const size_t m = (size_t)(m0 + r2);
                    f32x4 av[4], ov[4]; const v4u z0 = hh[r2][0], z1 = hh[r2][1], q0 = og[r2][0], q1 = og[r2][1];
#define UNPQ(dst, lo, hi) do { dst[0] = bflo(lo); dst[1] = bfhi(lo); dst[2] = bflo(hi); dst[3] = bfhi(hi); } while (0)
                    UNPQ(av[0], z0.x, z0.y); UNPQ(av[1], z0.z, z0.w); UNPQ(av[2], z1.x, z1.y); UNPQ(av[3], z1.z, z1.w);
                    UNPQ(ov[0], q0.x, q0.y); UNPQ(ov[1], q0.z, q0.w); UNPQ(ov[2], q1.x, q1.y); UNPQ(ov[3], q1.z, q1.w);
#undef UNPQ
                    float ss = 0.f;
                    ss = pg8::dot2_bf16(z0.x, ss); ss = pg8::dot2_bf16(z0.y, ss); ss = pg8::dot2_bf16(z0.z, ss); ss = pg8::dot2_bf16(z0.w, ss);
                    ss = pg8::dot2_bf16(z1.x, ss); ss = pg8::dot2_bf16(z1.y, ss); ss = pg8::dot2_bf16(z1.z, ss); ss = pg8::dot2_bf16(z1.w, ss);
                    ss += shfl_xor_l(ss, 1, lane); ss += shfl_xor_l(ss, 2, lane); ss += shfl_xor_l(ss, 4, lane); ss += shfl_xor_l(ss, 8, lane);
                    const float r = __builtin_amdgcn_rsqf(ss * (1.f / 256.f) + EPS);
                    f32x4 yv[4];
#pragma unroll
                    for (int q = 0; q < 4; ++q) { f32x4 e = ov[q] * -1.4426950408889634f;
#pragma unroll
                        for (int j = 0; j < 4; ++j) e[j] = __builtin_amdgcn_exp2f(e[j]);
                        e = e + 1.0f;
#pragma unroll
                        for (int j = 0; j < 4; ++j) e[j] = __builtin_amdgcn_rcpf(e[j]);
                        yv[q] = (av[q] * gn[q]) * r * e; }
                    v4u w0, w1; w0.x = pk2(yv[0][0], yv[0][1]); w0.y = pk2(yv[0][2], yv[0][3]); w0.z = pk2(yv[1][0], yv[1][1]); w0.w = pk2(yv[1][2], yv[1][3]);
                    w1.x = pk2(yv[2][0], yv[2][1]); w1.y = pk2(yv[2][2], yv[2][3]); w1.z = pk2(yv[3][0], yv[3][1]); w1.w = pk2(yv[3][2], yv[3][3]);
                    bf16* up = U + h16_off((int)m, 1024 + col); *(GAS v4u*)up = w0; *(GAS v4u*)(up + 8) = w1; }
            }
            GRID_BAR();
        }
        if (IN(7)) for (int rep = 0; rep < NREP(7); ++rep) {
            PH_BEGIN();
            const bool dummy = rep + 1 < NREP(7);
            pg8::Gemm g{U, WOUT, D, 0, 8, 1, 1}; pg8::StaticOrder S; S.init(128, 8, G, bx);
            pg8::EpiResid16 E{H16, dummy ? DUMMY16 : H16, 1.0f, dummy ? RSS(17) : RSS(4 * l + 2)};
            pg8::gemm_phase<pg8::EpiResid16, pg8::StaticOrder, false, PG8_SP2, true>(lds + RING_OFF, g, S, E, tid);
            GRID_BAR();
        }
        if (IN(8)) for (int rep = 0; rep < NREP(8); ++rep) {
            PH_BEGIN();
            pg8::Gemm g{H16, GT, D, 8, 4, 1}; pg8::StaticOrder S; S.init(128, 4, G, bx);
            pg8::EpiSoftmaxP E{PB, RSS(4 * l + 2), (LAS float*)(lds + LDSCTL_OFF + 1024)};
            pg8::gemm_phase<pg8::EpiSoftmaxP, pg8::StaticOrder, true, PG8_SP2, true>(lds + RING_OFF, g, S, E, tid);
            GRID_BAR();
        }
        if (IN(9)) for (int rep = 0; rep < NREP(9); ++rep) {
            PH_BEGIN();
            const bool dummy = rep + 1 < NREP(9);
            pg8::Gemm g{PB, VWT, 1024, 8, 8, 1}; pg8::StaticOrder S; S.init(128, 8, G, bx);
            pg8::EpiResid16 E{H16, dummy ? DUMMY16 : H16, 1.0f, dummy ? RSS(17) : RSS(4 * l + 3)};
            pg8::gemm_phase<pg8::EpiResid16, pg8::StaticOrder, false, PG8_SP2, true>(lds + RING_OFF, g, S, E, tid);
            GRID_BAR();
        }
        if (IN(10)) for (int rep = 0; rep < NREP(10); ++rep) {
            PH_BEGIN();
            pg8::Gemm g{H16, WGU2, D, 0, 44, 1, 1}; pg8::StaticOrder S; S.init(128, 44, G, bx);
            pg8::EpiSwiGLU E{HID, 64, RSS(4 * l + 3), (LAS float*)(lds + LDSCTL_OFF + 12288)};
            pg8::gemm_phase<pg8::EpiSwiGLU, pg8::StaticOrder, PG8_ALIGN, PG8_SP2, true>(lds + RING_OFF, g, S, E, tid);
            GRID_BAR();
        }
        if (IN(11)) for (int rep = 0; rep < NREP(11); ++rep) {
            PH_BEGIN();
            const bool dummy = rep + 1 < NREP(11);
            pg8::Gemm g{HID, WD2, FF, 0, 8, 1, 1}; pg8::StaticOrder S; S.init(128, 8, G, bx);
            pg8::EpiResid16 E{H16, dummy ? DUMMY16 : H16, 0.5f, dummy ? RSS(17) : RSS(4 * l + 4)};
            pg8::gemm_phase<pg8::EpiResid16, pg8::StaticOrder, false, PG8_SP2, true>(lds + RING_OFF, g, S, E, tid);
            GRID_BAR();
        }
    }
    if (args.do_final) {
        PH_BEGIN();
        const float* gf = INP(23);
        for (int m = gw; m < M; m += NGW) {
            const float r = pg8::rms_scale(RSS(16), m);
            GAS f32x4* orow = (GAS f32x4*)(args.out + (size_t)m * D) + lane;
#pragma unroll
            for (int j = 0; j < 8; ++j) { const v2u w = *(const GAS v2u*)(H16 + h16_off(m, 256 * j + 4 * lane)); const f32x4 gv = *((const GAS f32x4*)gf + lane + 64 * j);
                __builtin_nontemporal_store((f32x4){bflo(w.x) * r * gv.x, bfhi(w.x) * r * gv.y, bflo(w.y) * r * gv.z, bfhi(w.y) * r * gv.w}, orow + 64 * j); }
        }
    }
#undef IN
#undef GRID_BAR
}

extern "C" void kernel_launch(void* const* d_in, const int* in_sizes, int n_in, void* d_out, int out_size, void* d_ws, size_t ws_size, hipStream_t stream) {
    static int grid = 0;
    if (grid == 0) {
        if (n_in != 24 || in_sizes[0] != M * D || out_size != M * D || ws_size < WS_END) { fprintf(stderr, "kernel_launch: unexpected shapes / workspace (n_in %d, ws %zu, need %zu)\n", n_in, ws_size, (size_t)WS_END); grid = -1; return; }
        int dev = 0, cus = 0;
        if (hipGetDevice(&dev) != hipSuccess || hipDeviceGetAttribute(&cus, hipDeviceAttributeMultiprocessorCount, dev) != hipSuccess) { grid = -1; return; }
        if (hipFuncSetAttribute((const void*)fwd, hipFuncAttributeMaxDynamicSharedMemorySize, LDS_BYTES) != hipSuccess) { fprintf(stderr, "kernel_launch: hipFuncSetAttribute failed\n"); grid = -1; return; }
        int per_cu = 0;
        if (hipOccupancyMaxActiveBlocksPerMultiprocessor(&per_cu, (const void*)fwd, NWAVES * 64, LDS_BYTES) != hipSuccess || per_cu < 1) { fprintf(stderr, "kernel_launch: occupancy query says %d\n", per_cu); }
        (void)hipGetLastError();
        grid = cus;
    }
    if (grid < 0) return;
    (void)hipMemsetAsync((char*)d_ws + WS_CTL, 0, CTL_ZERO_BYTES, stream);
    Args a{};
    for (int i = 0; i < 24; ++i) a.in[i] = (const float*)d_in[i];
    a.out = (float*)d_out; a.ws = (unsigned char*)d_ws;
#if MK_ONE_LAUNCH
    a.l_lo = 0; a.l_hi = DEPTH; a.ph_lo = 0; a.ph_hi = N_PH; a.use_bar = 1; a.do_init = 1; a.do_final = 1;
    hipLaunchKernelGGL(fwd, dim3(grid), dim3(NWAVES * 64), LDS_BYTES, stream, a);
#else
    a.l_lo = 0; a.l_hi = 0; a.ph_lo = 0; a.ph_hi = 0; a.use_bar = 0; a.do_init = 1; a.do_final = 0;
    hipLaunchKernelGGL(fwd, dim3(grid), dim3(NWAVES * 64), LDS_BYTES, stream, a);
    for (int l = 0; l < DEPTH; ++l)
        for (int ph = 0; ph < N_PH; ++ph) {
            a.l_lo = l; a.l_hi = l + 1; a.ph_lo = ph; a.ph_hi = ph + 1; a.use_bar = 0; a.do_init = 0; a.do_final = 0;
            hipLaunchKernelGGL(fwd, dim3(grid), dim3(NWAVES * 64), LDS_BYTES, stream, a);
        }
    a.l_lo = 0; a.l_hi = 0; a.ph_lo = 0; a.ph_hi = 0; a.use_bar = 0; a.do_init = 0; a.do_final = 1;
    hipLaunchKernelGGL(fwd, dim3(grid), dim3(NWAVES * 64), LDS_BYTES, stream, a);
#endif
}
```

```cpp
#include <hip/hip_runtime.h>
#include <cstdio>
#include <cstdint>

#ifndef MK_ONE_LAUNCH
#define MK_ONE_LAUNCH 1
#endif

namespace pg8 {
typedef _Float16 f16x4_t __attribute__((ext_vector_type(4)));
#define PG8_LAS __attribute__((address_space(3)))
typedef unsigned short bf16_t;
typedef short bf16x8 __attribute__((ext_vector_type(8)));
typedef float f32x4 __attribute__((ext_vector_type(4)));
typedef unsigned u32x4 __attribute__((ext_vector_type(4)));
constexpr int FFH = 5632;
constexpr int BM = 256, BK = 64, HALF = 128, HTB = HALF * BK * 2  , STAGE_BYTES = 8 * HTB, NXCD = 8, WGM = 8;

__host__ __device__ __forceinline__ int lds_byte(int r, int c) { const int st = (r >> 4) * 2 + (c >> 5), rr = r & 15, cc = c & 31, ob = rr * 64 + cc * 2; return st * 1024 + (ob ^ (((ob >> 9) & 1) << 5)); }
__host__ __device__ __forceinline__ void stage_rc(int b, int& R, int& C) { const int st = b / 1024, sb = b % 1024, swz = sb ^ (((sb >> 9) & 1) << 5); R = (st >> 1) * 16 + swz / 64; C = (st & 1) * 32 + (swz % 64) / 2; }
__host__ __device__ __forceinline__ int perm32(int rho) { const int n = rho >> 4, i = rho & 15; return 8 * (i >> 2) + 4 * n + (i & 3); }

struct Unit { int pm, pn; };
struct Gemm { const bf16_t* A; const bf16_t* Bt; int K; int nMz; int nN; int ablk = 0, bblk = 0; };

struct StaticOrder {
    int nM, nN, nwg, G, c, base, count;
    __host__ __device__ void init(int nM_, int nN_, int G_, int c_) { nM = nM_; nN = nN_; nwg = nM * nN; G = G_; c = c_; base = 0; count = nwg; }
    __host__ __device__ void slice(int base_, int count_, int G_, int c_) { base = base_; count = count_; G = G_; c = c_; }
    __host__ __device__ bool next(int i, Unit& u) const {
        const long Lr = (long)i * G + c; if (Lr >= count) return false; const long L = base + Lr;
        int wgid = (int)L; { const int q = nwg / NXCD, r = nwg % NXCD, xcd = wgid % NXCD, off = wgid / NXCD; wgid = (xcd < r ? xcd * (q + 1) : r * (q + 1) + (xcd - r) * q) + off; }
        const int nig = WGM * nN, gid = wgid / nig, fm = gid * WGM, gsz = (nM - fm) < WGM ? (nM - fm) : WGM;
        u.pm = fm + ((wgid % nig) % gsz); u.pn = (wgid % nig) / gsz; return true;
    }
    __device__ __forceinline__ void a_ready(const Unit&) const {}
    __device__ __forceinline__ void done(const Unit&) const {}
};

struct SyncOrder : StaticOrder {
    unsigned* cnt; unsigned members; int w0;
    __device__ __forceinline__ void done(const Unit&) const {
        if (w0) {
            unsigned ln; asm volatile("v_mbcnt_lo_u32_b32 %0, -1, 0\n\tv_mbcnt_hi_u32_b32 %0, -1, %0" : "=v"(ln));
            unsigned old = 0u; if (ln == 0u) old = __hip_atomic_fetch_add(cnt, 1u, __ATOMIC_RELAXED, __HIP_MEMORY_SCOPE_AGENT);
            old = (unsigned)__builtin_amdgcn_readfirstlane((int)old);
            const unsigned target = (old / members + 1u) * members; unsigned sp = 0u;
            while ((unsigned)__builtin_amdgcn_readfirstlane((int)__hip_atomic_load(cnt, __ATOMIC_RELAXED, __HIP_MEMORY_SCOPE_AGENT)) < target) { __builtin_amdgcn_s_sleep(1); if (++sp > (1u << 16)) break; }
        }
        asm volatile("" ::: "memory"); __builtin_amdgcn_s_barrier(); asm volatile("" ::: "memory");
    }
};

__device__ __forceinline__ unsigned cvt_pk_bf16(float lo, float hi) { unsigned r; asm volatile("v_cvt_pk_bf16_f32 %0, %1, %2" : "=v"(r) : "v"(lo), "v"(hi)); return r; }

__device__ __forceinline__ float silu_f(float x) { return x * __builtin_amdgcn_rcpf(1.0f + __builtin_amdgcn_exp2f(-1.4426950408889634f * x)); }

typedef unsigned long long rss_t;
#define PG8_GAS __attribute__((address_space(1)))
__device__ __forceinline__ float rms_from_ss(rss_t v) { return __builtin_amdgcn_rsqf((float)v * (1.0f / (2048.0f * 1048576.0f)) + 1e-6f); }
__device__ __forceinline__ float rms_scale(const rss_t* rss, int row) { return rms_from_ss(((const PG8_GAS rss_t*)rss)[row]); }
struct EpiSwiGLU {
    static constexpr bool PERM = true, AFTER_DRAIN = false, ROWTAB = true;
    bf16_t* O; int ldc; const rss_t* rss; PG8_LAS float* tab;
    __device__ __forceinline__ void fill_table(int pm, int par, int tid) const { if (tid < 256) tab[par * 256 + tid] = rms_scale(rss, pm * BM + tid); }
    __device__ __forceinline__ void operator()(const f32x4 (&acc)[2][2][4][2], const Unit& u, int wr, int wc, int fr, int fq, int par) const {
        bf16_t* rowp = O + ((size_t)(u.pm * (FFH / 64) + 2 * u.pn + (wc >> 1)) * BM + wr * 64 + fr) * 64 + (wc & 1) * 32 + 8 * fq;
        float sv[2][4];
#pragma unroll
        for (int ai = 0; ai < 2; ++ai)
#pragma unroll
            for (int m = 0; m < 4; ++m) sv[ai][m] = tab[par * 256 + wr * 64 + fr + ai * HALF + m * 16];
#pragma unroll
        for (int ai = 0; ai < 2; ++ai) {
#pragma unroll
            for (int m = 0; m < 4; ++m) { const float rs = sv[ai][m], rsn = rs * -1.4426950408889634f, rs2 = rs * rs;
                f32x4 e0 = acc[ai][0][m][0] * rsn, e1 = acc[ai][0][m][1] * rsn;
#pragma unroll
                for (int j = 0; j < 4; ++j) { e0[j] = __builtin_amdgcn_exp2f(e0[j]); e1[j] = __builtin_amdgcn_exp2f(e1[j]); }
                e0 = e0 + 1.0f; e1 = e1 + 1.0f;
#pragma unroll
                for (int j = 0; j < 4; ++j) { e0[j] = __builtin_amdgcn_rcpf(e0[j]); e1[j] = __builtin_amdgcn_rcpf(e1[j]); }
                const f32x4 v0 = (acc[ai][0][m][0] * acc[ai][1][m][0]) * rs2 * e0, v1 = (acc[ai][0][m][1] * acc[ai][1][m][1]) * rs2 * e1;
                u32x4 w; w.x = cvt_pk_bf16(v0[0], v0[1]); w.y = cvt_pk_bf16(v0[2], v0[3]); w.z = cvt_pk_bf16(v1[0], v1[1]); w.w = cvt_pk_bf16(v1[2], v1[3]);
                *(PG8_GAS u32x4*)rowp = w; rowp += (size_t)16 * ldc; asm volatile("" : "+v"(rowp)); }
            rowp += (size_t)64 * ldc; asm volatile("" : "+v"(rowp)); }
    }
};
typedef __bf16 bf16x2_t __attribute__((ext_vector_type(2)));
__device__ __forceinline__ float dot2_bf16(unsigned w, float acc) { const bf16x2_t v = __builtin_bit_cast(bf16x2_t, w); return __builtin_amdgcn_fdot2_f32_bf16(v, v, acc, false); }
struct EpiResid16 {
    static constexpr bool PERM = true, AFTER_DRAIN = false, ROWTAB = false;
    const bf16_t* base; bf16_t* out; float scale; rss_t* rss_out;
    __device__ __forceinline__ void operator()(const f32x4 (&acc)[2][2][4][2], const Unit& u, int wr, int wc, int fr, int fq) const {
        const int row0 = u.pm * BM + wr * 64 + fr;
        const size_t off0 = ((size_t)(u.pm * 32 + 4 * u.pn + (wc >> 1)) * BM + wr * 64 + fr) * 64 + (wc & 1) * 32 + 8 * fq;
        const int l1 = (((fq ^ 1) << 4) | fr) << 2, l2 = (((fq ^ 2) << 4) | fr) << 2;
        u32x4 bs2[2][4][2];
#pragma unroll
        for (int ai = 0; ai < 2; ++ai)
#pragma unroll
            for (int m = 0; m < 4; ++m)
#pragma unroll
                for (int bj = 0; bj < 2; ++bj) bs2[ai][m][bj] = *(const PG8_GAS u32x4*)(base + off0 + (size_t)(ai * HALF + m * 16) * 64 + (size_t)bj * 2 * BM * 64);
        float ssv[2][4];
#pragma unroll
        for (int ai = 0; ai < 2; ++ai) {
#pragma unroll
            for (int m = 0; m < 4; ++m) {
                float ss = 0.f;
#pragma unroll
                for (int bj = 0; bj < 2; ++bj) { const u32x4 b4 = bs2[ai][m][bj];
                    f32x4 b0, b1; b0[0] = __uint_as_float(b4.x << 16); b0[1] = __uint_as_float(b4.x & 0xffff0000u); b0[2] = __uint_as_float(b4.y << 16); b0[3] = __uint_as_float(b4.y & 0xffff0000u);
                    b1[0] = __uint_as_float(b4.z << 16); b1[1] = __uint_as_float(b4.z & 0xffff0000u); b1[2] = __uint_as_float(b4.w << 16); b1[3] = __uint_as_float(b4.w & 0xffff0000u);
                    const f32x4 r0 = acc[ai][bj][m][0] * scale + b0, r1 = acc[ai][bj][m][1] * scale + b1;
                    u32x4 w; w.x = cvt_pk_bf16(r0[0], r0[1]); w.y = cvt_pk_bf16(r0[2], r0[3]); w.z = cvt_pk_bf16(r1[0], r1[1]); w.w = cvt_pk_bf16(r1[2], r1[3]);
                    *(PG8_GAS u32x4*)(out + off0 + (size_t)(ai * HALF + m * 16) * 64 + (size_t)bj * 2 * BM * 64) = w;
                    ss = dot2_bf16(w.x, ss); ss = dot2_bf16(w.y, ss); ss = dot2_bf16(w.z, ss); ss = dot2_bf16(w.w, ss); }
                ssv[ai][m] = ss;
            }
        }
#pragma unroll
        for (int ai = 0; ai < 2; ++ai)
#pragma unroll
            for (int m = 0; m < 4; ++m) ssv[ai][m] += __int_as_float(__builtin_amdgcn_ds_bpermute(l1, __float_as_int(ssv[ai][m])));
#pragma unroll
        for (int ai = 0; ai < 2; ++ai)
#pragma unroll
            for (int m = 0; m < 4; ++m) ssv[ai][m] += __int_as_float(__builtin_amdgcn_ds_bpermute(l2, __float_as_int(ssv[ai][m])));
        if (fq == 0) {
#pragma unroll
            for (int ai = 0; ai < 2; ++ai)
#pragma unroll
                for (int m = 0; m < 4; ++m) (void)__hip_atomic_fetch_add((PG8_GAS rss_t*)rss_out + row0 + ai * HALF + m * 16, (rss_t)(ssv[ai][m] * 1048576.0f + 0.5f), __ATOMIC_RELAXED, __HIP_MEMORY_SCOPE_AGENT);
        }
    }
};
struct EpiF32Tile {
    static constexpr bool PERM = false, AFTER_DRAIN = false, ROWTAB = false;
    float* C;
    __device__ __forceinline__ void operator()(const f32x4 (&acc)[2][2][4][2], const Unit& u, int wr, int wc, int fr, int fq) const {
        float* base = C + (size_t)(u.pm * BM + wr * 64 + fr) * 256 + wc * 32 + 4 * fq;
#pragma unroll
        for (int ai = 0; ai < 2; ++ai)
#pragma unroll
            for (int m = 0; m < 4; ++m) { float* rowp = base + (size_t)(ai * HALF + m * 16) * 256;
#pragma unroll
                for (int bj = 0; bj < 2; ++bj)
#pragma unroll
                    for (int n = 0; n < 2; ++n) *(f32x4*)(rowp + bj * HALF + n * 16) = acc[ai][bj][m][n]; }
    }
};
template <int KIND> struct EpiBf16K {
    static constexpr bool PERM = true, AFTER_DRAIN = false, ROWTAB = (KIND == 0);
    bf16_t* O; const float* cs; float scale; int mrows; const rss_t* rss; float* gat; const float* gbias; PG8_LAS float* tab;
    __device__ __forceinline__ void fill_table(int pm, int par, int tid) const { if (tid < 256) tab[par * 256 + tid] = rms_scale(rss, pm * BM + tid); }
    __device__ __forceinline__ void operator()(const f32x4 (&acc)[2][2][4][2], const Unit& u, int wr, int wc, int fr, int fq, int par = 0) const {
        bf16_t* base; int ldc; const float* csp = nullptr;
        if (KIND == 0) { ldc = 5376; base = O + (size_t)u.pm * BM * ldc + u.pn * BM; }
        else if (KIND == 1) { ldc = 512; const int h = u.pn >> 1; base = O + ((size_t)h * mrows + (size_t)u.pm * BM) * 512 + (u.pn & 1) * BM; }
        else if (KIND == 2) { ldc = 256; const int h = u.pm >> 1; base = O + ((size_t)(h * 16 + u.pn) * 512 + (size_t)(u.pm & 1) * BM) * 256; }
        else if (KIND == 3) { ldc = 2048; const int g = u.pm >> 7, pl = u.pm & 127; base = O + (size_t)pl * BM * 2048 + g * BM; csp = cs + g * BM; }
        else if (KIND == 4) { ldc = 2048; const int z = u.pm >> 3, pl = u.pm & 7, h = z >> 4, b = z & 15; base = O + ((size_t)b * 2048 + (size_t)pl * BM) * 2048 + h * 512 + u.pn * BM; }
        else if (KIND == 5) { ldc = 2048; const int h = u.pm >> 4, b = u.pm & 15; base = O + (size_t)(b * 4 + h) * BM * 2048 + u.pn * BM; }
        else { ldc = 1024; const int h = u.pm >> 3, np = u.pm & 7; base = O + ((size_t)u.pn * 2048 + (size_t)np * BM) * 1024 + h * BM; }
        const int row0 = wr * 64 + fr, col0 = wc * 32 + 8 * fq;
        float rsv[2][4];
#pragma unroll
        for (int ai = 0; ai < 2; ++ai)
#pragma unroll
            for (int m = 0; m < 4; ++m) rsv[ai][m] = (KIND == 0) ? scale * tab[par * 256 + row0 + ai * HALF + m * 16] : ((KIND == 1 && rss) ? scale * rms_scale(rss, u.pm * BM + row0 + ai * HALF + m * 16) : scale);
        if (KIND == 0 && u.pn == 20) {
            if (wc == 0 && fq == 0) { const f32x4 bi = *(const f32x4*)gbias, bf = *(const f32x4*)(gbias + 4);
#pragma unroll
                for (int ai = 0; ai < 2; ++ai)
#pragma unroll
                    for (int m = 0; m < 4; ++m) { const f32x4 li = acc[ai][0][m][0] * rsv[ai][m] + bi, xf = acc[ai][0][m][1] * rsv[ai][m] + bf; f32x4 lf;
#pragma unroll
                        for (int j = 0; j < 4; ++j) lf[j] = fminf(xf[j], 0.f) - log1pf(expf(-fabsf(xf[j])));
                        float* gp = gat + (size_t)(u.pm * BM + row0 + ai * HALF + m * 16) * 8; *(f32x4*)gp = li; *(f32x4*)(gp + 4) = lf; } }
            return; }
        bf16_t* rowp = base + (size_t)row0 * ldc + col0; size_t rstep = (size_t)ldc, bjstep = HALF;
        if (KIND == 3) {
            const int g = u.pm >> 7, pl = u.pm & 127; rowp = O + ((size_t)(pl * 32 + 4 * g + (wc >> 1)) * BM + row0) * 64 + (wc & 1) * 32 + 8 * fq; rstep = 64; bjstep = (size_t)2 * BM * 64; }
#pragma unroll
        for (int bj = 0; bj < 2; ++bj) {
            f32x4 s0 = (f32x4){1.f, 1.f, 1.f, 1.f}, s1 = s0;
            if (KIND == 3) { s0 = *(const f32x4*)(csp + col0 + bj * HALF); s1 = *(const f32x4*)(csp + col0 + bj * HALF + 4); }
            bf16_t* rp = rowp + bj * bjstep;
#pragma unroll
            for (int ai = 0; ai < 2; ++ai) {
#pragma unroll
                for (int m = 0; m < 4; ++m) { const f32x4 v0 = acc[ai][bj][m][0] * s0 * rsv[ai][m], v1 = acc[ai][bj][m][1] * s1 * rsv[ai][m];
                    u32x4 w; w.x = cvt_pk_bf16(v0[0], v0[1]); w.y = cvt_pk_bf16(v0[2], v0[3]); w.z = cvt_pk_bf16(v1[0], v1[1]); w.w = cvt_pk_bf16(v1[2], v1[3]);
                    *(PG8_GAS u32x4*)rp = w; rp += 16 * rstep; asm volatile("" : "+v"(rp)); }
                rp += 64 * rstep; asm volatile("" : "+v"(rp)); }
        }
    }
};

struct EpiSoftmaxP {
    static constexpr bool PERM = true, AFTER_DRAIN = false, ROWTAB = false;
    bf16_t* P; const rss_t* rss; PG8_LAS float* scr;
    __device__ __forceinline__ void operator()(f32x4 (&acc)[2][2][4][2], const Unit& u, int wr, int wc, int fr, int fq) const {
        const int l1 = (((fq ^ 1) << 4) | fr) << 2, l2 = (((fq ^ 2) << 4) | fr) << 2, rowb = wr * 64 + fr;
        unsigned wo_ = (unsigned)(rowb * 4 + wc) * 4u, ro_ = (unsigned)(rowb * 4) * 4u; asm volatile("" : "+v"(wo_), "+v"(ro_));
        PG8_LAS float* wb = (PG8_LAS float*)((PG8_LAS unsigned char*)scr + wo_);
        const PG8_LAS float* rb = (const PG8_LAS float*)((const PG8_LAS unsigned char*)scr + ro_);
#pragma unroll
        for (int ai = 0; ai < 2; ++ai)
#pragma unroll
            for (int m = 0; m < 4; ++m) { const int row = rowb + ai * HALF + m * 16; const float rs = rms_scale(rss, u.pm * BM + row); float mx = -3.0e38f;
#pragma unroll
                for (int bj = 0; bj < 2; ++bj)
#pragma unroll
                    for (int n = 0; n < 2; ++n) { const f32x4 v = acc[ai][bj][m][n] * rs; acc[ai][bj][m][n] = v; mx = fmaxf(mx, fmaxf(fmaxf(v[0], v[1]), fmaxf(v[2], v[3]))); }
                mx = fmaxf(mx, __int_as_float(__builtin_amdgcn_ds_bpermute(l1, __float_as_int(mx)))); mx = fmaxf(mx, __int_as_float(__builtin_amdgcn_ds_bpermute(l2, __float_as_int(mx))));
                if (fq == 0) wb[(ai * HALF + m * 16) * 4] = mx; }
        asm volatile("s_waitcnt lgkmcnt(0)" ::: "memory"); __builtin_amdgcn_s_barrier(); asm volatile("" ::: "memory");
#pragma unroll
        for (int ai = 0; ai < 2; ++ai)
#pragma unroll
            for (int m = 0; m < 4; ++m) { const f32x4 mv = *(const PG8_LAS f32x4*)(rb + (ai * HALF + m * 16) * 4);
                const float rmax = fmaxf(fmaxf(mv[0], mv[1]), fmaxf(mv[2], mv[3])) * 1.4426950408889634f; float sm = 0.f;
#pragma unroll
                for (int bj = 0; bj < 2; ++bj)
#pragma unroll
                    for (int n = 0; n < 2; ++n) { f32x4 e;
#pragma unroll
                        for (int j = 0; j < 4; ++j) e[j] = __builtin_amdgcn_exp2f(acc[ai][bj][m][n][j] * 1.4426950408889634f - rmax);
                        acc[ai][bj][m][n] = e; sm += (e[0] + e[1]) + (e[2] + e[3]); }
                sm += __int_as_float(__builtin_amdgcn_ds_bpermute(l1, __float_as_int(sm))); sm += __int_as_float(__builtin_amdgcn_ds_bpermute(l2, __float_as_int(sm)));
                if (fq == 0) wb[1024 + (ai * HALF + m * 16) * 4] = sm; }
        asm volatile("s_waitcnt lgkmcnt(0)" ::: "memory"); __builtin_amdgcn_s_barrier(); asm volatile("" ::: "memory");
        bf16_t* rp = P + ((size_t)(u.pm * 16 + 4 * u.pn + (wc >> 1)) * BM + rowb) * 64 + (wc & 1) * 32 + 8 * fq;
#pragma unroll
        for (int ai = 0; ai < 2; ++ai) {
#pragma unroll
            for (int m = 0; m < 4; ++m) { const f32x4 sv = *(const PG8_LAS f32x4*)(rb + 1024 + (ai * HALF + m * 16) * 4); const float inv = 1.0f / ((sv[0] + sv[1]) + (sv[2] + sv[3]));
#pragma unroll
                for (int bj = 0; bj < 2; ++bj) { const f32x4 v0 = acc[ai][bj][m][0] * inv, v1 = acc[ai][bj][m][1] * inv;
                    u32x4 w; w.x = cvt_pk_bf16(v0[0], v0[1]); w.y = cvt_pk_bf16(v0[2], v0[3]); w.z = cvt_pk_bf16(v1[0], v1[1]); w.w = cvt_pk_bf16(v1[2], v1[3]);
                    *(PG8_GAS u32x4*)(rp + (size_t)bj * 2 * BM * 64) = w; }
                rp += (size_t)16 * 64; asm volatile("" : "+v"(rp)); }
            rp += (size_t)64 * 64; asm volatile("" : "+v"(rp)); }
    }
};

template <class Epi, class Sched, bool ALIGN_EPI = false, bool SP2 = false, bool PEEL = false>
__device__ __forceinline__ void gemm_phase(PG8_LAS unsigned char* lds, const Gemm g, const Sched& S, const Epi& E, int tid_in) {
    int tid_ = tid_in; asm volatile("" : "+v"(tid_));
    const int tid = tid_, wid = __builtin_amdgcn_readfirstlane(tid >> 6), lane = tid & 63, wr = wid >> 2, wc = wid & 3, fr = lane & 15, fq = lane >> 4;
    int K_ = g.K; asm volatile("" : "+s"(K_));
    const int K = K_, nt = K / BK;
    unsigned voffA[2], voffB[2];
#pragma unroll
    for (int i = 0; i < 2; ++i) { int R, C; stage_rc(tid * 16 + i * 8192, R, C); const int Rb = Epi::PERM ? ((R & ~31) + perm32(R & 31)) : R;
        voffA[i] = (unsigned)(R * (g.ablk ? BK : K) + C) * 2u; voffB[i] = (unsigned)(Rb * (g.bblk ? BK : K) + C) * 2u; }
    const size_t kstep = (size_t)(BK * 2);
    const size_t hstep = (size_t)HALF * K * 2;
    const size_t tstep = 2 * hstep;
    const size_t kstepB = g.bblk ? (size_t)(BM * BK * 2) : kstep, hstepB = g.bblk ? (size_t)(HALF * BK * 2) : hstep;
    const size_t kstepA = g.ablk ? (size_t)(BM * BK * 2) : kstep, hstepA = g.ablk ? (size_t)(HALF * BK * 2) : hstep;
    const unsigned ldsw = (unsigned)wid * 1024u;
    const int aoff = lds_byte(wr * 64 + fr, fq * 8), boff = lds_byte(wc * 32 + fr, fq * 8);
#define PG8_SA(b, h) (((b) * 2 + (h)) * HTB)
#define PG8_SB(b, h) ((4 + (b) * 2 + (h)) * HTB)
#define PG8_STAGE(bufoff, gbase, voff) do { _Pragma("unroll") for (int _i = 0; _i < 2; ++_i) { asm volatile("" : "+v"((voff)[_i])); \
        __builtin_amdgcn_global_load_lds((const unsigned*)((const char*)(gbase) + (voff)[_i]), (PG8_LAS unsigned*)(lds + (bufoff) + ldsw + _i * 8192), 16, 0, 0); } } while (0)
#define PG8_LDA(dst, b, h) do { _Pragma("unroll") for (int m = 0; m < 4; ++m) _Pragma("unroll") for (int k = 0; k < 2; ++k) dst[m][k] = *(const PG8_LAS bf16x8*)(lds + PG8_SA(b, h) + aoff + m * 2048 + k * 1024); } while (0)
#define PG8_LDB(dst, b, h) do { _Pragma("unroll") for (int n = 0; n < 2; ++n) _Pragma("unroll") for (int k = 0; k < 2; ++k) dst[n][k] = *(const PG8_LAS bf16x8*)(lds + PG8_SB(b, h) + boff + n * 2048 + k * 1024); } while (0)
#define PG8_MMA(ai, bj, At, Bt) do { __builtin_amdgcn_s_setprio(2); _Pragma("unroll") for (int m = 0; m < 4; ++m) _Pragma("unroll") for (int n = 0; n < 2; ++n) _Pragma("unroll") for (int k = 0; k < 2; ++k) \
        acc[ai][bj][m][n] = __builtin_amdgcn_mfma_f32_16x16x32_bf16(Bt[n][k], At[m][k], acc[ai][bj][m][n], 0, 0, 0); __builtin_amdgcn_s_setprio(0); } while (0)
#define PG8_MMAZ(ZC, ai, bj, At, Bt) do { __builtin_amdgcn_s_setprio(2); _Pragma("unroll") for (int m = 0; m < 4; ++m) _Pragma("unroll") for (int n = 0; n < 2; ++n) _Pragma("unroll") for (int k = 0; k < 2; ++k) \
        acc[ai][bj][m][n] = __builtin_amdgcn_mfma_f32_16x16x32_bf16(Bt[n][k], At[m][k], ((ZC) && k == 0) ? (f32x4){0.f, 0.f, 0.f, 0.f} : acc[ai][bj][m][n], 0, 0, 0); __builtin_amdgcn_s_setprio(0); } while (0)
#define PG8_WAIT_V(n) asm volatile("s_waitcnt vmcnt(" #n ")" ::: "memory")
#define PG8_WAIT_L(n) asm volatile("s_waitcnt lgkmcnt(" #n ")" ::: "memory")
#define PG8_BAR __builtin_amdgcn_s_barrier()
#define PG8_SCHED __builtin_amdgcn_sched_barrier(0)
#define PG8_BIDX(u) ((size_t)((g.nMz ? ((u).pm / g.nMz) * g.nN : 0) + (u).pn))
#define PG8_KITER(ZC) do { \
            const bool last = (t == nt - 2); \
            const char* a1 = cA + (size_t)(t + 1) * kstepA; \
            const char* a2 = last ? nA : cA + (size_t)(t + 2) * kstepA; const char* b2 = last ? nB : cB + (size_t)(t + 2) * kstepB; \
            const char* a3 = a2 + kstepA; const char* b3 = b2 + kstepB; \
            if (last && has_next) S.a_ready(nxt); \
            if constexpr (Epi::ROWTAB) { if (last && has_next && nxt.pm != cur.pm) E.fill_table(nxt.pm, rtpar ^ 1, tid); } \
            PG8_LDB(B0, 0, 0); PG8_LDB(B1, 0, 1); PG8_SCHED; PG8_LDA(At, 0, 0); PG8_STAGE(PG8_SA(1, 1), a1 + hstepA, voffA); \
            PG8_WAIT_V(8); PG8_WAIT_L(0); PG8_BAR; PG8_MMAZ(ZC, 0, 0, At, B0); PG8_MMAZ(ZC, 0, 1, At, B1); PG8_BAR; PG8_SCHED; \
            PG8_LDA(At, 0, 1); PG8_STAGE(PG8_SB(0, 0), b2, voffB); PG8_STAGE(PG8_SB(0, 1), b2 + hstepB, voffB); PG8_STAGE(PG8_SA(0, 0), a2, voffA); \
            PG8_WAIT_V(8); PG8_WAIT_L(0); PG8_BAR; PG8_MMAZ(ZC, 1, 0, At, B0); PG8_MMAZ(ZC, 1, 1, At, B1); PG8_BAR; PG8_SCHED; \
            PG8_LDB(B0, 1, 0); PG8_LDB(B1, 1, 1); PG8_SCHED; PG8_LDA(At, 1, 0); PG8_STAGE(PG8_SA(0, 1), a2 + hstepA, voffA); \
            PG8_WAIT_V(8); PG8_WAIT_L(0); PG8_BAR; PG8_MMA(0, 0, At, B0); PG8_MMA(0, 1, At, B1); PG8_BAR; PG8_SCHED; \
            PG8_LDA(At, 1, 1); PG8_STAGE(PG8_SB(1, 0), b3, voffB); PG8_STAGE(PG8_SB(1, 1), b3 + hstepB, voffB); PG8_STAGE(PG8_SA(1, 0), a3, voffA); \
            PG8_WAIT_V(8); PG8_WAIT_L(0); PG8_BAR; PG8_MMA(1, 0, At, B0); PG8_MMA(1, 1, At, B1); PG8_BAR; PG8_SCHED; \
        } while (0)
    Unit cur, nxt; int ui = 0;
    if (!S.next(0, cur)) return;
#define PG8_ZERO_ACC() do { f16x4_t z_ = (f16x4_t){(_Float16)0, (_Float16)0, (_Float16)0, (_Float16)0}; asm volatile("" : "+v"(z_)); \
          \
        acc[0][0][0][0] = __builtin_amdgcn_mfma_f32_4x4x4f16(z_, z_, (f32x4){0.f, 0.f, 0.f, 0.f}, 4, 0, 0); acc[0][0][0][1] = __builtin_amdgcn_mfma_f32_4x4x4f16(z_, z_, (f32x4){0.f, 0.f, 0.f, 0.f}, 4, 1, 0); \
        acc[0][0][1][0] = __builtin_amdgcn_mfma_f32_4x4x4f16(z_, z_, (f32x4){0.f, 0.f, 0.f, 0.f}, 4, 2, 0); acc[0][0][1][1] = __builtin_amdgcn_mfma_f32_4x4x4f16(z_, z_, (f32x4){0.f, 0.f, 0.f, 0.f}, 4, 3, 0); \
        acc[0][0][2][0] = __builtin_amdgcn_mfma_f32_4x4x4f16(z_, z_, (f32x4){0.f, 0.f, 0.f, 0.f}, 4, 4, 0); acc[0][0][2][1] = __builtin_amdgcn_mfma_f32_4x4x4f16(z_, z_, (f32x4){0.f, 0.f, 0.f, 0.f}, 4, 5, 0); \
        acc[0][0][3][0] = __builtin_amdgcn_mfma_f32_4x4x4f16(z_, z_, (f32x4){0.f, 0.f, 0.f, 0.f}, 4, 6, 0); acc[0][0][3][1] = __builtin_amdgcn_mfma_f32_4x4x4f16(z_, z_, (f32x4){0.f, 0.f, 0.f, 0.f}, 4, 7, 0); \
        acc[0][1][0][0] = __builtin_amdgcn_mfma_f32_4x4x4f16(z_, z_, (f32x4){0.f, 0.f, 0.f, 0.f}, 4, 8, 0); acc[0][1][0][1] = __builtin_amdgcn_mfma_f32_4x4x4f16(z_, z_, (f32x4){0.f, 0.f, 0.f, 0.f}, 4, 9, 0); \
        acc[0][1][1][0] = __builtin_amdgcn_mfma_f32_4x4x4f16(z_, z_, (f32x4){0.f, 0.f, 0.f, 0.f}, 4, 10, 0); acc[0][1][1][1] = __builtin_amdgcn_mfma_f32_4x4x4f16(z_, z_, (f32x4){0.f, 0.f, 0.f, 0.f}, 4, 11, 0); \
        acc[0][1][2][0] = __builtin_amdgcn_mfma_f32_4x4x4f16(z_, z_, (f32x4){0.f, 0.f, 0.f, 0.f}, 4, 12, 0); acc[0][1][2][1] = __builtin_amdgcn_mfma_f32_4x4x4f16(z_, z_, (f32x4){0.f, 0.f, 0.f, 0.f}, 4, 13, 0); \
        acc[0][1][3][0] = __builtin_amdgcn_mfma_f32_4x4x4f16(z_, z_, (f32x4){0.f, 0.f, 0.f, 0.f}, 4, 14, 0); acc[0][1][3][1] = __builtin_amdgcn_mfma_f32_4x4x4f16(z_, z_, (f32x4){0.f, 0.f, 0.f, 0.f}, 4, 15, 0); \
        acc[1][0][0][0] = __builtin_amdgcn_mfma_f32_4x4x4f16(z_, z_, (f32x4){0.f, 0.f, 0.f, 0.f}, 4, 0, 1); acc[1][0][0][1] = __builtin_amdgcn_mfma_f32_4x4x4f16(z_, z_, (f32x4){0.f, 0.f, 0.f, 0.f}, 4, 1, 1); \
        acc[1][0][1][0] = __builtin_amdgcn_mfma_f32_4x4x4f16(z_, z_, (f32x4){0.f, 0.f, 0.f, 0.f}, 4, 2, 1); acc[1][0][1][1] = __builtin_amdgcn_mfma_f32_4x4x4f16(z_, z_, (f32x4){0.f, 0.f, 0.f, 0.f}, 4, 3, 1); \
        acc[1][0][2][0] = __builtin_amdgcn_mfma_f32_4x4x4f16(z_, z_, (f32x4){0.f, 0.f, 0.f, 0.f}, 4, 4, 1); acc[1][0][2][1] = __builtin_amdgcn_mfma_f32_4x4x4f16(z_, z_, (f32x4){0.f, 0.f, 0.f, 0.f}, 4, 5, 1); \
        acc[1][0][3][0] = __builtin_amdgcn_mfma_f32_4x4x4f16(z_, z_, (f32x4){0.f, 0.f, 0.f, 0.f}, 4, 6, 1); acc[1][0][3][1] = __builtin_amdgcn_mfma_f32_4x4x4f16(z_, z_, (f32x4){0.f, 0.f, 0.f, 0.f}, 4, 7, 1); \
        acc[1][1][0][0] = __builtin_amdgcn_mfma_f32_4x4x4f16(z_, z_, (f32x4){0.f, 0.f, 0.f, 0.f}, 4, 8, 1); acc[1][1][0][1] = __builtin_amdgcn_mfma_f32_4x4x4f16(z_, z_, (f32x4){0.f, 0.f, 0.f, 0.f}, 4, 9, 1); \
        acc[1][1][1][0] = __builtin_amdgcn_mfma_f32_4x4x4f16(z_, z_, (f32x4){0.f, 0.f, 0.f, 0.f}, 4, 10, 1); acc[1][1][1][1] = __builtin_amdgcn_mfma_f32_4x4x4f16(z_, z_, (f32x4){0.f, 0.f, 0.f, 0.f}, 4, 11, 1); \
        acc[1][1][2][0] = __builtin_amdgcn_mfma_f32_4x4x4f16(z_, z_, (f32x4){0.f, 0.f, 0.f, 0.f}, 4, 12, 1); acc[1][1][2][1] = __builtin_amdgcn_mfma_f32_4x4x4f16(z_, z_, (f32x4){0.f, 0.f, 0.f, 0.f}, 4, 13, 1); \
        acc[1][1][3][0] = __builtin_amdgcn_mfma_f32_4x4x4f16(z_, z_, (f32x4){0.f, 0.f, 0.f, 0.f}, 4, 14, 1); acc[1][1][3][1] = __builtin_amdgcn_mfma_f32_4x4x4f16(z_, z_, (f32x4){0.f, 0.f, 0.f, 0.f}, 4, 15, 1); } while (0)
    f32x4 acc[2][2][4][2];
    if constexpr (!(PEEL && SP2)) PG8_ZERO_ACC();
    bf16x8 At[4][2], B0[2][2], B1[2][2];
    const char* cA = (const char*)g.A + (size_t)cur.pm * tstep; const char* cB = (const char*)g.Bt + PG8_BIDX(cur) * tstep;
    S.a_ready(cur);
    int rtpar = 0;
    if constexpr (Epi::ROWTAB) E.fill_table(cur.pm, 0, tid);
    if constexpr (SP2) {
        PG8_STAGE(PG8_SB(0, 0), cB, voffB); PG8_STAGE(PG8_SB(0, 1), cB + hstepB, voffB); PG8_STAGE(PG8_SA(0, 0), cA, voffA); PG8_STAGE(PG8_SA(0, 1), cA + hstepA, voffA);
        if (wr == 1) PG8_BAR;
        PG8_WAIT_V(2); PG8_BAR;
        PG8_STAGE(PG8_SB(1, 0), cB + kstepB, voffB); PG8_STAGE(PG8_SA(1, 0), cA + kstepA, voffA); PG8_STAGE(PG8_SB(1, 1), cB + hstepB + kstepB, voffB);
        PG8_WAIT_V(6); PG8_BAR;
    } else {
        PG8_STAGE(PG8_SB(0, 0), cB, voffB); PG8_STAGE(PG8_SA(0, 0), cA, voffA); PG8_STAGE(PG8_SB(0, 1), cB + hstepB, voffB); PG8_STAGE(PG8_SA(0, 1), cA + hstepA, voffA);
        if (wr == 1) PG8_BAR;
        PG8_WAIT_V(4); PG8_BAR;
        PG8_STAGE(PG8_SB(1, 0), cB + kstepB, voffB); PG8_STAGE(PG8_SA(1, 0), cA + kstepA, voffA); PG8_STAGE(PG8_SB(1, 1), cB + hstepB + kstepB, voffB);
        PG8_WAIT_V(6); PG8_BAR;
    }
    for (;;) {
        const bool has_next = S.next(ui + 1, nxt);
        const char* nA = has_next ? (const char*)g.A + (size_t)nxt.pm * tstep : cA; const char* nB = has_next ? (const char*)g.Bt + PG8_BIDX(nxt) * tstep : cB;
        if constexpr (PEEL && SP2) { int t = 0; PG8_KITER(true); for (t = 2; t < nt; t += 2) PG8_KITER(false); } else
        for (int t = 0; t < nt; t += 2) {
            const bool last = (t == nt - 2);
            const char* a1 = cA + (size_t)(t + 1) * kstepA;
            const char* a2 = last ? nA : cA + (size_t)(t + 2) * kstepA; const char* b2 = last ? nB : cB + (size_t)(t + 2) * kstepB;
            const char* a3 = a2 + kstepA; const char* b3 = b2 + kstepB;
            if (last && has_next) S.a_ready(nxt);
            if constexpr (Epi::ROWTAB) { if (last && has_next && nxt.pm != cur.pm) E.fill_table(nxt.pm, rtpar ^ 1, tid); }
            if constexpr (SP2) {
            PG8_LDB(B0, 0, 0); PG8_LDB(B1, 0, 1); PG8_SCHED; PG8_LDA(At, 0, 0); PG8_STAGE(PG8_SA(1, 1), a1 + hstepA, voffA);
            PG8_WAIT_V(8); PG8_WAIT_L(0); PG8_BAR; PG8_MMA(0, 0, At, B0); PG8_MMA(0, 1, At, B1); PG8_BAR; PG8_SCHED;
            PG8_LDA(At, 0, 1); PG8_STAGE(PG8_SB(0, 0), b2, voffB); PG8_STAGE(PG8_SB(0, 1), b2 + hstepB, voffB); PG8_STAGE(PG8_SA(0, 0), a2, voffA);
            PG8_WAIT_V(8); PG8_WAIT_L(0); PG8_BAR; PG8_MMA(1, 0, At, B0); PG8_MMA(1, 1, At, B1); PG8_BAR; PG8_SCHED;
            PG8_LDB(B0, 1, 0); PG8_LDB(B1, 1, 1); PG8_SCHED; PG8_LDA(At, 1, 0); PG8_STAGE(PG8_SA(0, 1), a2 + hstepA, voffA);
            PG8_WAIT_V(8); PG8_WAIT_L(0); PG8_BAR; PG8_MMA(0, 0, At, B0); PG8_MMA(0, 1, At, B1); PG8_BAR; PG8_SCHED;
            PG8_LDA(At, 1, 1); PG8_STAGE(PG8_SB(1, 0), b3, voffB); PG8_STAGE(PG8_SB(1, 1), b3 + hstepB, voffB); PG8_STAGE(PG8_SA(1, 0), a3, voffA);
            PG8_WAIT_V(8); PG8_WAIT_L(0); PG8_BAR; PG8_MMA(1, 0, At, B0); PG8_MMA(1, 1, At, B1); PG8_BAR; PG8_SCHED;
            } else {
            PG8_LDB(B0, 0, 0); PG8_SCHED; PG8_LDA(At, 0, 0); PG8_STAGE(PG8_SA(1, 1), a1 + hstepA, voffA);
            PG8_WAIT_L(8); PG8_BAR; PG8_WAIT_L(0); PG8_MMA(0, 0, At, B0); PG8_BAR; PG8_SCHED;
            PG8_LDB(B1, 0, 1); PG8_STAGE(PG8_SB(0, 0), b2, voffB);
            PG8_BAR; PG8_WAIT_L(0); PG8_MMA(0, 1, At, B1); PG8_BAR;
            PG8_LDA(At, 0, 1); PG8_STAGE(PG8_SA(0, 0), a2, voffA);
            PG8_BAR; PG8_WAIT_L(0); PG8_MMA(1, 0, At, B0); PG8_BAR; PG8_SCHED;
            PG8_STAGE(PG8_SB(0, 1), b2 + hstepB, voffB);
            PG8_WAIT_V(6); PG8_BAR; PG8_MMA(1, 1, At, B1); PG8_BAR;
            PG8_LDB(B0, 1, 0); PG8_SCHED; PG8_LDA(At, 1, 0); PG8_STAGE(PG8_SA(0, 1), a2 + hstepA, voffA);
            PG8_WAIT_L(8); PG8_BAR; PG8_WAIT_L(0); PG8_MMA(0, 0, At, B0); PG8_BAR; PG8_SCHED;
            PG8_LDB(B1, 1, 1); PG8_STAGE(PG8_SB(1, 0), b3, voffB);
            PG8_BAR; PG8_WAIT_L(0); PG8_MMA(0, 1, At, B1); PG8_BAR;
            PG8_LDA(At, 1, 1); PG8_STAGE(PG8_SA(1, 0), a3, voffA);
            PG8_BAR; PG8_WAIT_L(0); PG8_MMA(1, 0, At, B0); PG8_BAR; PG8_SCHED;
            PG8_STAGE(PG8_SB(1, 1), b3 + hstepB, voffB);
            PG8_WAIT_V(6); PG8_BAR; PG8_MMA(1, 1, At, B1); PG8_BAR;
            }
        }
        if constexpr (ALIGN_EPI) { if (wr == 0) PG8_BAR; }
        { int le_; asm volatile("v_mbcnt_lo_u32_b32 %0, -1, 0\n\tv_mbcnt_hi_u32_b32 %0, -1, %0" : "=v"(le_)); const int fre = le_ & 15, fqe = le_ >> 4;
          if constexpr (Epi::ROWTAB) E(acc, cur, wr, wc, fre, fqe, rtpar); else E(acc, cur, wr, wc, fre, fqe); }
        S.done(cur);
        if (!has_next) break;
        if constexpr (!(PEEL && SP2)) PG8_ZERO_ACC();
        if constexpr (Epi::ROWTAB) { if (nxt.pm != cur.pm) rtpar ^= 1; }
        cur = nxt; cA = nA; cB = nB; ++ui;
        if constexpr (ALIGN_EPI) { if (wr == 1) PG8_BAR; }
    }
    PG8_WAIT_V(0);
    if constexpr (!ALIGN_EPI) { if (wr == 0) PG8_BAR; }
    PG8_BAR;
#undef PG8_SA
#undef PG8_SB
#undef PG8_STAGE
#undef PG8_LDA
#undef PG8_LDB
#undef PG8_MMA
#undef PG8_WAIT_V
#undef PG8_WAIT_L
#undef PG8_BAR
#undef PG8_SCHED
#undef PG8_BIDX
#undef PG8_KITER
#undef PG8_MMAZ
#undef PG8_ZERO_ACC
}
}

#ifndef PG8_SP2
#define PG8_SP2 true
#endif
#ifndef PG8_ALIGN
#define PG8_ALIGN true
#endif

constexpr int NWAVES = 8;
constexpr int NB = 16, SEQ = 2048, D = 2048, M = NB * SEQ, DEPTH = 4, FF = 5632, NMEM = 256, MMEM = NB * NMEM;
constexpr int DIN = 5128, DINM = 5120, ZP = 5376;
constexpr float EPS = 1e-6f;
constexpr int N_PH = 12;
constexpr int N_RSS = 18;

constexpr size_t MiB = 1u << 20;
constexpr size_t WS_CTL = 0, WS_RSS = 1 * MiB, CTL_ZERO_BYTES = 8 * MiB;
static_assert(WS_RSS + (size_t)N_RSS * M * 8 <= CTL_ZERO_BYTES, "rss inside the memset region");
constexpr size_t WS_H    = 8 * MiB;
constexpr size_t WS_U    = WS_H + 256 * MiB;
constexpr size_t WS_BIG  = WS_U + 128 * MiB;
constexpr size_t WS_X1   = WS_BIG + 352 * MiB;
constexpr size_t WS_X2   = WS_X1 + 128 * MiB;
constexpr size_t WS_HM   = WS_X2 + 64 * MiB;
constexpr size_t WS_GAT  = WS_HM + 64 * MiB;
constexpr size_t WS_KB   = WS_GAT + 1 * MiB;
constexpr size_t WS_VT   = WS_KB + 16 * MiB;
constexpr size_t WS_MEMN = WS_VT + 16 * MiB;
constexpr size_t WS_WGU1 = WS_MEMN + 16 * MiB;
constexpr size_t WS_WD1  = WS_WGU1 + 44 * MiB;
constexpr size_t WS_WGU2 = WS_WD1 + 22 * MiB;
constexpr size_t WS_WD2  = WS_WGU2 + 44 * MiB;
constexpr size_t WS_WIN  = WS_WD2 + 22 * MiB;
constexpr size_t WS_WPOOL= WS_WIN + 21 * MiB;
constexpr size_t WS_WOUT = WS_WPOOL + 1 * MiB;
constexpr size_t WS_WQ   = WS_WOUT + 8 * MiB;
constexpr size_t WS_WKV  = WS_WQ + 8 * MiB;
constexpr size_t WS_WO   = WS_WKV + 16 * MiB;
constexpr size_t WS_END  = WS_WO + 8 * MiB;
constexpr size_t WS_GT = WS_H + 128 * MiB, WS_VWT = WS_H + 192 * MiB;
constexpr int CW_TMO = 0, CW_BAR = 4096, CW_SYNC = 16384;

constexpr int RING_OFF = 0, RING_BYTES = 131072;
constexpr int LDSCTL_OFF = RING_BYTES, MISC_OFF = 147456 - 128;
constexpr int LDS_BYTES = 147456;

#define GAS __attribute__((address_space(1)))
#define LAS __attribute__((address_space(3)))
typedef unsigned short bf16;
typedef unsigned v4u __attribute__((ext_vector_type(4)));
typedef unsigned v2u __attribute__((ext_vector_type(2)));
typedef unsigned u32x4v __attribute__((ext_vector_type(4)));
typedef float f32x4 __attribute__((ext_vector_type(4)));
typedef GAS unsigned gu32;
#define RLX_AGENT __ATOMIC_RELAXED, __HIP_MEMORY_SCOPE_AGENT
#define LDS_WAIT() asm volatile("s_waitcnt lgkmcnt(0)" ::: "memory")
__device__ __forceinline__ unsigned pk2(float lo, float hi) { return pg8::cvt_pk_bf16(lo, hi); }
__device__ __forceinline__ float bflo(unsigned w) { return __uint_as_float(w << 16); }
__device__ __forceinline__ float bfhi(unsigned w) { return __uint_as_float(w & 0xffff0000u); }
__device__ __forceinline__ size_t h16_off(int m, int c) { return ((size_t)((m >> 8) * 32 + (c >> 6)) * 256 + (m & 255)) * 64 + (c & 63); }

#define XB_TMO      128
#define XB_XCNT(j)  (256  + 64 * (j))
#define XB_XSUB(j)  (1280 + 64 * (j))
#define XB_XGEN(j)  (2304 + 64 * (j))
#define XB_TOP      3328
#define XB_TOPGEN   3392
#define XCD_BAR_WORDS 3456
#define XB_SPIN_CAP (1u << 18)

__device__ __forceinline__ unsigned xb_ld(unsigned* p)              { return __hip_atomic_load(p, __ATOMIC_RELAXED, __HIP_MEMORY_SCOPE_AGENT); }
__device__ __forceinline__ unsigned xb_add(unsigned* p, unsigned v) { return __hip_atomic_fetch_add(p, v, __ATOMIC_RELAXED, __HIP_MEMORY_SCOPE_AGENT); }
__device__ __forceinline__ unsigned xb_xcc_id() { return (unsigned)__builtin_amdgcn_s_getreg((3 << 11) | 20) & 0xFu; }
#define XB_SPIN(cond, bar) do { unsigned _sp = 0; while (cond) { __builtin_amdgcn_s_sleep(1); \
    if ((++_sp & 255u) == 0u) { if (xb_ld(&(bar)[XB_TMO])) break; if (_sp > XB_SPIN_CAP) { atomicAdd(&(bar)[XB_TMO], 1u); break; } } } } while (0)

struct XcdBarrier { unsigned* bar; unsigned x; volatile LAS unsigned* st; };

__device__ __forceinline__ XcdBarrier xcd_barrier_post(unsigned* bar, volatile LAS unsigned* st) {
    XcdBarrier b; b.bar = bar; b.x = xb_xcc_id(); b.st = st;
    if (threadIdx.x == 0) (void)xb_add(&bar[XB_XCNT(b.x)], 1u);
    return b;
}
__device__ __forceinline__ void xcd_barrier_complete(unsigned* bar, unsigned x, unsigned& nloc, unsigned& nx) {
    const unsigned G = gridDim.x * gridDim.y * gridDim.z;
    unsigned sum, cnt, mine, sp = 0u;
    for (;;) {
        sum = 0u; cnt = 0u; mine = 0u;
#pragma unroll
        for (unsigned j = 0; j < 16; ++j) { const unsigned c = xb_ld(&bar[XB_XCNT(j)]); sum += c; cnt += (c > 0u) ? 1u : 0u; mine = (j == x) ? c : mine; }
        if (sum == G) break;
        __builtin_amdgcn_s_sleep(1);
        if ((++sp & 255u) == 0u) { if (xb_ld(&bar[XB_TMO])) break; if (sp > XB_SPIN_CAP) { atomicAdd(&bar[XB_TMO], 1u); break; } }
    }
    nloc = mine > 0u ? mine : 1u; nx = cnt > 0u ? cnt : 1u;
}
__device__ __forceinline__ void xcd_barrier(const XcdBarrier& b, int tid) {
    asm volatile("s_waitcnt vmcnt(0)" ::: "memory");
    __syncthreads();
    if (tid == 0) {
        unsigned* bar = b.bar;
        __builtin_amdgcn_s_waitcnt(0);
        unsigned nloc = b.st[0], nx = b.st[1];
        if (nloc == 0u) { xcd_barrier_complete(bar, b.x, nloc, nx); b.st[0] = nloc; b.st[1] = nx; }
        const unsigned old = xb_add(&bar[XB_XSUB(b.x)], 1u);
        const unsigned gen = old / nloc;
        if (old + 1u == (gen + 1u) * nloc) {
            __builtin_amdgcn_fence(__ATOMIC_RELEASE, "agent");
            asm volatile("s_waitcnt vmcnt(0)" ::: "memory");
            const unsigned og = xb_add(&bar[XB_TOP], 1u);
            const unsigned tg = og / nx;
            if (og + 1u == (tg + 1u) * nx) xb_add(&bar[XB_TOPGEN], 1u);
            else XB_SPIN(xb_ld(&bar[XB_TOPGEN]) == tg, bar);
            __builtin_amdgcn_fence(__ATOMIC_ACQUIRE, "agent");
            xb_add(&bar[XB_XGEN(b.x)], 1u);
            asm volatile("s_waitcnt vmcnt(0)" ::: "memory");
        } else {
            XB_SPIN(xb_ld(&bar[XB_XGEN(b.x)]) == gen, bar);
            __builtin_amdgcn_fence(__ATOMIC_ACQUIRE, "agent");
            asm volatile("s_waitcnt vmcnt(0)" ::: "memory");
        }
    }
    __syncthreads();
}

__device__ __forceinline__ float shfl_xor_l(float v, int m, int lane) { return __int_as_float(__builtin_amdgcn_ds_bpermute((lane ^ m) << 2, __float_as_int(v))); }
__device__ __forceinline__ float shfl_up_l(float v, int o, int lane) { return __int_as_float(__builtin_amdgcn_ds_bpermute((lane - o) << 2, __float_as_int(v))); }
__device__ __forceinline__ float wave_sum(float v, int lane) {
#pragma unroll
    for (int o = 1; o < 64; o <<= 1) v += shfl_xor_l(v, o, lane);
    return v;
}
__device__ __forceinline__ float wave_max(float v, int lane) {
#pragma unroll
    for (int o = 1; o < 64; o <<= 1) v = fmaxf(v, shfl_xor_l(v, o, lane));
    return v;
}
__device__ __forceinline__ void transpose_item(const float* W, int ldw, int K, int N, bf16* WT, int mode, LAS float* scr, int item, int lane, const float* gain = nullptr) {
    const int nblk = N / 32, kb = item / nblk, nb = item % nblk, k0 = 64 * kb, n0 = 32 * nb;
    const int r0 = (mode == 0) ? n0 : ((n0 >> 7) * 256 + (mode == 2 ? 128 : 0) + (n0 & 127));
#pragma unroll 8
    for (int i = 0; i < 32; ++i) { const int kk = 2 * i + (lane >> 5); scr[kk * 33 + (lane & 31)] = W[(size_t)(k0 + kk) * ldw + n0 + (lane & 31)]; }
    LDS_WAIT(); asm volatile("" ::: "memory");
    const int c = lane & 7;
    f32x4 ga = (f32x4){1.f, 1.f, 1.f, 1.f}, gb = ga; if (gain) { ga = *(const f32x4*)(gain + k0 + 8 * c); gb = *(const f32x4*)(gain + k0 + 8 * c + 4); }
#pragma unroll
    for (int j = 0; j < 4; ++j) { const int n = (lane >> 3) + 8 * j; const LAS float* s = scr + (8 * c) * 33 + n;
        v4u o; o.x = pk2(s[0 * 33] * ga.x, s[1 * 33] * ga.y); o.y = pk2(s[2 * 33] * ga.z, s[3 * 33] * ga.w); o.z = pk2(s[4 * 33] * gb.x, s[5 * 33] * gb.y); o.w = pk2(s[6 * 33] * gb.z, s[7 * 33] * gb.w);
        *(GAS v4u*)(WT + (size_t)(r0 + n) * K + k0 + 8 * c) = o; }
    LDS_WAIT(); asm volatile("" ::: "memory");
}
struct CvtDesc { const float* W; int ldw, K, N; bf16* WT; int mode; const float* gain; int tile; };
__device__ __forceinline__ void cvt_load(const CvtDesc& d, f32x4 (&v)[16], int tid) {
    const int ntn = d.N >> 8, kb = d.tile / ntn, nb = d.tile - kb * ntn, k0 = kb * 128, n0 = nb * 256;
#pragma unroll
    for (int i = 0; i < 16; ++i) { const int idx = tid + 512 * i, k = idx >> 6, c4 = idx & 63; v[i] = __builtin_nontemporal_load((const GAS f32x4*)(d.W + (size_t)(k0 + k) * d.ldw + n0 + 4 * c4)); }
}
__device__ __forceinline__ void cvt_to_lds(const CvtDesc& d, const f32x4 (&v)[16], LAS unsigned char* lds, int tid) {
    const int ntn = d.N >> 8, kb = d.tile / ntn, k0 = kb * 128;
#pragma unroll
    for (int i = 0; i < 16; ++i) { const int idx = tid + 512 * i, k = idx >> 6, c4 = idx & 63; f32x4 x = v[i];
        if (d.gain) x = x * d.gain[k0 + k];
        v2u w; w.x = pk2(x.x, x.y); w.y = pk2(x.z, x.w);
        *(LAS v2u*)(lds + k * 520 + c4 * 8) = w; }
}
__device__ __forceinline__ void cvt_store(const CvtDesc& d, const LAS unsigned char* lds, int tid) {
    const int ntn = d.N >> 8, kb = d.tile / ntn, nb = d.tile - kb * ntn, k0 = kb * 128, n0 = nb * 256;
    const int n = tid & 255, half = tid >> 8, ng = n0 + n;
    const int drow = (d.mode == 0) ? ng : ((ng >> 7) * 256 + (d.mode == 2 ? 128 : 0) + (ng & 127));
    bf16* dst = (d.mode == 3) ? d.WT + ((size_t)(k0 >> 9) * 2048 + ng) * 512 + (k0 & 511)
                              : d.WT + ((size_t)((drow >> 8) * (d.K >> 6) + (k0 >> 6)) * 256 + (drow & 255)) * 64;
    const int kcs = (d.mode == 3) ? 8 : 8, kts = (d.mode == 3) ? 0 : 256 * 64 - 64;
#pragma unroll 2
    for (int j = 0; j < 8; ++j) { const int kc = 2 * j + half; const LAS unsigned short* sp = (const LAS unsigned short*)(lds + (8 * kc) * 520 + n * 2);
        v4u o; o.x = (unsigned)sp[0] | ((unsigned)sp[260] << 16); o.y = (unsigned)sp[2 * 260] | ((unsigned)sp[3 * 260] << 16); o.z = (unsigned)sp[4 * 260] | ((unsigned)sp[5 * 260] << 16); o.w = (unsigned)sp[6 * 260] | ((unsigned)sp[7 * 260] << 16);
        *(GAS v4u*)(dst + kcs * kc + (kc >> 3) * kts) = o; }
}
__device__ __forceinline__ void rms_row(const float* xrow, const float* g, bf16* orow, int lane, f32x4 (&v)[8]) {
    const GAS f32x4* xr = (const GAS f32x4*)xrow + lane;
    float s = 0.f;
#pragma unroll
    for (int j = 0; j < 8; ++j) { v[j] = xr[64 * j]; s += (v[j].x * v[j].x + v[j].y * v[j].y) + (v[j].z * v[j].z + v[j].w * v[j].w); }
    const float r = 1.0f / sqrtf(wave_sum(s, lane) * (1.f / 2048.f) + EPS);
    const GAS f32x4* gr = (const GAS f32x4*)g + lane;
    GAS v2u* o8 = (GAS v2u*)orow + lane;
#pragma unroll
    for (int j = 0; j < 8; ++j) { const f32x4 gv = gr[64 * j]; v[j] = v[j] * r * gv; v2u w; w.x = pk2(v[j].x, v[j].y); w.y = pk2(v[j].z, v[j].w); o8[64 * j] = w; }
}


#ifndef MLSTM_NAIVE
#define MLSTM_NAIVE 0
#endif
typedef short ml_bf16x8 __attribute__((ext_vector_type(8)));
typedef short ml_s16x4 __attribute__((ext_vector_type(4)));
constexpr int ML_QS = 0, ML_KS = 33792, ML_VS = 67584, ML_VW = 76800, ML_WS = 86016, ML_XCH = 95232, ML_NS = 111616, ML_SC = 112640, ML_GA = 114688, ML_GB = 122880, ML_GP = 131072, ML_GM = 139264, ML_PQ = 528, ML_PV = 144;
constexpr int SC_A2 = 0, SC_M2 = 64, SC_IW = 128, SC_NFL = 192, SC_WS = 256, SC_DEN = 320, SC_DECAY = 384;
static_assert(ML_GM + 256 <= LDS_BYTES - 128, "mLSTM LDS map below the barrier words");
__device__ __forceinline__ ml_bf16x8 ml_tr_read2(const LAS unsigned char* p0, const LAS unsigned char* p1) {
    const ml_s16x4 lo = __builtin_amdgcn_ds_read_tr16_b64_v4i16((LAS ml_s16x4*)p0), hi = __builtin_amdgcn_ds_read_tr16_b64_v4i16((LAS ml_s16x4*)p1);
    return __builtin_shufflevector(lo, hi, 0, 1, 2, 3, 4, 5, 6, 7);
}
__device__ __forceinline__ unsigned ml_pk2n(float lo, float hi) { unsigned r; asm volatile("v_cvt_pk_bf16_f32 %0, %1, %2\n\ts_nop 1" : "=v"(r) : "v"(lo), "v"(hi)); return r; }
#define ML_EXP(x) __builtin_amdgcn_exp2f((x) * 1.4426950408889634f)
#define ML_MFMA(a, b, c) __builtin_amdgcn_mfma_f32_16x16x32_bf16((a), (b), (c), 0, 0, 0)
__device__ __forceinline__ void mlstm_item(LAS unsigned char* lds, const bf16* QCp, const bf16* KCp, const bf16* Zp, const float* GATp, bf16* HMp, int item, int tid) {
    const int lane = tid & 63, w = __builtin_amdgcn_readfirstlane(tid >> 6), g = lane >> 4, i = lane & 15, dvb = w & 3, dkh = w >> 2;
    const int b = item >> 4, h = (item >> 2) & 3, jv = item & 3;
    LAS float* sc = (LAS float*)(lds + ML_SC); LAS float* nS = (LAS float*)(lds + ML_NS);
    LAS float* gA = (LAS float*)(lds + ML_GA); LAS float* gB = (LAS float*)(lds + ML_GB); LAS float* gP = (LAS float*)(lds + ML_GP); LAS float* gM = (LAS float*)(lds + ML_GM);
    f32x4 Cacc[8];
#pragma unroll
    for (int x = 0; x < 8; ++x) Cacc[x] = (f32x4){0.f, 0.f, 0.f, 0.f};
    if (tid < 256) nS[tid] = 0.f;
    const size_t tokb = (size_t)b * SEQ;
#pragma unroll 1
    for (int cc = w; cc < SEQ / 64; cc += 8) {
        const size_t t = tokb + (size_t)cc * 64 + lane; const float li = GATp[t * 8 + h], lf = GATp[t * 8 + 4 + h];
        float bc = lf;
#pragma unroll
        for (int o = 1; o < 64; o <<= 1) { const float y = shfl_up_l(bc, o, lane); if (lane >= o) bc += y; }
        const float a = li - bc; float pm = a;
#pragma unroll
        for (int o = 1; o < 64; o <<= 1) { const float y = shfl_up_l(pm, o, lane); if (lane >= o) pm = fmaxf(pm, y); }
        gA[cc * 64 + lane] = a; gB[cc * 64 + lane] = bc; gP[cc * 64 + lane] = pm;
    }
    __syncthreads();
    if (tid == 0) { float m = 0.f; gM[0] = 0.f;
        for (int cc = 0; cc < SEQ / 64; ++cc) { m = gB[cc * 64 + 63] + fmaxf(m, gP[cc * 64 + 63]); gM[cc + 1] = m; } }
    v4u qreg[4], kreg[4], vreg;
    const unsigned qoff = (unsigned)((tid >> 5) * 2048 + (tid & 31) * 16), voff = (unsigned)((tid >> 3) * (ZP * 2) + (tid & 7) * 16);
#define ML_FETCH(c) do { const size_t t0_ = tokb + (size_t)(c) * 64; unsigned qo_ = qoff, vo_ = voff; asm volatile("" : "+v"(qo_), "+v"(vo_)); \
        const char* qb_ = (const char*)(QCp + t0_ * 1024 + h * 256); const char* kb_ = (const char*)(KCp + t0_ * 1024 + h * 256); \
        _Pragma("unroll") for (int i4 = 0; i4 < 4; ++i4) { qreg[i4] = *(const GAS v4u*)(qb_ + (size_t)i4 * 32768 + qo_); kreg[i4] = *(const GAS v4u*)(kb_ + (size_t)i4 * 32768 + qo_); } \
        vreg = *(const GAS v4u*)((const char*)(Zp + t0_ * ZP + 3072 + h * 256 + jv * 64) + vo_); } while (0)
    ML_FETCH(0);
    __syncthreads();
    for (int c = 0; c < SEQ / 64; ++c) {
        const size_t t0 = tokb + (size_t)c * 64;
        unsigned trb_ = (unsigned)((8 * g + (i >> 2)) * ML_PV + (16 * dvb + 4 * (i & 3)) * 2), trk_ = (unsigned)(ML_KS + (8 * g + (i >> 2)) * ML_PQ + (128 * dkh + 4 * (i & 3)) * 2);
        asm volatile("" : "+v"(trb_), "+v"(trk_));
        const LAS unsigned char* trb = lds + trb_; const LAS unsigned char* trk = lds + trk_;
#pragma unroll
        for (int i4 = 0; i4 < 4; ++i4) { const int p = tid + 512 * i4; *(LAS v4u*)(lds + ML_QS + (p >> 5) * ML_PQ + (p & 31) * 16) = qreg[i4]; *(LAS v4u*)(lds + ML_KS + (p >> 5) * ML_PQ + (p & 31) * 16) = kreg[i4]; }
        if (w == 0) {
            const float mc = gM[c], a = gA[c * 64 + lane], bc = gB[c * 64 + lane], Mt = fmaxf(mc, gP[c * 64 + lane]), M63 = fmaxf(mc, gP[c * 64 + 63]);
            sc[SC_A2 + lane] = a * 1.4426950408889634f; sc[SC_M2 + lane] = Mt * 1.4426950408889634f; sc[SC_IW + lane] = ML_EXP(mc - Mt); sc[SC_NFL + lane] = ML_EXP(-(bc + Mt)); sc[SC_WS + lane] = ML_EXP(a - M63);
            if (lane == 0) sc[SC_DECAY] = ML_EXP(mc - M63);
        }
        __syncthreads();
        { const int row = tid >> 3, c8 = tid & 7; const float wsr = sc[SC_WS + row];
          *(LAS v4u*)(lds + ML_VS + row * ML_PV + c8 * 16) = vreg;
          v4u o; o.x = pk2(bflo(vreg.x) * wsr, bfhi(vreg.x) * wsr); o.y = pk2(bflo(vreg.y) * wsr, bfhi(vreg.y) * wsr); o.z = pk2(bflo(vreg.z) * wsr, bfhi(vreg.z) * wsr); o.w = pk2(bflo(vreg.w) * wsr, bfhi(vreg.w) * wsr);
          *(LAS v4u*)(lds + ML_VW + row * ML_PV + c8 * 16) = o; }
        {
            const int tb1 = w >> 1, sb0 = 2 * (w & 1);
            f32x4 S0 = (f32x4){0.f, 0.f, 0.f, 0.f}, S1 = S0;
#pragma unroll
            for (int kk = 0; kk < 8; ++kk) {
                const ml_bf16x8 af = *(const LAS ml_bf16x8*)(lds + ML_QS + (16 * tb1 + i) * ML_PQ + (32 * kk + 8 * g) * 2);
                const ml_bf16x8 b0 = *(const LAS ml_bf16x8*)(lds + ML_KS + (16 * sb0 + i) * ML_PQ + (32 * kk + 8 * g) * 2);
                const ml_bf16x8 b1 = *(const LAS ml_bf16x8*)(lds + ML_KS + (16 * (sb0 + 1) + i) * ML_PQ + (32 * kk + 8 * g) * 2);
                S0 = ML_MFMA(af, b0, S0); S1 = ML_MFMA(af, b1, S1);
            }
            const f32x4 M2v = *(const LAS f32x4*)(sc + SC_M2 + 16 * tb1 + 4 * g);
            const float a20 = sc[SC_A2 + 16 * sb0 + i], a21 = sc[SC_A2 + 16 * (sb0 + 1) + i];
#pragma unroll
            for (int r = 0; r < 4; ++r) { const int t = 16 * tb1 + 4 * g + r, s0 = 16 * sb0 + i, s1 = s0 + 16;
                const float w0 = (s0 <= t) ? __builtin_amdgcn_exp2f(fminf(a20 - M2v[r], 0.f)) * S0[r] : 0.f;
                const float w1 = (s1 <= t) ? __builtin_amdgcn_exp2f(fminf(a21 - M2v[r], 0.f)) * S1[r] : 0.f;
                *(LAS unsigned short*)(lds + ML_WS + t * ML_PV + s0 * 2) = (unsigned short)(pk2(w0, 0.f) & 0xffffu);
                *(LAS unsigned short*)(lds + ML_WS + t * ML_PV + s1 * 2) = (unsigned short)(pk2(w1, 0.f) & 0xffffu); }
        }
        f32x4 P0 = (f32x4){0.f, 0.f, 0.f, 0.f}, P1 = P0, P2 = P0, P3 = P0;
#pragma unroll
        for (int kk = 0; kk < 4; ++kk) {
            u32x4v bw; bw.x = ml_pk2n(Cacc[2 * kk][0], Cacc[2 * kk][1]); bw.y = ml_pk2n(Cacc[2 * kk][2], Cacc[2 * kk][3]); bw.z = ml_pk2n(Cacc[2 * kk + 1][0], Cacc[2 * kk + 1][1]); bw.w = ml_pk2n(Cacc[2 * kk + 1][2], Cacc[2 * kk + 1][3]);
            const ml_bf16x8 bfr = __builtin_bit_cast(ml_bf16x8, bw);
            const int dkb = 128 * dkh + 32 * kk;
#define ML_QFRAG(tb) ({ const v2u lo_ = *(const LAS v2u*)(lds + ML_QS + (16 * (tb) + i) * ML_PQ + (dkb + 4 * g) * 2), hi_ = *(const LAS v2u*)(lds + ML_QS + (16 * (tb) + i) * ML_PQ + (dkb + 16 + 4 * g) * 2); \
            u32x4v q_; q_.x = lo_.x; q_.y = lo_.y; q_.z = hi_.x; q_.w = hi_.y; __builtin_bit_cast(ml_bf16x8, q_); })
            P0 = ML_MFMA(ML_QFRAG(0), bfr, P0); P1 = ML_MFMA(ML_QFRAG(1), bfr, P1); P2 = ML_MFMA(ML_QFRAG(2), bfr, P2); P3 = ML_MFMA(ML_QFRAG(3), bfr, P3);
#undef ML_QFRAG
        }
        __syncthreads();
        if (c + 1 < SEQ / 64) ML_FETCH(c + 1);
        f32x4 H0 = (f32x4){0.f, 0.f, 0.f, 0.f}, H1 = H0;
#pragma unroll
        for (int kk = 0; kk < 2; ++kk) {
            const LAS unsigned char* va = trb + ML_VS + 32 * kk * ML_PV;
            const ml_bf16x8 bfr = ml_tr_read2(va, va + 4 * ML_PV);
            const ml_bf16x8 a0 = *(const LAS ml_bf16x8*)(lds + ML_WS + (16 * (2 * dkh) + i) * ML_PV + (32 * kk + 8 * g) * 2);
            const ml_bf16x8 a1 = *(const LAS ml_bf16x8*)(lds + ML_WS + (16 * (2 * dkh + 1) + i) * ML_PV + (32 * kk + 8 * g) * 2);
            H0 = ML_MFMA(a0, bfr, H0); H1 = ML_MFMA(a1, bfr, H1);
        }
        { const int t = tid >> 3, p = tid & 7; float qn = 0.f;
#pragma unroll
          for (int e = 0; e < 4; ++e) { const v4u qq = *(const LAS v4u*)(lds + ML_QS + t * ML_PQ + (32 * p + 8 * e) * 2); const f32x4 n0 = *(const LAS f32x4*)(nS + 32 * p + 8 * e), n1 = *(const LAS f32x4*)(nS + 32 * p + 8 * e + 4);
              qn += (bflo(qq.x) * n0.x + bfhi(qq.x) * n0.y) + (bflo(qq.y) * n0.z + bfhi(qq.y) * n0.w) + (bflo(qq.z) * n1.x + bfhi(qq.z) * n1.y) + (bflo(qq.w) * n1.z + bfhi(qq.w) * n1.w); }
          const v4u ww = *(const LAS v4u*)(lds + ML_WS + t * ML_PV + 8 * p * 2);
          float d = sc[SC_IW + t] * qn + ((bflo(ww.x) + bfhi(ww.x)) + (bflo(ww.y) + bfhi(ww.y)) + (bflo(ww.z) + bfhi(ww.z)) + (bflo(ww.w) + bfhi(ww.w)));
          d += shfl_xor_l(d, 1, lane); d += shfl_xor_l(d, 2, lane); d += shfl_xor_l(d, 4, lane);
          if (p == 0) sc[SC_DEN + t] = d; }
        { const f32x4 x0 = dkh ? P0 : P2, x1 = dkh ? P1 : P3;
          *(LAS f32x4*)(lds + ML_XCH + ((w * 2 + 0) * 64 + lane) * 16) = x0; *(LAS f32x4*)(lds + ML_XCH + ((w * 2 + 1) * 64 + lane) * 16) = x1; }
        __syncthreads();
        { const f32x4 o0 = dkh ? P2 : P0, o1 = dkh ? P3 : P1;
          const f32x4 p0 = *(const LAS f32x4*)(lds + ML_XCH + (((w ^ 4) * 2 + 0) * 64 + lane) * 16), p1 = *(const LAS f32x4*)(lds + ML_XCH + (((w ^ 4) * 2 + 1) * 64 + lane) * 16);
#pragma unroll
          for (int x = 0; x < 2; ++x) { const int tb = 2 * dkh + x; const f32x4 own = x ? o1 : o0, oth = x ? p1 : p0, hin = x ? H1 : H0;
              const f32x4 iwv = *(const LAS f32x4*)(sc + SC_IW + 16 * tb + 4 * g), dnv = *(const LAS f32x4*)(sc + SC_DEN + 16 * tb + 4 * g), nfv = *(const LAS f32x4*)(sc + SC_NFL + 16 * tb + 4 * g);
#pragma unroll
              for (int r = 0; r < 4; ++r) { const float num = iwv[r] * (own[r] + oth[r]) + hin[r]; const float hv = num / fmaxf(fabsf(dnv[r]), nfv[r]);
                  HMp[(t0 + 16 * tb + 4 * g + r) * 1024 + h * 256 + jv * 64 + 16 * dvb + i] = (bf16)(pk2(hv, 0.f) & 0xffffu); } } }
        const float decay = sc[SC_DECAY];
#pragma unroll
        for (int x = 0; x < 8; ++x) Cacc[x] = Cacc[x] * decay;
        f32x4 nacc0 = (f32x4){0.f, 0.f, 0.f, 0.f}, nacc1 = nacc0;
#pragma unroll
        for (int kk = 0; kk < 2; ++kk) {
            const LAS unsigned char* va = trb + ML_VW + 32 * kk * ML_PV;
            const ml_bf16x8 bfr = ml_tr_read2(va, va + 4 * ML_PV);
            const f32x4 wa = *(const LAS f32x4*)(sc + SC_WS + 32 * kk + 8 * g), wb = *(const LAS f32x4*)(sc + SC_WS + 32 * kk + 8 * g + 4);
            u32x4v ww; ww.x = ml_pk2n(wa[0], wa[1]); ww.y = ml_pk2n(wa[2], wa[3]); ww.z = ml_pk2n(wb[0], wb[1]); ww.w = ml_pk2n(wb[2], wb[3]);
            const ml_bf16x8 wfr = __builtin_bit_cast(ml_bf16x8, ww);
#pragma unroll
            for (int x = 0; x < 8; ++x) { const LAS unsigned char* ka = trk + 32 * kk * ML_PQ + 32 * x; const ml_bf16x8 afr = ml_tr_read2(ka, ka + 4 * ML_PQ);
                Cacc[x] = ML_MFMA(afr, bfr, Cacc[x]);
                if ((x >> 1) == dvb) { if (x & 1) nacc1 = ML_MFMA(afr, wfr, nacc1); else nacc0 = ML_MFMA(afr, wfr, nacc0); } }
        }
        if (i == 0) { LAS f32x4* np0 = (LAS f32x4*)(nS + 128 * dkh + 16 * (2 * dvb) + 4 * g); LAS f32x4* np1 = (LAS f32x4*)(nS + 128 * dkh + 16 * (2 * dvb + 1) + 4 * g);
            *np0 = *np0 * decay + nacc0; *np1 = *np1 * decay + nacc1; }
        __syncthreads();
    }
#undef ML_FETCH
}

struct Args { const float* in[24]; float* out; unsigned char* ws; int l_lo, l_hi, ph_lo, ph_hi, use_bar, do_init, do_final, pad; };
static_assert(sizeof(Args) == 26 * 8 + 8 * 4, "Args has no padding");

__global__ void __launch_bounds__(NWAVES * 64, 2) fwd(Args args) {
    extern __shared__ __attribute__((aligned(16))) unsigned char lds_raw[];
    LAS unsigned char* lds = (LAS unsigned char*)lds_raw;
    volatile LAS unsigned* MISC = (volatile LAS unsigned*)(lds + MISC_OFF);
    const int G = gridDim.x, bx = blockIdx.x, NGW = G * NWAVES;
    const int wave0 = __builtin_amdgcn_readfirstlane((int)threadIdx.x >> 6);
    { const int t0 = threadIdx.x;
      for (int u = t0; u < (LDS_BYTES - LDSCTL_OFF) / 4; u += NWAVES * 64) ((LAS unsigned*)(lds + LDSCTL_OFF))[u] = 0u; }
    __syncthreads();
    XcdBarrier bar; bar.bar = (unsigned*)(args.ws + WS_CTL) + CW_BAR; bar.x = 0; bar.st = nullptr;
    if (args.use_bar) bar = xcd_barrier_post((unsigned*)(args.ws + WS_CTL) + CW_BAR, MISC + 8);
#define GRID_BAR() do { if (args.use_bar) { int bt_; asm volatile("v_mbcnt_lo_u32_b32 %0, -1, 0\n\tv_mbcnt_hi_u32_b32 %0, -1, %0" : "=v"(bt_)); xcd_barrier(bar, bt_ + wave0 * 64); } } while (0)
#define PH_BEGIN() int tid_; asm volatile("v_mbcnt_lo_u32_b32 %0, -1, 0\n\tv_mbcnt_hi_u32_b32 %0, -1, %0" : "=v"(tid_)); tid_ += wave0 * 64; const int tid = tid_, lane = tid & 63, wave = __builtin_amdgcn_readfirstlane(tid >> 6), gw = bx * NWAVES + wave; \
    unsigned char* ws = args.ws; asm volatile("" : "+s"(ws)); unsigned char* BIG = ws + WS_BIG; (void)tid; (void)lane; (void)gw; (void)BIG; \
    bf16* U = (bf16*)(ws + WS_U); (void)U
#define INP(k) ({ int k_ = (k); asm volatile("" : "+s"(k_)); const float* p_ = args.in[k_]; p_; })
#define HID ((bf16*)BIG)
#define Z ((bf16*)BIG)
#define PB ((bf16*)BIG)
#define GT ((bf16*)(ws + WS_GT))
#define VWT ((bf16*)(ws + WS_VWT))
#define QC ((bf16*)(ws + WS_X1))
#define KC (QC + (size_t)M * 1024)
#define DP ((bf16*)(ws + WS_X2))
#define HM ((bf16*)(ws + WS_HM))
#define GAT ((float*)(ws + WS_GAT))
#define KB ((bf16*)(ws + WS_KB))
#define VB ((bf16*)(ws + WS_VT))
#define MEMN ((bf16*)(ws + WS_MEMN))
#define WGU1 ((bf16*)(ws + WS_WGU1))
#define WD1 ((bf16*)(ws + WS_WD1))
#define WGU2 ((bf16*)(ws + WS_WGU2))
#define WD2 ((bf16*)(ws + WS_WD2))
#define WIN ((bf16*)(ws + WS_WIN))
#define WPOOL ((bf16*)(ws + WS_WPOOL))
#define WOUT ((bf16*)(ws + WS_WOUT))
#define WQH ((bf16*)(ws + WS_WQ))
#define WKV ((bf16*)(ws + WS_WKV))
#define WOH ((bf16*)(ws + WS_WO))

    const int lo = args.ph_lo, hi = args.ph_hi;
#ifndef PHMASK
#define PHMASK 0xfff
#endif
#ifndef DUPMASK
#define DUPMASK 0
#endif
#define NREP(k) (1 + ((DUPMASK >> (k)) & 1))
#define IN(k) (((PHMASK >> (k)) & 1) && lo <= (k) && (k) < hi)
#define RSS(k) ((pg8::rss_t*)(ws + WS_RSS) + (size_t)(k) * M)
#define H16 ((bf16*)(ws + WS_H))
#define DUMMY16 ((bf16*)(ws + WS_X1))

    if (args.do_init) {
        PH_BEGIN();
        const float* x = INP(0);
        for (int m = gw; m < M; m += NGW) {
            const GAS f32x4* xr = (const GAS f32x4*)(x + (size_t)m * D) + lane; float ss = 0.f;
#pragma unroll
            for (int j = 0; j < 8; ++j) { const f32x4 v = __builtin_nontemporal_load(xr + 64 * j); v2u w; w.x = pk2(v.x, v.y); w.y = pk2(v.z, v.w); *(GAS v2u*)(H16 + h16_off(m, 256 * j + 4 * lane)) = w;
                const float a0 = bflo(w.x), a1 = bfhi(w.x), a2 = bflo(w.y), a3 = bfhi(w.y); ss += (a0 * a0 + a1 * a1) + (a2 * a2 + a3 * a3); }
            ss = wave_sum(ss, lane);
            if (lane == 0) RSS(0)[m] = (pg8::rss_t)(ss * 1048576.0f + 0.5f);
        }
        GRID_BAR();
    }
    for (int l = args.l_lo; l < args.l_hi; ++l) {
        if (IN(0)) for (int rep = 0; rep < NREP(0); ++rep) {
            PH_BEGIN();
            const float* wg1 = INP(3) + (size_t)l * D * FF; const float* wu1 = INP(4) + (size_t)l * D * FF; const float* wd1 = INP(5) + (size_t)l * FF * D;
            const float* wg2 = INP(20) + (size_t)l * D * FF; const float* wu2 = INP(21) + (size_t)l * D * FF; const float* wd2 = INP(22) + (size_t)l * FF * D;
            const float* win = INP(7) + (size_t)l * D * DIN; const float* wpool = INP(11) + (size_t)l * 4 * 65536; const float* wout = INP(13) + (size_t)l * D * D;
            const float* wq = INP(16) + (size_t)l * D * D; const float* wkv = INP(17) + (size_t)l * D * 2 * D; const float* wo = INP(18) + (size_t)l * D * D;
            const float* g1 = INP(2) + (size_t)l * D; const float* gm = INP(6) + (size_t)l * D; const float* gx = INP(14) + (size_t)l * D; const float* g2 = INP(19) + (size_t)l * D;
            constexpr int T_GU = (D / 128) * (FF / 256), T_DN = (FF / 128) * (D / 256), T_IN = (D / 128) * (DINM / 256), T_PL = 2, T_SQ = (D / 128) * (D / 256), T_KV = (D / 128) * (2 * D / 256);
            constexpr int NTILES = 4 * T_GU + 2 * T_DN + T_IN + 4 * T_PL + 2 * T_SQ + T_KV;
#define CVT_DESC(dst, it_) do { int r = (it_); \
                if (r < T_GU) { dst = CvtDesc{wg1, FF, D, FF, WGU1, 1, g1, r}; break; } r -= T_GU; \
                if (r < T_GU) { dst = CvtDesc{wu1, FF, D, FF, WGU1, 2, g1, r}; break; } r -= T_GU; \
                if (r < T_DN) { dst = CvtDesc{wd1, D, FF, D, WD1, 0, nullptr, r}; break; } r -= T_DN; \
                if (r < T_GU) { dst = CvtDesc{wg2, FF, D, FF, WGU2, 1, g2, r}; break; } r -= T_GU; \
                if (r < T_GU) { dst = CvtDesc{wu2, FF, D, FF, WGU2, 2, g2, r}; break; } r -= T_GU; \
                if (r < T_DN) { dst = CvtDesc{wd2, D, FF, D, WD2, 0, nullptr, r}; break; } r -= T_DN; \
                if (r < T_IN) { dst = CvtDesc{win, DIN, D, DINM, WIN, 0, gm, r}; break; } r -= T_IN; \
                if (r < 4 * T_PL) { const int g_ = r / T_PL; dst = CvtDesc{wpool + (size_t)g_ * 65536, 256, 256, 256, WPOOL + (size_t)g_ * 65536, 0, nullptr, r % T_PL}; break; } r -= 4 * T_PL; \
                if (r < T_SQ) { dst = CvtDesc{wout, D, D, D, WOUT, 0, nullptr, r}; break; } r -= T_SQ; \
                if (r < T_KV) { dst = CvtDesc{wkv, 2 * D, D, 2 * D, WKV, 0, nullptr, r}; break; } r -= T_KV; \
                dst = CvtDesc{wo, D, D, D, WOH, 3, nullptr, r}; } while (0)
            int it0 = bx; asm volatile("" : "+s"(it0));
            if (it0 < NTILES) {
                f32x4 cv[16]; CvtDesc cd; CVT_DESC(cd, it0); cvt_load(cd, cv, tid);
                int buf = 0;
#pragma unroll 1
                for (int it = it0; it < NTILES; it += G) {
                    LAS unsigned char* img = lds + RING_OFF + buf * 66560;
                    cvt_to_lds(cd, cv, img, tid);
                    __syncthreads();
                    CvtDesc cn = cd; const bool more = it + G < NTILES;
                    if (more) { CVT_DESC(cn, it + G); cvt_load(cn, cv, tid); }
                    cvt_store(cd, img, tid);
                    cd = cn; buf ^= 1;
                }
                __syncthreads();
            }
#undef CVT_DESC
            for (int e = bx * (NWAVES * 64) + tid; e < D * D / 8; e += G * NWAVES * 64) { const int k = e >> 8, n8 = (e & 255) * 8; const float sc = gx[k] * 0.044194173824159216f;
                const f32x4 a = __builtin_nontemporal_load((const GAS f32x4*)(wq + (size_t)k * D + n8)), b = __builtin_nontemporal_load((const GAS f32x4*)(wq + (size_t)k * D + n8 + 4));
                v4u o; o.x = pk2(a.x * sc, a.y * sc); o.y = pk2(a.z * sc, a.w * sc); o.z = pk2(b.x * sc, b.y * sc); o.w = pk2(b.z * sc, b.w * sc);
                *(GAS v4u*)(WQH + ((size_t)(n8 >> 9) * D + k) * 512 + (n8 & 511)) = o; }
            for (int e = bx * (NWAVES * 64) + tid; e < 256 * D; e += G * NWAVES * 64) { const int rr = e >> 11, k = e & (D - 1);
                const float v = (rr < 8) ? win[(size_t)k * DIN + DINM + rr] * gm[k] : 0.f; WIN[((size_t)(20 * 32 + (k >> 6)) * 256 + rr) * 64 + (k & 63)] = (bf16)(pk2(v, 0.f) & 0xffffu); }
            f32x4 v[8];
            for (int m = gw; m < MMEM; m += NGW) rms_row(INP(1) + (size_t)m * D, INP(15) + (size_t)l * D, MEMN + (size_t)m * D, lane, v);
            GRID_BAR();
        }
        if (IN(1)) for (int rep = 0; rep < NREP(1); ++rep) {
            PH_BEGIN();
            pg8::Gemm g{H16, WGU1, D, 0, 44, 1, 1}; pg8::StaticOrder S; S.init(128, 44, G, bx);
            pg8::EpiSwiGLU E{HID, 64, RSS(4 * l), (LAS float*)(lds + LDSCTL_OFF + 12288)};
            pg8::gemm_phase<pg8::EpiSwiGLU, pg8::StaticOrder, PG8_ALIGN, PG8_SP2, true>(lds + RING_OFF, g, S, E, tid);
            { pg8::Gemm g2{MEMN, WKV, D, 0, 16, 0, 1}; pg8::StaticOrder S2; S2.init(16, 16, G, bx);
              pg8::EpiBf16K<1> E2{KB, nullptr, 1.0f, MMEM, nullptr, nullptr, nullptr, nullptr};
              pg8::gemm_phase<pg8::EpiBf16K<1>, pg8::StaticOrder, PG8_ALIGN, PG8_SP2>(lds + RING_OFF, g2, S2, E2, tid); }
            GRID_BAR();
        }
        if (IN(2)) for (int rep = 0; rep < NREP(2); ++rep) {
            PH_BEGIN();
            const bool dummy = rep + 1 < NREP(2);
            pg8::Gemm g{HID, WD1, FF, 0, 8, 1, 1}; pg8::StaticOrder S; S.init(128, 8, G, bx);
            pg8::EpiResid16 E{H16, dummy ? DUMMY16 : H16, 0.5f, dummy ? RSS(17) : RSS(4 * l + 1)};
            pg8::gemm_phase<pg8::EpiResid16, pg8::StaticOrder, false, PG8_SP2, true>(lds + RING_OFF, g, S, E, tid);
            GRID_BAR();
        }
        if (IN(3)) for (int rep = 0; rep < NREP(3); ++rep) {
            PH_BEGIN();
            pg8::Gemm g{H16, WIN, D, 0, 21, 1, 1}; pg8::StaticOrder S; S.init(128, 21, G, bx);
            pg8::EpiBf16K<0> E{Z, nullptr, 1.0f, 0, RSS(4 * l + 1), GAT, INP(8) + l * 8, (LAS float*)(lds + LDSCTL_OFF + 12288)};
            pg8::gemm_phase<pg8::EpiBf16K<0>, pg8::StaticOrder, PG8_ALIGN, PG8_SP2>(lds + RING_OFF, g, S, E, tid);
            const bool lateWG = (G == 256) && bx >= 128;
#pragma unroll 1
            for (int part = 0; part < 2; ++part) {
                pg8::Gemm g2{KB, WQH, 512, 16, 8}; pg8::StaticOrder S2; S2.init(64, 8, G, bx);
                if (G == 256) { if (part == 0) S2.slice(0, 256, 256, bx); else S2.slice(256, 256, 128, lateWG ? bx - 128 : 256); } else if (part == 1) S2.slice(0, 0, G, 1);
                pg8::EpiBf16K<5> E2{GT, nullptr, 1.0f, 0, nullptr, nullptr, nullptr, nullptr};
                pg8::gemm_phase<pg8::EpiBf16K<5>, pg8::StaticOrder, PG8_ALIGN, PG8_SP2>(lds + RING_OFF, g2, S2, E2, tid);
                pg8::Gemm g3{WOH, VB, 512, 8, 16}; pg8::StaticOrder S3; S3.init(32, 16, G, bx);
                if (G == 256) { if (part == 0) S3.slice(0, 256, 256, bx); else S3.slice(256, 256, 128, lateWG ? bx - 128 : 256); } else if (part == 1) S3.slice(0, 0, G, 1);
                pg8::EpiBf16K<6> E3{VWT, nullptr, 1.0f, 0, nullptr, nullptr, nullptr, nullptr};
                pg8::gemm_phase<pg8::EpiBf16K<6>, pg8::StaticOrder, PG8_ALIGN, PG8_SP2>(lds + RING_OFF, g3, S3, E3, tid);
            }
            GRID_BAR();
        }
        if (IN(4)) for (int rep = 0; rep < NREP(4); ++rep) {
            PH_BEGIN();
            const float* cw = INP(9) + (size_t)l * 4 * 2048;
#define UNPK8(dst, zz) do { dst[0] = bflo(zz.x); dst[1] = bfhi(zz.x); dst[2] = bflo(zz.y); dst[3] = bfhi(zz.y); dst[4] = bflo(zz.z); dst[5] = bfhi(zz.z); dst[6] = bflo(zz.w); dst[7] = bfhi(zz.w); } while (0)
            for (int blk = bx; blk < 256; blk += G) {
                const int tokb = blk * 128;
                {
                    const int o = tid & 255, c0 = o * 8, t1 = tokb + 64 * (tid >> 8), s1 = t1 & (SEQ - 1);
                    f32x4 W0[2], W1[2], W2[2], W3[2], XA[2], XB[2], XC[2];
#pragma unroll
                    for (int h2 = 0; h2 < 2; ++h2) { W0[h2] = *(const f32x4*)(cw + c0 + 4 * h2); W1[h2] = *(const f32x4*)(cw + 2048 + c0 + 4 * h2); W2[h2] = *(const f32x4*)(cw + 4096 + c0 + 4 * h2); W3[h2] = *(const f32x4*)(cw + 6144 + c0 + 4 * h2); }
#define UNPKV(dst, zz) do { dst[0][0] = bflo(zz.x); dst[0][1] = bfhi(zz.x); dst[0][2] = bflo(zz.y); dst[0][3] = bfhi(zz.y); dst[1][0] = bflo(zz.z); dst[1][1] = bfhi(zz.z); dst[1][2] = bflo(zz.w); dst[1][3] = bfhi(zz.w); } while (0)
                    const bf16* zcol = Z + 1024 + c0;
                    { v4u z3 = (v4u){0u, 0u, 0u, 0u}, z2 = z3, z1 = z3;
                      if (s1 >= 3) z3 = *(const GAS v4u*)(zcol + (size_t)(t1 - 3) * ZP);
                      if (s1 >= 2) z2 = *(const GAS v4u*)(zcol + (size_t)(t1 - 2) * ZP);
                      if (s1 >= 1) z1 = *(const GAS v4u*)(zcol + (size_t)(t1 - 1) * ZP);
                      UNPKV(XA, z3); UNPKV(XB, z2); UNPKV(XC, z1); }
                    const float qs = (c0 < 1024) ? 0.0625f : 1.0f;
                    bf16* dcol = (c0 < 1024) ? (QC + c0) : (KC + (c0 - 1024));
                    v4u zr[8];
#pragma unroll
                    for (int u = 0; u < 8; ++u) zr[u] = *(const GAS v4u*)(zcol + (size_t)(t1 + u) * ZP);
                    for (int tt = 0; tt < 64; tt += 8) {
                        v4u zq[8];
#pragma unroll
                        for (int u = 0; u < 8; ++u) zq[u] = (tt + 8 < 64) ? *(const GAS v4u*)(zcol + (size_t)(t1 + tt + 8 + u) * ZP) : (v4u){0u, 0u, 0u, 0u};
#pragma unroll
                        for (int u = 0; u < 8; ++u) { f32x4 XD[2], Y[2]; UNPKV(XD, zr[u]);
#pragma unroll
                            for (int h2 = 0; h2 < 2; ++h2) { const f32x4 a = W0[h2] * XA[h2] + W1[h2] * XB[h2] + W2[h2] * XC[h2] + W3[h2] * XD[h2];
                                f32x4 e = a * -1.4426950408889634f;
#pragma unroll
                                for (int j = 0; j < 4; ++j) e[j] = __builtin_amdgcn_exp2f(e[j]);
                                e = e + 1.0f;
#pragma unroll
                                for (int j = 0; j < 4; ++j) e[j] = __builtin_amdgcn_rcpf(e[j]);
                                Y[h2] = (a * qs) * e; XA[h2] = XB[h2]; XB[h2] = XC[h2]; XC[h2] = XD[h2]; }
                            v4u wv; wv.x = pk2(Y[0][0], Y[0][1]); wv.y = pk2(Y[0][2], Y[0][3]); wv.z = pk2(Y[1][0], Y[1][1]); wv.w = pk2(Y[1][2], Y[1][3]);
                            *(GAS v4u*)(dcol + (size_t)(t1 + tt + u) * 1024) = wv; }
#pragma unroll
                        for (int u = 0; u < 8; ++u) zr[u] = zq[u];
                    }
                }
                {
                    const int o = tid & 127, c0 = o * 8, g = o >> 5, wdw = 2 << g, t1 = tokb + 32 * (tid >> 7), s1 = t1 & (SEQ - 1);
                    const bf16* zcol = Z + c0;
                    f32x4 S[2]; S[0] = (f32x4){0.f, 0.f, 0.f, 0.f}; S[1] = S[0];
                    for (int j = 1; j <= wdw; ++j) if (s1 - j >= 0) { const v4u zz = *(const GAS v4u*)(zcol + (size_t)(t1 - j) * ZP); f32x4 x[2]; UNPKV(x, zz); S[0] += x[0]; S[1] += x[1]; }
                    bf16* dcol = DP + (size_t)g * M * 256 + (c0 & 255);
                    for (int tt = 0; tt < 32; tt += 8) {
                        v4u zn[8], zo[8];
#pragma unroll
                        for (int u = 0; u < 8; ++u) { const int t = t1 + tt + u, sq = s1 + tt + u; zn[u] = *(const GAS v4u*)(zcol + (size_t)t * ZP);
                            zo[u] = (v4u){0u, 0u, 0u, 0u}; if (sq >= wdw) zo[u] = *(const GAS v4u*)(zcol + (size_t)(t - wdw) * ZP); }
#pragma unroll
                        for (int u = 0; u < 8; ++u) { const int sq = s1 + tt + u; f32x4 xn[2], xo[2], d[2]; UNPKV(xn, zn[u]); UNPKV(xo, zo[u]);
                            const float inv = __builtin_amdgcn_rcpf((float)((sq + 1 < wdw) ? (sq + 1) : wdw));
#pragma unroll
                            for (int h2 = 0; h2 < 2; ++h2) { S[h2] += xn[h2] - xo[h2]; d[h2] = S[h2] * inv - xn[h2]; }
                            v4u wv; wv.x = pk2(d[0][0], d[0][1]); wv.y = pk2(d[0][2], d[0][3]); wv.z = pk2(d[1][0], d[1][1]); wv.w = pk2(d[1][2], d[1][3]);
                            *(GAS v4u*)(dcol + (size_t)(t1 + tt + u) * 256) = wv; }
                    }
                }
            }
#undef UNPK8
#undef UNPKV
            GRID_BAR();
        }
        if (IN(5)) for (int rep = 0; rep < NREP(5); ++rep) {
            PH_BEGIN();
            {
                pg8::Gemm g{DP, WPOOL, 256, 128, 1, 0, 1}; pg8::StaticOrder S; S.init(512, 1, G, bx);
                pg8::EpiBf16K<3> E{U, INP(12) + (size_t)l * 1024, 1.0f, 0, nullptr, nullptr, nullptr, nullptr};
                pg8::gemm_phase<pg8::EpiBf16K<3>, pg8::StaticOrder, PG8_ALIGN, PG8_SP2>(lds + RING_OFF, g, S, E, tid);
            }
            __syncthreads();
            for (int wgi = bx; wgi < 256; wgi += G) { const int item = (G == 256) ? ((((wgi & 7) + 8 * (wgi >> 5)) << 2) | ((wgi >> 3) & 3)) : wgi;
                mlstm_item(lds + RING_OFF, QC, KC, Z, GAT, HM, item, tid); }
            GRID_BAR();
        }
        if (IN(6)) for (int rep = 0; rep < NREP(6); ++rep) {
            PH_BEGIN();
            const float* hn = INP(10) + (size_t)l * 1024;
            const int hq = lane >> 4, i16 = lane & 15, col = hq * 256 + 16 * i16;
            f32x4 gn[4];
#pragma unroll
            for (int q = 0; q < 4; ++q) gn[q] = *(const GAS f32x4*)(hn + col + 4 * q);
            for (int m0 = 2 * gw; m0 < M; m0 += 2 * NGW) {
                v4u hh[2][2], og[2][2];
#pragma unroll
                for (int r2 = 0; r2 < 2; ++r2) { const size_t m = (size_t)(m0 + r2);
                    hh[r2][0] = *(const GAS v4u*)(HM + m * 1024 + col); hh[r2][1] = *(const GAS v4u*)(HM + m * 1024 + col + 8);
                    og[r2][0] = *(const GAS v4u*)(Z + m * ZP + 4096 + col); og[r2][1] = *(const GAS v4u*)(Z + m * ZP + 4096 + col + 8); }
#pragma unroll
                for (int r2 = 0; r2 < 2; ++r2) { const size_t m = (size_t)(m0 + r2);
                    f32x4 av[4], ov[4]; const v4u z0 = hh[r2][0], z1 = hh[r2][1], q0 = og[r2][0], q1 = og[r2][1];
#define UNPQ(dst, lo, hi) do { dst[0] = bflo(lo); dst[1] = bfhi(lo); dst[2] = bflo(hi); dst[3] = bfhi(hi); } while (0)
                    UNPQ(av[0], z0.x, z0.y); UNPQ(av[1], z0.z, z0.w); UNPQ(av[2], z1.x, z1.y); UNPQ(av[3], z1.z, z1.w);
                    UNPQ(ov[0], q0.x, q0.y); UNPQ(ov[1], q0.z, q0.w); UNPQ(ov[2], q1.x, q1.y); UNPQ(ov[3], q1.z, q1.w);
#undef UNPQ
                    float ss = 0.f;
                    ss = pg8::dot2_bf16(z0.x, ss); ss = pg8::dot2_bf16(z0.y, ss); ss = pg8::dot2_bf16(z0.z, ss); ss = pg8::dot2_bf16(z0.w, ss);
                    ss = pg8::dot2_bf16(z1.x, ss); ss = pg8::dot2_bf16(z1.y, ss); ss = pg8::dot2_bf16(z1.z, ss); ss = pg8::dot2_bf16(z1.w, ss);
                    ss += shfl_xor_l(ss, 1, lane); ss += shfl_xor_l(ss, 2, lane); ss += shfl_xor_l(ss, 4, lane); ss += shfl_xor_l(ss, 8, lane);
                    const float r = __builtin_amdgcn_rsqf(ss * (1.f / 256.f) + EPS);
                    f32x4 yv[4];
#pragma unroll
                    for (int q = 0; q < 4; ++q) { f32x4 e = ov[q] * -1.4426950408889634f;
#pragma unroll
                        for (int j = 0; j < 4; ++j) e[j] = __builtin_amdgcn_exp2f(e[j]);
                        e = e + 1.0f;
#pragma unroll
                        for (int j = 0; j < 4; ++j) e[j] = __builtin_amdgcn_rcpf(e[j]);
                        yv[q] = (av[q] * gn[q]) * r * e; }
                    v4u w0, w1; w0.x = pk2(yv[0][0], yv[0][1]); w0.y = pk2(yv[0][2], yv[0][3]); w0.z = pk2(yv[1][0], yv[1][1]); w0.w = pk2(yv[1][2], yv[1][3]);
                    w1.x = pk2(yv[2][0], yv[2][1]); w1.y = pk2(yv[2][2], yv[2][3]); w1.z = pk2(yv[3][0], yv[3][1]); w1.w = pk2(yv[3][2], yv[3][3]);
                    bf16* up = U + h16_off((int)m, 1024 + col); *(GAS v4u*)up = w0; *(GAS v4u*)(up + 8) = w1; }
            }
            GRID_BAR();
        }
        if (IN(7)) for (int rep = 0; rep < NREP(7); ++rep) {
            PH_BEGIN();
            const bool dummy = rep + 1 < NREP(7);
            pg8::Gemm g{U, WOUT, D, 0, 8, 1, 1}; pg8::StaticOrder S; S.init(128, 8, G, bx);
            pg8::EpiResid16 E{H16, dummy ? DUMMY16 : H16, 1.0f, dummy ? RSS(17) : RSS(4 * l + 2)};
            pg8::gemm_phase<pg8::EpiResid16, pg8::StaticOrder, false, PG8_SP2, true>(lds + RING_OFF, g, S, E, tid);
            GRID_BAR();
        }
        if (IN(8)) for (int rep = 0; rep < NREP(8); ++rep) {
            PH_BEGIN();
            pg8::Gemm g{H16, GT, D, 8, 4, 1}; pg8::StaticOrder S; S.init(128, 4, G, bx);
            pg8::EpiSoftmaxP E{PB, RSS(4 * l + 2), (LAS float*)(lds + LDSCTL_OFF + 1024)};
            pg8::gemm_phase<pg8::EpiSoftmaxP, pg8::StaticOrder, true, PG8_SP2, true>(lds + RING_OFF, g, S, E, tid);
            GRID_BAR();
        }
        if (IN(9)) for (int rep = 0; rep < NREP(9); ++rep) {
            PH_BEGIN();
            const bool dummy = rep + 1 < NREP(9);
            pg8::Gemm g{PB, VWT, 1024, 8, 8, 1}; pg8::StaticOrder S; S.init(128, 8, G, bx);
            pg8::EpiResid16 E{H16, dummy ? DUMMY16 : H16, 1.0f, dummy ? RSS(17) : RSS(4 * l + 3)};
            pg8::gemm_phase<pg8::EpiResid16, pg8::StaticOrder, false, PG8_SP2, true>(lds + RING_OFF, g, S, E, tid);
            GRID_BAR();
        }
        if (IN(10)) for (int rep = 0; rep < NREP(10); ++rep) {
            PH_BEGIN();
            pg8::Gemm g{H16, WGU2, D, 0, 44, 1, 1}; pg8::StaticOrder S; S.init(128, 44, G, bx);
            pg8::EpiSwiGLU E{HID, 64, RSS(4 * l + 3), (LAS float*)(lds + LDSCTL_OFF + 12288)};
            pg8::gemm_phase<pg8::EpiSwiGLU, pg8::StaticOrder, PG8_ALIGN, PG8_SP2, true>(lds + RING_OFF, g, S, E, tid);
            GRID_BAR();
        }
        if (IN(11)) for (int rep = 0; rep < NREP(11); ++rep) {
            PH_BEGIN();
            const bool dummy = rep + 1 < NREP(11);
            pg8::Gemm g{HID, WD2, FF, 0, 8, 1, 1}; pg8::StaticOrder S; S.init(128, 8, G, bx);
            pg8::EpiResid16 E{H16, dummy ? DUMMY16 : H16, 0.5f, dummy ? RSS(17) : RSS(4 * l + 4)};
            pg8::gemm_phase<pg8::EpiResid16, pg8::StaticOrder, false, PG8_SP2, true>(lds + RING_OFF, g, S, E, tid);
            GRID_BAR();
        }
    }
    if (args.do_final) {
        PH_BEGIN();
        const float* gf = INP(23);
        for (int m = gw; m < M; m += NGW) {
            const float r = pg8::rms_scale(RSS(16), m);
            GAS f32x4* orow = (GAS f32x4*)(args.out + (size_t)m * D) + lane;
#pragma unroll
            for (int j = 0; j < 8; ++j) { const v2u w = *(const GAS v2u*)(H16 + h16_off(m, 256 * j + 4 * lane)); const f32x4 gv = *((const GAS f32x4*)gf + lane + 64 * j);
                __builtin_nontemporal_store((f32x4){bflo(w.x) * r * gv.x, bfhi(w.x) * r * gv.y, bflo(w.y) * r * gv.z, bfhi(w.y) * r * gv.w}, orow + 64 * j); }
        }
    }
#undef IN
#undef GRID_BAR
}

extern "C" void kernel_launch(void* const* d_in, const int* in_sizes, int n_in, void* d_out, int out_size, void* d_ws, size_t ws_size, hipStream_t stream) {
    static int grid = 0;
    if (grid == 0) {
        if (n_in != 24 || in_sizes[0] != M * D || out_size != M * D || ws_size < WS_END) { fprintf(stderr, "kernel_launch: unexpected shapes / workspace (n_in %d, ws %zu, need %zu)\n", n_in, ws_size, (size_t)WS_END); grid = -1; return; }
        int dev = 0, cus = 0;
        if (hipGetDevice(&dev) != hipSuccess || hipDeviceGetAttribute(&cus, hipDeviceAttributeMultiprocessorCount, dev) != hipSuccess) { grid = -1; return; }
        if (hipFuncSetAttribute((const void*)fwd, hipFuncAttributeMaxDynamicSharedMemorySize, LDS_BYTES) != hipSuccess) { fprintf(stderr, "kernel_launch: hipFuncSetAttribute failed\n"); grid = -1; return; }
        int per_cu = 0;
        if (hipOccupancyMaxActiveBlocksPerMultiprocessor(&per_cu, (const void*)fwd, NWAVES * 64, LDS_BYTES) != hipSuccess || per_cu < 1) { fprintf(stderr, "kernel_launch: occupancy query says %d\n", per_cu); }
        (void)hipGetLastError();
        grid = cus;
    }
    if (grid < 0) return;
    (void)hipMemsetAsync((char*)d_ws + WS_CTL, 0, CTL_ZERO_BYTES, stream);
    Args a{};
    for (int i = 0; i < 24; ++i) a.in[i] = (const float*)d_in[i];
    a.out = (float*)d_out; a.ws = (unsigned char*)d_ws;
#if MK_ONE_LAUNCH
    a.l_lo = 0; a.l_hi = DEPTH; a.ph_lo = 0; a.ph_hi = N_PH; a.use_bar = 1; a.do_init = 1; a.do_final = 1;
    hipLaunchKernelGGL(fwd, dim3(grid), dim3(NWAVES * 64), LDS_BYTES, stream, a);
#else
    a.l_lo = 0; a.l_hi = 0; a.ph_lo = 0; a.ph_hi = 0; a.use_bar = 0; a.do_init = 1; a.do_final = 0;
    hipLaunchKernelGGL(fwd, dim3(grid), dim3(NWAVES * 64), LDS_BYTES, stream, a);
    for (int l = 0; l < DEPTH; ++l)
        for (int ph = 0; ph < N_PH; ++ph) {
            a.l_lo = l; a.l_hi = l + 1; a.ph_lo = ph; a.ph_hi = ph + 1; a.use_bar = 0; a.do_init = 0; a.do_final = 0;
            hipLaunchKernelGGL(fwd, dim3(grid), dim3(NWAVES * 64), LDS_BYTES, stream, a);
        }
    a.l_lo = 0; a.l_hi = 0; a.ph_lo = 0; a.ph_hi = 0; a.use_bar = 0; a.do_init = 0; a.do_final = 1;
    hipLaunchKernelGGL(fwd, dim3(grid), dim3(NWAVES * 64), LDS_BYTES, stream, a);
#endif
}
```

```cpp
#include <hip/hip_runtime.h>
#include <cstdio>
#include <cstdint>

#ifndef MK_ONE_LAUNCH
#define MK_ONE_LAUNCH 1
#endif

namespace pg8 {
typedef _Float16 f16x4_t __attribute__((ext_vector_type(4)));
#define PG8_LAS __attribute__((address_space(3)))
typedef unsigned short bf16_t;
typedef short bf16x8 __attribute__((ext_vector_type(8)));
typedef float f32x4 __attribute__((ext_vector_type(4)));
typedef unsigned u32x4 __attribute__((ext_vector_type(4)));
constexpr int FFH = 5632;
constexpr int BM = 256, BK = 64, HALF = 128, HTB = HALF * BK * 2  , STAGE_BYTES = 8 * HTB, NXCD = 8, WGM = 8;

__host__ __device__ __forceinline__ int lds_byte(int r, int c) { const int st = (r >> 4) * 2 + (c >> 5), rr = r & 15, cc = c & 31, ob = rr * 64 + cc * 2; return st * 1024 + (ob ^ (((ob >> 9) & 1) << 5)); }
__host__ __device__ __forceinline__ void stage_rc(int b, int& R, int& C) { const int st = b / 1024, sb = b % 1024, swz = sb ^ (((sb >> 9) & 1) << 5); R = (st >> 1) * 16 + swz / 64; C = (st & 1) * 32 + (swz % 64) / 2; }
__host__ __device__ __forceinline__ int perm32(int rho) { const int n = rho >> 4, i = rho & 15; return 8 * (i >> 2) + 4 * n + (i & 3); }

struct Unit { int pm, pn; };
struct Gemm { const bf16_t* A; const bf16_t* Bt; int K; int nMz; int nN; int ablk = 0, bblk = 0; };

struct StaticOrder {
    int nM, nN, nwg, G, c, base, count;
    __host__ __device__ void init(int nM_, int nN_, int G_, int c_) { nM = nM_; nN = nN_; nwg = nM * nN; G = G_; c = c_; base = 0; count = nwg; }
    __host__ __device__ void slice(int base_, int count_, int G_, int c_) { base = base_; count = count_; G = G_; c = c_; }
    __host__ __device__ bool next(int i, Unit& u) const {
        const long Lr = (long)i * G + c; if (Lr >= count) return false; const long L = base + Lr;
        int wgid = (int)L; { const int q = nwg / NXCD, r = nwg % NXCD, xcd = wgid % NXCD, off = wgid / NXCD; wgid = (xcd < r ? xcd * (q + 1) : r * (q + 1) + (xcd - r) * q) + off; }
        const int nig = WGM * nN, gid = wgid / nig, fm = gid * WGM, gsz = (nM - fm) < WGM ? (nM - fm) : WGM;
        u.pm = fm + ((wgid % nig) % gsz); u.pn = (wgid % nig) / gsz; return true;
    }
    __device__ __forceinline__ void a_ready(const Unit&) const {}
    __device__ __forceinline__ void done(const Unit&) const {}
};

struct SyncOrder : StaticOrder {
    unsigned* cnt; unsigned members; int w0;
    __device__ __forceinline__ void done(const Unit&) const {
        if (w0) {
            unsigned ln; asm volatile("v_mbcnt_lo_u32_b32 %0, -1, 0\n\tv_mbcnt_hi_u32_b32 %0, -1, %0" : "=v"(ln));
            unsigned old = 0u; if (ln == 0u) old = __hip_atomic_fetch_add(cnt, 1u, __ATOMIC_RELAXED, __HIP_MEMORY_SCOPE_AGENT);
            old = (unsigned)__builtin_amdgcn_readfirstlane((int)old);
            const unsigned target = (old / members + 1u) * members; unsigned sp = 0u;
            while ((unsigned)__builtin_amdgcn_readfirstlane((int)__hip_atomic_load(cnt, __ATOMIC_RELAXED, __HIP_MEMORY_SCOPE_AGENT)) < target) { __builtin_amdgcn_s_sleep(1); if (++sp > (1u << 16)) break; }
        }
        asm volatile("" ::: "memory"); __builtin_amdgcn_s_barrier(); asm volatile("" ::: "memory");
    }
};

__device__ __forceinline__ unsigned cvt_pk_bf16(float lo, float hi) { unsigned r; asm volatile("v_cvt_pk_bf16_f32 %0, %1, %2" : "=v"(r) : "v"(lo), "v"(hi)); return r; }

__device__ __forceinline__ float silu_f(float x) { return x * __builtin_amdgcn_rcpf(1.0f + __builtin_amdgcn_exp2f(-1.4426950408889634f * x)); }

typedef unsigned long long rss_t;
#define PG8_GAS __attribute__((address_space(1)))
__device__ __forceinline__ float rms_from_ss(rss_t v) { return __builtin_amdgcn_rsqf((float)v * (1.0f / (2048.0f * 1048576.0f)) + 1e-6f); }
__device__ __forceinline__ float rms_scale(const rss_t* rss, int row) { return rms_from_ss(((const PG8_GAS rss_t*)rss)[row]); }
struct EpiSwiGLU {
    static constexpr bool PERM = true, AFTER_DRAIN = false, ROWTAB = true;
    bf16_t* O; int ldc; const rss_t* rss; PG8_LAS float* tab;
    __device__ __forceinline__ void fill_table(int pm, int par, int tid) const { if (tid < 256) tab[par * 256 + tid] = rms_scale(rss, pm * BM + tid); }
    __device__ __forceinline__ void operator()(const f32x4 (&acc)[2][2][4][2], const Unit& u, int wr, int wc, int fr, int fq, int par) const {
        bf16_t* rowp = O + ((size_t)(u.pm * (FFH / 64) + 2 * u.pn + (wc >> 1)) * BM + wr * 64 + fr) * 64 + (wc & 1) * 32 + 8 * fq;
        float sv[2][4];
#pragma unroll
        for (int ai = 0; ai < 2; ++ai)
#pragma unroll
            for (int m = 0; m < 4; ++m) sv[ai][m] = tab[par * 256 + wr * 64 + fr + ai * HALF + m * 16];
#pragma unroll
        for (int ai = 0; ai < 2; ++ai) {
#pragma unroll
            for (int m = 0; m < 4; ++m) { const float rs = sv[ai][m], rsn = rs * -1.4426950408889634f, rs2 = rs * rs;
                f32x4 e0 = acc[ai][0][m][0] * rsn, e1 = acc[ai][0][m][1] * rsn;
#pragma unroll
                for (int j = 0; j < 4; ++j) { e0[j] = __builtin_amdgcn_exp2f(e0[j]); e1[j] = __builtin_amdgcn_exp2f(e1[j]); }
                e0 = e0 + 1.0f; e1 = e1 + 1.0f;
#pragma unroll
                for (int j = 0; j < 4; ++j) { e0[j] = __builtin_amdgcn_rcpf(e0[j]); e1[j] = __builtin_amdgcn_rcpf(e1[j]); }
                const f32x4 v0 = (acc[ai][0][m][0] * acc[ai][1][m][0]) * rs2 * e0, v1 = (acc[ai][0][m][1] * acc[ai][1][m][1]) * rs2 * e1;
                u32x4 w; w.x = cvt_pk_bf16(v0[0], v0[1]); w.y = cvt_pk_bf16(v0[2], v0[3]); w.z = cvt_pk_bf16(v1[0], v1[1]); w.w = cvt_pk_bf16(v1[2], v1[3]);
                *(PG8_GAS u32x4*)rowp = w; rowp += (size_t)16 * ldc; asm volatile("" : "+v"(rowp)); }
            rowp += (size_t)64 * ldc; asm volatile("" : "+v"(rowp)); }
    }
};
typedef __bf16 bf16x2_t __attribute__((ext_vector_type(2)));
__device__ __forceinline__ float dot2_bf16(unsigned w, float acc) { const bf16x2_t v = __builtin_bit_cast(bf16x2_t, w); return __builtin_amdgcn_fdot2_f32_bf16(v, v, acc, false); }
struct EpiResid16 {
    static constexpr bool PERM = true, AFTER_DRAIN = false, ROWTAB = false;
    const bf16_t* base; bf16_t* out; float scale; rss_t* rss_out;
    __device__ __forceinline__ void operator()(const f32x4 (&acc)[2][2][4][2], const Unit& u, int wr, int wc, int fr, int fq) const {
        const int row0 = u.pm * BM + wr * 64 + fr;
        const size_t off0 = ((size_t)(u.pm * 32 + 4 * u.pn + (wc >> 1)) * BM + wr * 64 + fr) * 64 + (wc & 1) * 32 + 8 * fq;
        const int l1 = (((fq ^ 1) << 4) | fr) << 2, l2 = (((fq ^ 2) << 4) | fr) << 2;
        u32x4 bs2[2][4][2];
#pragma unroll
        for (int ai = 0; ai < 2; ++ai)
#pragma unroll
            for (int m = 0; m < 4; ++m)
#pragma unroll
                for (int bj = 0; bj < 2; ++bj) bs2[ai][m][bj] = *(const PG8_GAS u32x4*)(base + off0 + (size_t)(ai * HALF + m * 16) * 64 + (size_t)bj * 2 * BM * 64);
        float ssv[2][4];
#pragma unroll
        for (int ai = 0; ai < 2; ++ai) {
#pragma unroll
            for (int m = 0; m < 4; ++m) {
                float ss = 0.f;
#pragma unroll
                for (int bj = 0; bj < 2; ++bj) { const u32x4 b4 = bs2[ai][m][bj];
                    f32x4 b0, b1; b0[0] = __uint_as_float(b4.x << 16); b0[1] = __uint_as_float(b4.x & 0xffff0000u); b0[2] = __uint_as_float(b4.y << 16); b0[3] = __uint_as_float(b4.y & 0xffff0000u);
                    b1[0] = __uint_as_float(b4.z << 16); b1[1] = __uint_as_float(b4.z & 0xffff0000u); b1[2] = __uint_as_float(b4.w << 16); b1[3] = __uint_as_float(b4.w & 0xffff0000u);
                    const f32x4 r0 = acc[ai][bj][m][0] * scale + b0, r1 = acc[ai][bj][m][1] * scale + b1;
                    u32x4 w; w.x = cvt_pk_bf16(r0[0], r0[1]); w.y = cvt_pk_bf16(r0[2], r0[3]); w.z = cvt_pk_bf16(r1[0], r1[1]); w.w = cvt_pk_bf16(r1[2], r1[3]);
                    *(PG8_GAS u32x4*)(out + off0 + (size_t)(ai * HALF + m * 16) * 64 + (size_t)bj * 2 * BM * 64) = w;
                    ss = dot2_bf16(w.x, ss); ss = dot2_bf16(w.y, ss); ss = dot2_bf16(w.z, ss); ss = dot2_bf16(w.w, ss); }
                ssv[ai][m] = ss;
            }
        }
#pragma unroll
        for (int ai = 0; ai < 2; ++ai)
#pragma unroll
            for (int m = 0; m < 4; ++m) ssv[ai][m] += __int_as_float(__builtin_amdgcn_ds_bpermute(l1, __float_as_int(ssv[ai][m])));
#pragma unroll
        for (int ai = 0; ai < 2; ++ai)
#pragma unroll
            for (int m = 0; m < 4; ++m) ssv[ai][m] += __int_as_float(__builtin_amdgcn_ds_bpermute(l2, __float_as_int(ssv[ai][m])));
        if (fq == 0) {
#pragma unroll
            for (int ai = 0; ai < 2; ++ai)
#pragma unroll
                for (int m = 0; m < 4; ++m) (void)__hip_atomic_fetch_add((PG8_GAS rss_t*)rss_out + row0 + ai * HALF + m * 16, (rss_t)(ssv[ai][m] * 1048576.0f + 0.5f), __ATOMIC_RELAXED, __HIP_MEMORY_SCOPE_AGENT);
        }
    }
};
struct EpiF32Tile {
    static constexpr bool PERM = false, AFTER_DRAIN = false, ROWTAB = false;
    float* C;
    __device__ __forceinline__ void operator()(const f32x4 (&acc)[2][2][4][2], const Unit& u, int wr, int wc, int fr, int fq) const {
        float* base = C + (size_t)(u.pm * BM + wr * 64 + fr) * 256 + wc * 32 + 4 * fq;
#pragma unroll
        for (int ai = 0; ai < 2; ++ai)
#pragma unroll
            for (int m = 0; m < 4; ++m) { float* rowp = base + (size_t)(ai * HALF + m * 16) * 256;
#pragma unroll
                for (int bj = 0; bj < 2; ++bj)
#pragma unroll
                    for (int n = 0; n < 2; ++n) *(f32x4*)(rowp + bj * HALF + n * 16) = acc[ai][bj][m][n]; }
    }
};
template <int KIND> struct EpiBf16K {
    static constexpr bool PERM = true, AFTER_DRAIN = false, ROWTAB = (KIND == 0);
    bf16_t* O; const float* cs; float scale; int mrows; const rss_t* rss; float* gat; const float* gbias; PG8_LAS float* tab;
    __device__ __forceinline__ void fill_table(int pm, int par, int tid) const { if (tid < 256) tab[par * 256 + tid] = rms_scale(rss, pm * BM + tid); }
    __device__ __forceinline__ void operator()(const f32x4 (&acc)[2][2][4][2], const Unit& u, int wr, int wc, int fr, int fq, int par = 0) const {
        bf16_t* base; int ldc; const float* csp = nullptr;
        if (KIND == 0) { ldc = 5376; base = O + (size_t)u.pm * BM * ldc + u.pn * BM; }
        else if (KIND == 1) { ldc = 512; const int h = u.pn >> 1; base = O + ((size_t)h * mrows + (size_t)u.pm * BM) * 512 + (u.pn & 1) * BM; }
        else if (KIND == 2) { ldc = 256; const int h = u.pm >> 1; base = O + ((size_t)(h * 16 + u.pn) * 512 + (size_t)(u.pm & 1) * BM) * 256; }
        else if (KIND == 3) { ldc = 2048; const int g = u.pm >> 7, pl = u.pm & 127; base = O + (size_t)pl * BM * 2048 + g * BM; csp = cs + g * BM; }
        else if (KIND == 4) { ldc = 2048; const int z = u.pm >> 3, pl = u.pm & 7, h = z >> 4, b = z & 15; base = O + ((size_t)b * 2048 + (size_t)pl * BM) * 2048 + h * 512 + u.pn * BM; }
        else if (KIND == 5) { ldc = 2048; const int h = u.pm >> 4, b = u.pm & 15; base = O + (size_t)(b * 4 + h) * BM * 2048 + u.pn * BM; }
        else { ldc = 1024; const int h = u.pm >> 3, np = u.pm & 7; base = O + ((size_t)u.pn * 2048 + (size_t)np * BM) * 1024 + h * BM; }
        const int row0 = wr * 64 + fr, col0 = wc * 32 + 8 * fq;
        float rsv[2][4];
#pragma unroll
        for (int ai = 0; ai < 2; ++ai)
#pragma unroll
            for (int m = 0; m < 4; ++m) rsv[ai][m] = (KIND == 0) ? scale * tab[par * 256 + row0 + ai * HALF + m * 16] : ((KIND == 1 && rss) ? scale * rms_scale(rss, u.pm * BM + row0 + ai * HALF + m * 16) : scale);
        if (KIND == 0 && u.pn == 20) {
            if (wc == 0 && fq == 0) { const f32x4 bi = *(const f32x4*)gbias, bf = *(const f32x4*)(gbias + 4);
#pragma unroll
                for (int ai = 0; ai < 2; ++ai)
#pragma unroll
                    for (int m = 0; m < 4; ++m) { const f32x4 li = acc[ai][0][m][0] * rsv[ai][m] + bi, xf = acc[ai][0][m][1] * rsv[ai][m] + bf; f32x4 lf;
#pragma unroll
                        for (int j = 0; j < 4; ++j) lf[j] = fminf(xf[j], 0.f) - log1pf(expf(-fabsf(xf[j])));
                        float* gp = gat + (size_t)(u.pm * BM + row0 + ai * HALF + m * 16) * 8; *(f32x4*)gp = li; *(f32x4*)(gp + 4) = lf; } }
            return; }
        bf16_t* rowp = base + (size_t)row0 * ldc + col0; size_t rstep = (size_t)ldc, bjstep = HALF;
        if (KIND == 3) {
            const int g = u.pm >> 7, pl = u.pm & 127; rowp = O + ((size_t)(pl * 32 + 4 * g + (wc >> 1)) * BM + row0) * 64 + (wc & 1) * 32 + 8 * fq; rstep = 64; bjstep = (size_t)2 * BM * 64; }
#pragma unroll
        for (int bj = 0; bj < 2; ++bj) {
            f32x4 s0 = (f32x4){1.f, 1.f, 1.f, 1.f}, s1 = s0;
            if (KIND == 3) { s0 = *(const f32x4*)(csp + col0 + bj * HALF); s1 = *(const f32x4*)(csp + col0 + bj * HALF + 4); }
            bf16_t* rp = rowp + bj * bjstep;
#pragma unroll
            for (int ai = 0; ai < 2; ++ai) {
#pragma unroll
                for (int m = 0; m < 4; ++m) { const f32x4 v0 = acc[ai][bj][m][0] * s0 * rsv[ai][m], v1 = acc[ai][bj][m][1] * s1 * rsv[ai][m];
                    u32x4 w; w.x = cvt_pk_bf16(v0[0], v0[1]); w.y = cvt_pk_bf16(v0[2], v0[3]); w.z = cvt_pk_bf16(v1[0], v1[1]); w.w = cvt_pk_bf16(v1[2], v1[3]);
                    *(PG8_GAS u32x4*)rp = w; rp += 16 * rstep; asm volatile("" : "+v"(rp)); }
                rp += 64 * rstep; asm volatile("" : "+v"(rp)); }
        }
    }
};

struct EpiSoftmaxP {
    static constexpr bool PERM = true, AFTER_DRAIN = false, ROWTAB = false;
    bf16_t* P; const rss_t* rss; PG8_LAS float* scr;
    __device__ __forceinline__ void operator()(f32x4 (&acc)[2][2][4][2], const Unit& u, int wr, int wc, int fr, int fq) const {
        const int l1 = (((fq ^ 1) << 4) | fr) << 2, l2 = (((fq ^ 2) << 4) | fr) << 2, rowb = wr * 64 + fr;
        unsigned wo_ = (unsigned)(rowb * 4 + wc) * 4u, ro_ = (unsigned)(rowb * 4) * 4u; asm volatile("" : "+v"(wo_), "+v"(ro_));
        PG8_LAS float* wb = (PG8_LAS float*)((PG8_LAS unsigned char*)scr + wo_);
        const PG8_LAS float* rb = (const PG8_LAS float*)((const PG8_LAS unsigned char*)scr + ro_);
#pragma unroll
        for (int ai = 0; ai < 2; ++ai)
#pragma unroll
            for (int m = 0; m < 4; ++m) { const int row = rowb + ai * HALF + m * 16; const float rs = rms_scale(rss, u.pm * BM + row); float mx = -3.0e38f;
#pragma unroll
                for (int bj = 0; bj < 2; ++bj)
#pragma unroll
                    for (int n = 0; n < 2; ++n) { const f32x4 v = acc[ai][bj][m][n] * rs; acc[ai][bj][m][n] = v; mx = fmaxf(mx, fmaxf(fmaxf(v[0], v[1]), fmaxf(v[2], v[3]))); }
                mx = fmaxf(mx, __int_as_float(__builtin_amdgcn_ds_bpermute(l1, __float_as_int(mx)))); mx = fmaxf(mx, __int_as_float(__builtin_amdgcn_ds_bpermute(l2, __float_as_int(mx))));
                if (fq == 0) wb[(ai * HALF + m * 16) * 4] = mx; }
        asm volatile("s_waitcnt lgkmcnt(0)" ::: "memory"); __builtin_amdgcn_s_barrier(); asm volatile("" ::: "memory");
#pragma unroll
        for (int ai = 0; ai < 2; ++ai)
#pragma unroll
            for (int m = 0; m < 4; ++m) { const f32x4 mv = *(const PG8_LAS f32x4*)(rb + (ai * HALF + m * 16) * 4);
                const float rmax = fmaxf(fmaxf(mv[0], mv[1]), fmaxf(mv[2], mv[3])) * 1.4426950408889634f; float sm = 0.f;
#pragma unroll
                for (int bj = 0; bj < 2; ++bj)
#pragma unroll
                    for (int n = 0; n < 2; ++n) { f32x4 e;
#pragma unroll
                        for (int j = 0; j < 4; ++j) e[j] = __builtin_amdgcn_exp2f(acc[ai][bj][m][n][j] * 1.4426950408889634f - rmax);
                        acc[ai][bj][m][n] = e; sm += (e[0] + e[1]) + (e[2] + e[3]); }
                sm += __int_as_float(__builtin_amdgcn_ds_bpermute(l1, __float_as_int(sm))); sm += __int_as_float(__builtin_amdgcn_ds_bpermute(l2, __float_as_int(sm)));
                if (fq == 0) wb[1024 + (ai * HALF + m * 16) * 4] = sm; }
        asm volatile("s_waitcnt lgkmcnt(0)" ::: "memory"); __builtin_amdgcn_s_barrier(); asm volatile("" ::: "memory");
        bf16_t* rp = P + ((size_t)(u.pm * 16 + 4 * u.pn + (wc >> 1)) * BM + rowb) * 64 + (wc & 1) * 32 + 8 * fq;
#pragma unroll
        for (int ai = 0; ai < 2; ++ai) {
#pragma unroll
            for (int m = 0; m < 4; ++m) { const f32x4 sv = *(const PG8_LAS f32x4*)(rb + 1024 + (ai * HALF + m * 16) * 4); const float inv = 1.0f / ((sv[0] + sv[1]) + (sv[2] + sv[3]));
#pragma unroll
                for (int bj = 0; bj < 2; ++bj) { const f32x4 v0 = acc[ai][bj][m][0] * inv, v1 = acc[ai][bj][m][1] * inv;
                    u32x4 w; w.x = cvt_pk_bf16(v0[0], v0[1]); w.y = cvt_pk_bf16(v0[2], v0[3]); w.z = cvt_pk_bf16(v1[0], v1[1]); w.w = cvt_pk_bf16(v1[2], v1[3]);
                    *(PG8_GAS u32x4*)(rp + (size_t)bj * 2 * BM * 64) = w; }
                rp += (size_t)16 * 64; asm volatile("" : "+v"(rp)); }
            rp += (size_t)64 * 64; asm volatile("" : "+v"(rp)); }
    }
};

template <class Epi, class Sched, bool ALIGN_EPI = false, bool SP2 = false, bool PEEL = false>
__device__ __forceinline__ void gemm_phase(PG8_LAS unsigned char* lds, const Gemm g, const Sched& S, const Epi& E, int tid_in) {
    int tid_ = tid_in; asm volatile("" : "+v"(tid_));
    const int tid = tid_, wid = __builtin_amdgcn_readfirstlane(tid >> 6), lane = tid & 63, wr = wid >> 2, wc = wid & 3, fr = lane & 15, fq = lane >> 4;
    int K_ = g.K; asm volatile("" : "+s"(K_));
    const int K = K_, nt = K / BK;
    unsigned voffA[2], voffB[2];
#pragma unroll
    for (int i = 0; i < 2; ++i) { int R, C; stage_rc(tid * 16 + i * 8192, R, C); const int Rb = Epi::PERM ? ((R & ~31) + perm32(R & 31)) : R;
        voffA[i] = (unsigned)(R * (g.ablk ? BK : K) + C) * 2u; voffB[i] = (unsigned)(Rb * (g.bblk ? BK : K) + C) * 2u; }
    const size_t kstep = (size_t)(BK * 2);
    const size_t hstep = (size_t)HALF * K * 2;
    const size_t tstep = 2 * hstep;
    const size_t kstepB = g.bblk ? (size_t)(BM * BK * 2) : kstep, hstepB = g.bblk ? (size_t)(HALF * BK * 2) : hstep;
    const size_t kstepA = g.ablk ? (size_t)(BM * BK * 2) : kstep, hstepA = g.ablk ? (size_t)(HALF * BK * 2) : hstep;
    const unsigned ldsw = (unsigned)wid * 1024u;
    const int aoff = lds_byte(wr * 64 + fr, fq * 8), boff = lds_byte(wc * 32 + fr, fq * 8);
#define PG8_SA(b, h) (((b) * 2 + (h)) * HTB)
#define PG8_SB(b, h) ((4 + (b) * 2 + (h)) * HTB)
#define PG8_STAGE(bufoff, gbase, voff) do { _Pragma("unroll") for (int _i = 0; _i < 2; ++_i) { asm volatile("" : "+v"((voff)[_i])); \
        __builtin_amdgcn_global_load_lds((const unsigned*)((const char*)(gbase) + (voff)[_i]), (PG8_LAS unsigned*)(lds + (bufoff) + ldsw + _i * 8192), 16, 0, 0); } } while (0)
#define PG8_LDA(dst, b, h) do { _Pragma("unroll") for (int m = 0; m < 4; ++m) _Pragma("unroll") for (int k = 0; k < 2; ++k) dst[m][k] = *(const PG8_LAS bf16x8*)(lds + PG8_SA(b, h) + aoff + m * 2048 + k * 1024); } while (0)
#define PG8_LDB(dst, b, h) do { _Pragma("unroll") for (int n = 0; n < 2; ++n) _Pragma("unroll") for (int k = 0; k < 2; ++k) dst[n][k] = *(const PG8_LAS bf16x8*)(lds + PG8_SB(b, h) + boff + n * 2048 + k * 1024); } while (0)
#define PG8_MMA(ai, bj, At, Bt) do { __builtin_amdgcn_s_setprio(1); _Pragma("unroll") for (int m = 0; m < 4; ++m) _Pragma("unroll") for (int n = 0; n < 2; ++n) _Pragma("unroll") for (int k = 0; k < 2; ++k) \
        acc[ai][bj][m][n] = __builtin_amdgcn_mfma_f32_16x16x32_bf16(Bt[n][k], At[m][k], acc[ai][bj][m][n], 0, 0, 0); __builtin_amdgcn_s_setprio(0); } while (0)
#define PG8_MMAZ(ZC, ai, bj, At, Bt) do { __builtin_amdgcn_s_setprio(1); _Pragma("unroll") for (int m = 0; m < 4; ++m) _Pragma("unroll") for (int n = 0; n < 2; ++n) _Pragma("unroll") for (int k = 0; k < 2; ++k) \
        acc[ai][bj][m][n] = __builtin_amdgcn_mfma_f32_16x16x32_bf16(Bt[n][k], At[m][k], ((ZC) && k == 0) ? (f32x4){0.f, 0.f, 0.f, 0.f} : acc[ai][bj][m][n], 0, 0, 0); __builtin_amdgcn_s_setprio(0); } while (0)
#define PG8_WAIT_V(n) asm volatile("s_waitcnt vmcnt(" #n ")" ::: "memory")
#define PG8_WAIT_L(n) asm volatile("s_waitcnt lgkmcnt(" #n ")" ::: "memory")
#define PG8_BAR __builtin_amdgcn_s_barrier()
#define PG8_SCHED __builtin_amdgcn_sched_barrier(0)
#define PG8_BIDX(u) ((size_t)((g.nMz ? ((u).pm / g.nMz) * g.nN : 0) + (u).pn))
#define PG8_KITER(ZC) do { \
            const bool last = (t == nt - 2); \
            const char* a1 = cA + (size_t)(t + 1) * kstepA; \
            const char* a2 = last ? nA : cA + (size_t)(t + 2) * kstepA; const char* b2 = last ? nB : cB + (size_t)(t + 2) * kstepB; \
            const char* a3 = a2 + kstepA; const char* b3 = b2 + kstepB; \
            if (last && has_next) S.a_ready(nxt); \
            if constexpr (Epi::ROWTAB) { if (last && has_next && nxt.pm != cur.pm) E.fill_table(nxt.pm, rtpar ^ 1, tid); } \
            PG8_LDB(B0, 0, 0); PG8_LDB(B1, 0, 1); PG8_SCHED; PG8_LDA(At, 0, 0); PG8_STAGE(PG8_SA(1, 1), a1 + hstepA, voffA); \
            PG8_WAIT_V(8); PG8_WAIT_L(0); PG8_BAR; PG8_MMAZ(ZC, 0, 0, At, B0); PG8_MMAZ(ZC, 0, 1, At, B1); PG8_BAR; PG8_SCHED; \
            PG8_LDA(At, 0, 1); PG8_STAGE(PG8_SB(0, 0), b2, voffB); PG8_STAGE(PG8_SB(0, 1), b2 + hstepB, voffB); PG8_STAGE(PG8_SA(0, 0), a2, voffA); \
            PG8_WAIT_V(8); PG8_WAIT_L(0); PG8_BAR; PG8_MMAZ(ZC, 1, 0, At, B0); PG8_MMAZ(ZC, 1, 1, At, B1); PG8_BAR; PG8_SCHED; \
            PG8_LDB(B0, 1, 0); PG8_LDB(B1, 1, 1); PG8_SCHED; PG8_LDA(At, 1, 0); PG8_STAGE(PG8_SA(0, 1), a2 + hstepA, voffA); \
            PG8_WAIT_V(8); PG8_WAIT_L(0); PG8_BAR; PG8_MMA(0, 0, At, B0); PG8_MMA(0, 1, At, B1); PG8_BAR; PG8_SCHED; \
            PG8_LDA(At, 1, 1); PG8_STAGE(PG8_SB(1, 0), b3, voffB); PG8_STAGE(PG8_SB(1, 1), b3 + hstepB, voffB); PG8_STAGE(PG8_SA(1, 0), a3, voffA); \
            PG8_WAIT_V(8); PG8_WAIT_L(0); PG8_BAR; PG8_MMA(1, 0, At, B0); PG8_MMA(1, 1, At, B1); PG8_BAR; PG8_SCHED; \
        } while (0)
    Unit cur, nxt; int ui = 0;
    if (!S.next(0, cur)) return;
#define PG8_ZERO_ACC() do { f16x4_t z_ = (f16x4_t){(_Float16)0, (_Float16)0, (_Float16)0, (_Float16)0}; asm volatile("" : "+v"(z_)); \
          \
        acc[0][0][0][0] = __builtin_amdgcn_mfma_f32_4x4x4f16(z_, z_, (f32x4){0.f, 0.f, 0.f, 0.f}, 4, 0, 0); acc[0][0][0][1] = __builtin_amdgcn_mfma_f32_4x4x4f16(z_, z_, (f32x4){0.f, 0.f, 0.f, 0.f}, 4, 1, 0); \
        acc[0][0][1][0] = __builtin_amdgcn_mfma_f32_4x4x4f16(z_, z_, (f32x4){0.f, 0.f, 0.f, 0.f}, 4, 2, 0); acc[0][0][1][1] = __builtin_amdgcn_mfma_f32_4x4x4f16(z_, z_, (f32x4){0.f, 0.f, 0.f, 0.f}, 4, 3, 0); \
        acc[0][0][2][0] = __builtin_amdgcn_mfma_f32_4x4x4f16(z_, z_, (f32x4){0.f, 0.f, 0.f, 0.f}, 4, 4, 0); acc[0][0][2][1] = __builtin_amdgcn_mfma_f32_4x4x4f16(z_, z_, (f32x4){0.f, 0.f, 0.f, 0.f}, 4, 5, 0); \
        acc[0][0][3][0] = __builtin_amdgcn_mfma_f32_4x4x4f16(z_, z_, (f32x4){0.f, 0.f, 0.f, 0.f}, 4, 6, 0); acc[0][0][3][1] = __builtin_amdgcn_mfma_f32_4x4x4f16(z_, z_, (f32x4){0.f, 0.f, 0.f, 0.f}, 4, 7, 0); \
        acc[0][1][0][0] = __builtin_amdgcn_mfma_f32_4x4x4f16(z_, z_, (f32x4){0.f, 0.f, 0.f, 0.f}, 4, 8, 0); acc[0][1][0][1] = __builtin_amdgcn_mfma_f32_4x4x4f16(z_, z_, (f32x4){0.f, 0.f, 0.f, 0.f}, 4, 9, 0); \
        acc[0][1][1][0] = __builtin_amdgcn_mfma_f32_4x4x4f16(z_, z_, (f32x4){0.f, 0.f, 0.f, 0.f}, 4, 10, 0); acc[0][1][1][1] = __builtin_amdgcn_mfma_f32_4x4x4f16(z_, z_, (f32x4){0.f, 0.f, 0.f, 0.f}, 4, 11, 0); \
        acc[0][1][2][0] = __builtin_amdgcn_mfma_f32_4x4x4f16(z_, z_, (f32x4){0.f, 0.f, 0.f, 0.f}, 4, 12, 0); acc[0][1][2][1] = __builtin_amdgcn_mfma_f32_4x4x4f16(z_, z_, (f32x4){0.f, 0.f, 0.f, 0.f}, 4, 13, 0); \
        acc[0][1][3][0] = __builtin_amdgcn_mfma_f32_4x4x4f16(z_, z_, (f32x4){0.f, 0.f, 0.f, 0.f}, 4, 14, 0); acc[0][1][3][1] = __builtin_amdgcn_mfma_f32_4x4x4f16(z_, z_, (f32x4){0.f, 0.f, 0.f, 0.f}, 4, 15, 0); \
        acc[1][0][0][0] = __builtin_amdgcn_mfma_f32_4x4x4f16(z_, z_, (f32x4){0.f, 0.f, 0.f, 0.f}, 4, 0, 1); acc[1][0][0][1] = __builtin_amdgcn_mfma_f32_4x4x4f16(z_, z_, (f32x4){0.f, 0.f, 0.f, 0.f}, 4, 1, 1); \
        acc[1][0][1][0] = __builtin_amdgcn_mfma_f32_4x4x4f16(z_, z_, (f32x4){0.f, 0.f, 0.f, 0.f}, 4, 2, 1); acc[1][0][1][1] = __builtin_amdgcn_mfma_f32_4x4x4f16(z_, z_, (f32x4){0.f, 0.f, 0.f, 0.f}, 4, 3, 1); \
        acc[1][0][2][0] = __builtin_amdgcn_mfma_f32_4x4x4f16(z_, z_, (f32x4){0.f, 0.f, 0.f, 0.f}, 4, 4, 1); acc[1][0][2][1] = __builtin_amdgcn_mfma_f32_4x4x4f16(z_, z_, (f32x4){0.f, 0.f, 0.f, 0.f}, 4, 5, 1); \
        acc[1][0][3][0] = __builtin_amdgcn_mfma_f32_4x4x4f16(z_, z_, (f32x4){0.f, 0.f, 0.f, 0.f}, 4, 6, 1); acc[1][0][3][1] = __builtin_amdgcn_mfma_f32_4x4x4f16(z_, z_, (f32x4){0.f, 0.f, 0.f, 0.f}, 4, 7, 1); \
        acc[1][1][0][0] = __builtin_amdgcn_mfma_f32_4x4x4f16(z_, z_, (f32x4){0.f, 0.f, 0.f, 0.f}, 4, 8, 1); acc[1][1][0][1] = __builtin_amdgcn_mfma_f32_4x4x4f16(z_, z_, (f32x4){0.f, 0.f, 0.f, 0.f}, 4, 9, 1); \
        acc[1][1][1][0] = __builtin_amdgcn_mfma_f32_4x4x4f16(z_, z_, (f32x4){0.f, 0.f, 0.f, 0.f}, 4, 10, 1); acc[1][1][1][1] = __builtin_amdgcn_mfma_f32_4x4x4f16(z_, z_, (f32x4){0.f, 0.f, 0.f, 0.f}, 4, 11, 1); \
        acc[1][1][2][0] = __builtin_amdgcn_mfma_f32_4x4x4f16(z_, z_, (f32x4){0.f, 0.f, 0.f, 0.f}, 4, 12, 1); acc[1][1][2][1] = __builtin_amdgcn_mfma_f32_4x4x4f16(z_, z_, (f32x4){0.f, 0.f, 0.f, 0.f}, 4, 13, 1); \
        acc[1][1][3][0] = __builtin_amdgcn_mfma_f32_4x4x4f16(z_, z_, (f32x4){0.f, 0.f, 0.f, 0.f}, 4, 14, 1); acc[1][1][3][1] = __builtin_amdgcn_mfma_f32_4x4x4f16(z_, z_, (f32x4){0.f, 0.f, 0.f, 0.f}, 4, 15, 1); } while (0)
    f32x4 acc[2][2][4][2];
    if constexpr (!(PEEL && SP2)) PG8_ZERO_ACC();
    bf16x8 At[4][2], B0[2][2], B1[2][2];
    const char* cA = (const char*)g.A + (size_t)cur.pm * tstep; const char* cB = (const char*)g.Bt + PG8_BIDX(cur) * tstep;
    S.a_ready(cur);
    int rtpar = 0;
    if constexpr (Epi::ROWTAB) E.fill_table(cur.pm, 0, tid);
    if constexpr (SP2) {
        PG8_STAGE(PG8_SB(0, 0), cB, voffB); PG8_STAGE(PG8_SB(0, 1), cB + hstepB, voffB); PG8_STAGE(PG8_SA(0, 0), cA, voffA); PG8_STAGE(PG8_SA(0, 1), cA + hstepA, voffA);
        if (wr == 1) PG8_BAR;
        PG8_WAIT_V(2); PG8_BAR;
        PG8_STAGE(PG8_SB(1, 0), cB + kstepB, voffB); PG8_STAGE(PG8_SA(1, 0), cA + kstepA, voffA); PG8_STAGE(PG8_SB(1, 1), cB + hstepB + kstepB, voffB);
        PG8_WAIT_V(6); PG8_BAR;
    } else {
        PG8_STAGE(PG8_SB(0, 0), cB, voffB); PG8_STAGE(PG8_SA(0, 0), cA, voffA); PG8_STAGE(PG8_SB(0, 1), cB + hstepB, voffB); PG8_STAGE(PG8_SA(0, 1), cA + hstepA, voffA);
        if (wr == 1) PG8_BAR;
        PG8_WAIT_V(4); PG8_BAR;
        PG8_STAGE(PG8_SB(1, 0), cB + kstepB, voffB); PG8_STAGE(PG8_SA(1, 0), cA + kstepA, voffA); PG8_STAGE(PG8_SB(1, 1), cB + hstepB + kstepB, voffB);
        PG8_WAIT_V(6); PG8_BAR;
    }
    for (;;) {
        const bool has_next = S.next(ui + 1, nxt);
        const char* nA = has_next ? (const char*)g.A + (size_t)nxt.pm * tstep : cA; const char* nB = has_next ? (const char*)g.Bt + PG8_BIDX(nxt) * tstep : cB;
        if constexpr (PEEL && SP2) { int t = 0; PG8_KITER(true); for (t = 2; t < nt; t += 2) PG8_KITER(false); } else
        for (int t = 0; t < nt; t += 2) {
            const bool last = (t == nt - 2);
            const char* a1 = cA + (size_t)(t + 1) * kstepA;
            const char* a2 = last ? nA : cA + (size_t)(t + 2) * kstepA; const char* b2 = last ? nB : cB + (size_t)(t + 2) * kstepB;
            const char* a3 = a2 + kstepA; const char* b3 = b2 + kstepB;
            if (last && has_next) S.a_ready(nxt);
            if constexpr (Epi::ROWTAB) { if (last && has_next && nxt.pm != cur.pm) E.fill_table(nxt.pm, rtpar ^ 1, tid); }
            if constexpr (SP2) {
            PG8_LDB(B0, 0, 0); PG8_LDB(B1, 0, 1); PG8_SCHED; PG8_LDA(At, 0, 0); PG8_STAGE(PG8_SA(1, 1), a1 + hstepA, voffA);
            PG8_WAIT_V(8); PG8_WAIT_L(0); PG8_BAR; PG8_MMA(0, 0, At, B0); PG8_MMA(0, 1, At, B1); PG8_BAR; PG8_SCHED;
            PG8_LDA(At, 0, 1); PG8_STAGE(PG8_SB(0, 0), b2, voffB); PG8_STAGE(PG8_SB(0, 1), b2 + hstepB, voffB); PG8_STAGE(PG8_SA(0, 0), a2, voffA);
            PG8_WAIT_V(8); PG8_WAIT_L(0); PG8_BAR; PG8_MMA(1, 0, At, B0); PG8_MMA(1, 1, At, B1); PG8_BAR; PG8_SCHED;
            PG8_LDB(B0, 1, 0); PG8_LDB(B1, 1, 1); PG8_SCHED; PG8_LDA(At, 1, 0); PG8_STAGE(PG8_SA(0, 1), a2 + hstepA, voffA);
            PG8_WAIT_V(8); PG8_WAIT_L(0); PG8_BAR; PG8_MMA(0, 0, At, B0); PG8_MMA(0, 1, At, B1); PG8_BAR; PG8_SCHED;
            PG8_LDA(At, 1, 1); PG8_STAGE(PG8_SB(1, 0), b3, voffB); PG8_STAGE(PG8_SB(1, 1), b3 + hstepB, voffB); PG8_STAGE(PG8_SA(1, 0), a3, voffA);
            PG8_WAIT_V(8); PG8_WAIT_L(0); PG8_BAR; PG8_MMA(1, 0, At, B0); PG8_MMA(1, 1, At, B1); PG8_BAR; PG8_SCHED;
            } else {
            PG8_LDB(B0, 0, 0); PG8_SCHED; PG8_LDA(At, 0, 0); PG8_STAGE(PG8_SA(1, 1), a1 + hstepA, voffA);
            PG8_WAIT_L(8); PG8_BAR; PG8_WAIT_L(0); PG8_MMA(0, 0, At, B0); PG8_BAR; PG8_SCHED;
            PG8_LDB(B1, 0, 1); PG8_STAGE(PG8_SB(0, 0), b2, voffB);
            PG8_BAR; PG8_WAIT_L(0); PG8_MMA(0, 1, At, B1); PG8_BAR;
            PG8_LDA(At, 0, 1); PG8_STAGE(PG8_SA(0, 0), a2, voffA);
            PG8_BAR; PG8_WAIT_L(0); PG8_MMA(1, 0, At, B0); PG8_BAR; PG8_SCHED;
            PG8_STAGE(PG8_SB(0, 1), b2 + hstepB, voffB);
            PG8_WAIT_V(6); PG8_BAR; PG8_MMA(1, 1, At, B1); PG8_BAR;
            PG8_LDB(B0, 1, 0); PG8_SCHED; PG8_LDA(At, 1, 0); PG8_STAGE(PG8_SA(0, 1), a2 + hstepA, voffA);
            PG8_WAIT_L(8); PG8_BAR; PG8_WAIT_L(0); PG8_MMA(0, 0, At, B0); PG8_BAR; PG8_SCHED;
            PG8_LDB(B1, 1, 1); PG8_STAGE(PG8_SB(1, 0), b3, voffB);
            PG8_BAR; PG8_WAIT_L(0); PG8_MMA(0, 1, At, B1); PG8_BAR;
            PG8_LDA(At, 1, 1); PG8_STAGE(PG8_SA(1, 0), a3, voffA);
            PG8_BAR; PG8_WAIT_L(0); PG8_MMA(1, 0, At, B0); PG8_BAR; PG8_SCHED;
            PG8_STAGE(PG8_SB(1, 1), b3 + hstepB, voffB);
            PG8_WAIT_V(6); PG8_BAR; PG8_MMA(1, 1, At, B1); PG8_BAR;
            }
        }
        if constexpr (ALIGN_EPI) { if (wr == 0) PG8_BAR; }
        { int le_; asm volatile("v_mbcnt_lo_u32_b32 %0, -1, 0\n\tv_mbcnt_hi_u32_b32 %0, -1, %0" : "=v"(le_)); const int fre = le_ & 15, fqe = le_ >> 4;
          if constexpr (Epi::ROWTAB) E(acc, cur, wr, wc, fre, fqe, rtpar); else E(acc, cur, wr, wc, fre, fqe); }
        S.done(cur);
        if (!has_next) break;
        if constexpr (!(PEEL && SP2)) PG8_ZERO_ACC();
        if constexpr (Epi::ROWTAB) { if (nxt.pm != cur.pm) rtpar ^= 1; }
        cur = nxt; cA = nA; cB = nB; ++ui;
        if constexpr (ALIGN_EPI) { if (wr == 1) PG8_BAR; }
    }
    PG8_WAIT_V(0);
    if constexpr (!ALIGN_EPI) { if (wr == 0) PG8_BAR; }
    PG8_BAR;
#undef PG8_SA
#undef PG8_SB
#undef PG8_STAGE
#undef PG8_LDA
#undef PG8_LDB
#undef PG8_MMA
#undef PG8_WAIT_V
#undef PG8_WAIT_L
#undef PG8_BAR
#undef PG8_SCHED
#undef PG8_BIDX
#undef PG8_KITER
#undef PG8_MMAZ
#undef PG8_ZERO_ACC
}
}

#ifndef PG8_SP2
#define PG8_SP2 true
#endif
#ifndef PG8_ALIGN
#define PG8_ALIGN true
#endif

constexpr int NWAVES = 8;
constexpr int NB = 16, SEQ = 2048, D = 2048, M = NB * SEQ, DEPTH = 4, FF = 5632, NMEM = 256, MMEM = NB * NMEM;
constexpr int DIN = 5128, DINM = 5120, ZP = 5376;
constexpr float EPS = 1e-6f;
constexpr int N_PH = 12;
constexpr int N_RSS = 18;

constexpr size_t MiB = 1u << 20;
constexpr size_t WS_CTL = 0, WS_RSS = 1 * MiB, CTL_ZERO_BYTES = 8 * MiB;
static_assert(WS_RSS + (size_t)N_RSS * M * 8 <= CTL_ZERO_BYTES, "rss inside the memset region");
constexpr size_t WS_H    = 8 * MiB;
constexpr size_t WS_U    = WS_H + 256 * MiB;
constexpr size_t WS_BIG  = WS_U + 128 * MiB;
constexpr size_t WS_X1   = WS_BIG + 352 * MiB;
constexpr size_t WS_X2   = WS_X1 + 128 * MiB;
constexpr size_t WS_HM   = WS_X2 + 64 * MiB;
constexpr size_t WS_GAT  = WS_HM + 64 * MiB;
constexpr size_t WS_KB   = WS_GAT + 1 * MiB;
constexpr size_t WS_VT   = WS_KB + 16 * MiB;
constexpr size_t WS_MEMN = WS_VT + 16 * MiB;
constexpr size_t WS_WGU1 = WS_MEMN + 16 * MiB;
constexpr size_t WS_WD1  = WS_WGU1 + 44 * MiB;
constexpr size_t WS_WGU2 = WS_WD1 + 22 * MiB;
constexpr size_t WS_WD2  = WS_WGU2 + 44 * MiB;
constexpr size_t WS_WIN  = WS_WD2 + 22 * MiB;
constexpr size_t WS_WPOOL= WS_WIN + 21 * MiB;
constexpr size_t WS_WOUT = WS_WPOOL + 1 * MiB;
constexpr size_t WS_WQ   = WS_WOUT + 8 * MiB;
constexpr size_t WS_WKV  = WS_WQ + 8 * MiB;
constexpr size_t WS_WO   = WS_WKV + 16 * MiB;
constexpr size_t WS_END  = WS_WO + 8 * MiB;
constexpr size_t WS_GT = WS_H + 128 * MiB, WS_VWT = WS_H + 192 * MiB;
constexpr int CW_TMO = 0, CW_BAR = 4096, CW_SYNC = 16384;

constexpr int RING_OFF = 0, RING_BYTES = 131072;
constexpr int LDSCTL_OFF = RING_BYTES, MISC_OFF = 147456 - 128;
constexpr int LDS_BYTES = 147456;

#define GAS __attribute__((address_space(1)))
#define LAS __attribute__((address_space(3)))
typedef unsigned short bf16;
typedef unsigned v4u __attribute__((ext_vector_type(4)));
typedef unsigned v2u __attribute__((ext_vector_type(2)));
typedef unsigned u32x4v __attribute__((ext_vector_type(4)));
typedef float f32x4 __attribute__((ext_vector_type(4)));
typedef GAS unsigned gu32;
#define RLX_AGENT __ATOMIC_RELAXED, __HIP_MEMORY_SCOPE_AGENT
#define LDS_WAIT() asm volatile("s_waitcnt lgkmcnt(0)" ::: "memory")
__device__ __forceinline__ unsigned pk2(float lo, float hi) { return pg8::cvt_pk_bf16(lo, hi); }
__device__ __forceinline__ float bflo(unsigned w) { return __uint_as_float(w << 16); }
__device__ __forceinline__ float bfhi(unsigned w) { return __uint_as_float(w & 0xffff0000u); }
__device__ __forceinline__ size_t h16_off(int m, int c) { return ((size_t)((m >> 8) * 32 + (c >> 6)) * 256 + (m & 255)) * 64 + (c & 63); }

#define XB_TMO      128
#define XB_XCNT(j)  (256  + 64 * (j))
#define XB_XSUB(j)  (1280 + 64 * (j))
#define XB_XGEN(j)  (2304 + 64 * (j))
#define XB_TOP      3328
#define XB_TOPGEN   3392
#define XCD_BAR_WORDS 3456
#define XB_SPIN_CAP (1u << 18)

__device__ __forceinline__ unsigned xb_ld(unsigned* p)              { return __hip_atomic_load(p, __ATOMIC_RELAXED, __HIP_MEMORY_SCOPE_AGENT); }
__device__ __forceinline__ unsigned xb_add(unsigned* p, unsigned v) { return __hip_atomic_fetch_add(p, v, __ATOMIC_RELAXED, __HIP_MEMORY_SCOPE_AGENT); }
__device__ __forceinline__ unsigned xb_xcc_id() { return (unsigned)__builtin_amdgcn_s_getreg((3 << 11) | 20) & 0xFu; }
#define XB_SPIN(cond, bar) do { unsigned _sp = 0; while (cond) { __builtin_amdgcn_s_sleep(1); \
    if ((++_sp & 255u) == 0u) { if (xb_ld(&(bar)[XB_TMO])) break; if (_sp > XB_SPIN_CAP) { atomicAdd(&(bar)[XB_TMO], 1u); break; } } } } while (0)

struct XcdBarrier { unsigned* bar; unsigned x; volatile LAS unsigned* st; };

__device__ __forceinline__ XcdBarrier xcd_barrier_post(unsigned* bar, volatile LAS unsigned* st) {
    XcdBarrier b; b.bar = bar; b.x = xb_xcc_id(); b.st = st;
    if (threadIdx.x == 0) (void)xb_add(&bar[XB_XCNT(b.x)], 1u);
    return b;
}
__device__ __forceinline__ void xcd_barrier_complete(unsigned* bar, unsigned x, unsigned& nloc, unsigned& nx) {
    const unsigned G = gridDim.x * gridDim.y * gridDim.z;
    unsigned sum, cnt, mine, sp = 0u;
    for (;;) {
        sum = 0u; cnt = 0u; mine = 0u;
#pragma unroll
        for (unsigned j = 0; j < 16; ++j) { const unsigned c = xb_ld(&bar[XB_XCNT(j)]); sum += c; cnt += (c > 0u) ? 1u : 0u; mine = (j == x) ? c : mine; }
        if (sum == G) break;
        __builtin_amdgcn_s_sleep(1);
        if ((++sp & 255u) == 0u) { if (xb_ld(&bar[XB_TMO])) break; if (sp > XB_SPIN_CAP) { atomicAdd(&bar[XB_TMO], 1u); break; } }
    }
    nloc = mine > 0u ? mine : 1u; nx = cnt > 0u ? cnt : 1u;
}
__device__ __forceinline__ void xcd_barrier(const XcdBarrier& b, int tid) {
    asm volatile("s_waitcnt vmcnt(0)" ::: "memory");
    __syncthreads();
    if (tid == 0) {
        unsigned* bar = b.bar;
        __builtin_amdgcn_s_waitcnt(0);
        unsigned nloc = b.st[0], nx = b.st[1];
        if (nloc == 0u) { xcd_barrier_complete(bar, b.x, nloc, nx); b.st[0] = nloc; b.st[1] = nx; }
        const unsigned old = xb_add(&bar[XB_XSUB(b.x)], 1u);
        const unsigned gen = old / nloc;
        if (old + 1u == (gen + 1u) * nloc) {
            __builtin_amdgcn_fence(__ATOMIC_RELEASE, "agent");
            asm volatile("s_waitcnt vmcnt(0)" ::: "memory");
            const unsigned og = xb_add(&bar[XB_TOP], 1u);
            const unsigned tg = og / nx;
            if (og + 1u == (tg + 1u) * nx) xb_add(&bar[XB_TOPGEN], 1u);
            else XB_SPIN(xb_ld(&bar[XB_TOPGEN]) == tg, bar);
            __builtin_amdgcn_fence(__ATOMIC_ACQUIRE, "agent");
            xb_add(&bar[XB_XGEN(b.x)], 1u);
            asm volatile("s_waitcnt vmcnt(0)" ::: "memory");
        } else {
            XB_SPIN(xb_ld(&bar[XB_XGEN(b.x)]) == gen, bar);
            __builtin_amdgcn_fence(__ATOMIC_ACQUIRE, "agent");
            asm volatile("s_waitcnt vmcnt(0)" ::: "memory");
        }
    }
    __syncthreads();
}

__device__ __forceinline__ float shfl_xor_l(float v, int m, int lane) { return __int_as_float(__builtin_amdgcn_ds_bpermute((lane ^ m) << 2, __float_as_int(v))); }
__device__ __forceinline__ float shfl_up_l(float v, int o, int lane) { return __int_as_float(__builtin_amdgcn_ds_bpermute((lane - o) << 2, __float_as_int(v))); }
__device__ __forceinline__ float wave_sum(float v, int lane) {
#pragma unroll
    for (int o = 1; o < 64; o <<= 1) v += shfl_xor_l(v, o, lane);
    return v;
}
__device__ __forceinline__ float wave_max(float v, int lane) {
#pragma unroll
    for (int o = 1; o < 64; o <<= 1) v = fmaxf(v, shfl_xor_l(v, o, lane));
    return v;
}
__device__ __forceinline__ void transpose_item(const float* W, int ldw, int K, int N, bf16* WT, int mode, LAS float* scr, int item, int lane, const float* gain = nullptr) {
    const int nblk = N / 32, kb = item / nblk, nb = item % nblk, k0 = 64 * kb, n0 = 32 * nb;
    const int r0 = (mode == 0) ? n0 : ((n0 >> 7) * 256 + (mode == 2 ? 128 : 0) + (n0 & 127));
#pragma unroll 8
    for (int i = 0; i < 32; ++i) { const int kk = 2 * i + (lane >> 5); scr[kk * 33 + (lane & 31)] = W[(size_t)(k0 + kk) * ldw + n0 + (lane & 31)]; }
    LDS_WAIT(); asm volatile("" ::: "memory");
    const int c = lane & 7;
    f32x4 ga = (f32x4){1.f, 1.f, 1.f, 1.f}, gb = ga; if (gain) { ga = *(const f32x4*)(gain + k0 + 8 * c); gb = *(const f32x4*)(gain + k0 + 8 * c + 4); }
#pragma unroll
    for (int j = 0; j < 4; ++j) { const int n = (lane >> 3) + 8 * j; const LAS float* s = scr + (8 * c) * 33 + n;
        v4u o; o.x = pk2(s[0 * 33] * ga.x, s[1 * 33] * ga.y); o.y = pk2(s[2 * 33] * ga.z, s[3 * 33] * ga.w); o.z = pk2(s[4 * 33] * gb.x, s[5 * 33] * gb.y); o.w = pk2(s[6 * 33] * gb.z, s[7 * 33] * gb.w);
        *(GAS v4u*)(WT + (size_t)(r0 + n) * K + k0 + 8 * c) = o; }
    LDS_WAIT(); asm volatile("" ::: "memory");
}
struct CvtDesc { const float* W; int ldw, K, N; bf16* WT; int mode; const float* gain; int tile; };
__device__ __forceinline__ void cvt_load(const CvtDesc& d, f32x4 (&v)[16], int tid) {
    const int ntn = d.N >> 8, kb = d.tile / ntn, nb = d.tile - kb * ntn, k0 = kb * 128, n0 = nb * 256;
#pragma unroll
    for (int i = 0; i < 16; ++i) { const int idx = tid + 512 * i, k = idx >> 6, c4 = idx & 63; v[i] = __builtin_nontemporal_load((const GAS f32x4*)(d.W + (size_t)(k0 + k) * d.ldw + n0 + 4 * c4)); }
}
__device__ __forceinline__ void cvt_to_lds(const CvtDesc& d, const f32x4 (&v)[16], LAS unsigned char* lds, int tid) {
    const int ntn = d.N >> 8, kb = d.tile / ntn, k0 = kb * 128;
#pragma unroll
    for (int i = 0; i < 16; ++i) { const int idx = tid + 512 * i, k = idx >> 6, c4 = idx & 63; f32x4 x = v[i];
        if (d.gain) x = x * d.gain[k0 + k];
        v2u w; w.x = pk2(x.x, x.y); w.y = pk2(x.z, x.w);
        *(LAS v2u*)(lds + k * 520 + c4 * 8) = w; }
}
__device__ __forceinline__ void cvt_store(const CvtDesc& d, const LAS unsigned char* lds, int tid) {
    const int ntn = d.N >> 8, kb = d.tile / ntn, nb = d.tile - kb * ntn, k0 = kb * 128, n0 = nb * 256;
    const int n = tid & 255, half = tid >> 8, ng = n0 + n;
    const int drow = (d.mode == 0) ? ng : ((ng >> 7) * 256 + (d.mode == 2 ? 128 : 0) + (ng & 127));
    bf16* dst = (d.mode == 3) ? d.WT + ((size_t)(k0 >> 9) * 2048 + ng) * 512 + (k0 & 511)
                              : d.WT + ((size_t)((drow >> 8) * (d.K >> 6) + (k0 >> 6)) * 256 + (drow & 255)) * 64;
    const int kcs = (d.mode == 3) ? 8 : 8, kts = (d.mode == 3) ? 0 : 256 * 64 - 64;
#pragma unroll 2
    for (int j = 0; j < 8; ++j) { const int kc = 2 * j + half; const LAS unsigned short* sp = (const LAS unsigned short*)(lds + (8 * kc) * 520 + n * 2);
        v4u o; o.x = (unsigned)sp[0] | ((unsigned)sp[260] << 16); o.y = (unsigned)sp[2 * 260] | ((unsigned)sp[3 * 260] << 16); o.z = (unsigned)sp[4 * 260] | ((unsigned)sp[5 * 260] << 16); o.w = (unsigned)sp[6 * 260] | ((unsigned)sp[7 * 260] << 16);
        *(GAS v4u*)(dst + kcs * kc + (kc >> 3) * kts) = o; }
}
__device__ __forceinline__ void rms_row(const float* xrow, const float* g, bf16* orow, int lane, f32x4 (&v)[8]) {
    const GAS f32x4* xr = (const GAS f32x4*)xrow + lane;
    float s = 0.f;
#pragma unroll
    for (int j = 0; j < 8; ++j) { v[j] = xr[64 * j]; s += (v[j].x * v[j].x + v[j].y * v[j].y) + (v[j].z * v[j].z + v[j].w * v[j].w); }
    const float r = 1.0f / sqrtf(wave_sum(s, lane) * (1.f / 2048.f) + EPS);
    const GAS f32x4* gr = (const GAS f32x4*)g + lane;
    GAS v2u* o8 = (GAS v2u*)orow + lane;
#pragma unroll
    for (int j = 0; j < 8; ++j) { const f32x4 gv = gr[64 * j]; v[j] = v[j] * r * gv; v2u w; w.x = pk2(v[j].x, v[j].y); w.y = pk2(v[j].z, v[j].w); o8[64 * j] = w; }
}


#ifndef MLSTM_NAIVE
#define MLSTM_NAIVE 0
#endif
typedef short ml_bf16x8 __attribute__((ext_vector_type(8)));
typedef short ml_s16x4 __attribute__((ext_vector_type(4)));
constexpr int ML_QS = 0, ML_KS = 33792, ML_VS = 67584, ML_VW = 76800, ML_WS = 86016, ML_XCH = 95232, ML_NS = 111616, ML_SC = 112640, ML_GA = 114688, ML_GB = 122880, ML_GP = 131072, ML_GM = 139264, ML_PQ = 528, ML_PV = 144;
constexpr int SC_A2 = 0, SC_M2 = 64, SC_IW = 128, SC_NFL = 192, SC_WS = 256, SC_DEN = 320, SC_DECAY = 384;
static_assert(ML_GM + 256 <= LDS_BYTES - 128, "mLSTM LDS map below the barrier words");
__device__ __forceinline__ ml_bf16x8 ml_tr_read2(const LAS unsigned char* p0, const LAS unsigned char* p1) {
    const ml_s16x4 lo = __builtin_amdgcn_ds_read_tr16_b64_v4i16((LAS ml_s16x4*)p0), hi = __builtin_amdgcn_ds_read_tr16_b64_v4i16((LAS ml_s16x4*)p1);
    return __builtin_shufflevector(lo, hi, 0, 1, 2, 3, 4, 5, 6, 7);
}
__device__ __forceinline__ unsigned ml_pk2n(float lo, float hi) { unsigned r; asm volatile("v_cvt_pk_bf16_f32 %0, %1, %2\n\ts_nop 1" : "=v"(r) : "v"(lo), "v"(hi)); return r; }
#define ML_EXP(x) __builtin_amdgcn_exp2f((x) * 1.4426950408889634f)
#define ML_MFMA(a, b, c) __builtin_amdgcn_mfma_f32_16x16x32_bf16((a), (b), (c), 0, 0, 0)
__device__ __forceinline__ void mlstm_item(LAS unsigned char* lds, const bf16* QCp, const bf16* KCp, const bf16* Zp, const float* GATp, bf16* HMp, int item, int tid) {
    const int lane = tid & 63, w = __builtin_amdgcn_readfirstlane(tid >> 6), g = lane >> 4, i = lane & 15, dvb = w & 3, dkh = w >> 2;
    const int b = item >> 4, h = (item >> 2) & 3, jv = item & 3;
    LAS float* sc = (LAS float*)(lds + ML_SC); LAS float* nS = (LAS float*)(lds + ML_NS);
    LAS float* gA = (LAS float*)(lds + ML_GA); LAS float* gB = (LAS float*)(lds + ML_GB); LAS float* gP = (LAS float*)(lds + ML_GP); LAS float* gM = (LAS float*)(lds + ML_GM);
    f32x4 Cacc[8];
#pragma unroll
    for (int x = 0; x < 8; ++x) Cacc[x] = (f32x4){0.f, 0.f, 0.f, 0.f};
    if (tid < 256) nS[tid] = 0.f;
    const size_t tokb = (size_t)b * SEQ;
#pragma unroll 1
    for (int cc = w; cc < SEQ / 64; cc += 8) {
        const size_t t = tokb + (size_t)cc * 64 + lane; const float li = GATp[t * 8 + h], lf = GATp[t * 8 + 4 + h];
        float bc = lf;
#pragma unroll
        for (int o = 1; o < 64; o <<= 1) { const float y = shfl_up_l(bc, o, lane); if (lane >= o) bc += y; }
        const float a = li - bc; float pm = a;
#pragma unroll
        for (int o = 1; o < 64; o <<= 1) { const float y = shfl_up_l(pm, o, lane); if (lane >= o) pm = fmaxf(pm, y); }
        gA[cc * 64 + lane] = a; gB[cc * 64 + lane] = bc; gP[cc * 64 + lane] = pm;
    }
    __syncthreads();
    if (tid == 0) { float m = 0.f; gM[0] = 0.f;
        for (int cc = 0; cc < SEQ / 64; ++cc) { m = gB[cc * 64 + 63] + fmaxf(m, gP[cc * 64 + 63]); gM[cc + 1] = m; } }
    v4u qreg[4], kreg[4], vreg;
    const unsigned qoff = (unsigned)((tid >> 5) * 2048 + (tid & 31) * 16), voff = (unsigned)((tid >> 3) * (ZP * 2) + (tid & 7) * 16);
#define ML_FETCH(c) do { const size_t t0_ = tokb + (size_t)(c) * 64; unsigned qo_ = qoff, vo_ = voff; asm volatile("" : "+v"(qo_), "+v"(vo_)); \
        const char* qb_ = (const char*)(QCp + t0_ * 1024 + h * 256); const char* kb_ = (const char*)(KCp + t0_ * 1024 + h * 256); \
        _Pragma("unroll") for (int i4 = 0; i4 < 4; ++i4) { qreg[i4] = *(const GAS v4u*)(qb_ + (size_t)i4 * 32768 + qo_); kreg[i4] = *(const GAS v4u*)(kb_ + (size_t)i4 * 32768 + qo_); } \
        vreg = *(const GAS v4u*)((const char*)(Zp + t0_ * ZP + 3072 + h * 256 + jv * 64) + vo_); } while (0)
    ML_FETCH(0);
    __syncthreads();
    for (int c = 0; c < SEQ / 64; ++c) {
        const size_t t0 = tokb + (size_t)c * 64;
        unsigned trb_ = (unsigned)((8 * g + (i >> 2)) * ML_PV + (16 * dvb + 4 * (i & 3)) * 2), trk_ = (unsigned)(ML_KS + (8 * g + (i >> 2)) * ML_PQ + (128 * dkh + 4 * (i & 3)) * 2);
        asm volatile("" : "+v"(trb_), "+v"(trk_));
        const LAS unsigned char* trb = lds + trb_; const LAS unsigned char* trk = lds + trk_;
#pragma unroll
        for (int i4 = 0; i4 < 4; ++i4) { const int p = tid + 512 * i4; *(LAS v4u*)(lds + ML_QS + (p >> 5) * ML_PQ + (p & 31) * 16) = qreg[i4]; *(LAS v4u*)(lds + ML_KS + (p >> 5) * ML_PQ + (p & 31) * 16) = kreg[i4]; }
        if (w == 0) {
            const float mc = gM[c], a = gA[c * 64 + lane], bc = gB[c * 64 + lane], Mt = fmaxf(mc, gP[c * 64 + lane]), M63 = fmaxf(mc, gP[c * 64 + 63]);
            sc[SC_A2 + lane] = a * 1.4426950408889634f; sc[SC_M2 + lane] = Mt * 1.4426950408889634f; sc[SC_IW + lane] = ML_EXP(mc - Mt); sc[SC_NFL + lane] = ML_EXP(-(bc + Mt)); sc[SC_WS + lane] = ML_EXP(a - M63);
            if (lane == 0) sc[SC_DECAY] = ML_EXP(mc - M63);
        }
        __syncthreads();
        { const int row = tid >> 3, c8 = tid & 7; const float wsr = sc[SC_WS + row];
          *(LAS v4u*)(lds + ML_VS + row * ML_PV + c8 * 16) = vreg;
          v4u o; o.x = pk2(bflo(vreg.x) * wsr, bfhi(vreg.x) * wsr); o.y = pk2(bflo(vreg.y) * wsr, bfhi(vreg.y) * wsr); o.z = pk2(bflo(vreg.z) * wsr, bfhi(vreg.z) * wsr); o.w = pk2(bflo(vreg.w) * wsr, bfhi(vreg.w) * wsr);
          *(LAS v4u*)(lds + ML_VW + row * ML_PV + c8 * 16) = o; }
        {
            const int tb1 = w >> 1, sb0 = 2 * (w & 1);
            f32x4 S0 = (f32x4){0.f, 0.f, 0.f, 0.f}, S1 = S0;
#pragma unroll
            for (int kk = 0; kk < 8; ++kk) {
                const ml_bf16x8 af = *(const LAS ml_bf16x8*)(lds + ML_QS + (16 * tb1 + i) * ML_PQ + (32 * kk + 8 * g) * 2);
                const ml_bf16x8 b0 = *(const LAS ml_bf16x8*)(lds + ML_KS + (16 * sb0 + i) * ML_PQ + (32 * kk + 8 * g) * 2);
                const ml_bf16x8 b1 = *(const LAS ml_bf16x8*)(lds + ML_KS + (16 * (sb0 + 1) + i) * ML_PQ + (32 * kk + 8 * g) * 2);
                S0 = ML_MFMA(af, b0, S0); S1 = ML_MFMA(af, b1, S1);
            }
            const f32x4 M2v = *(const LAS f32x4*)(sc + SC_M2 + 16 * tb1 + 4 * g);
            const float a20 = sc[SC_A2 + 16 * sb0 + i], a21 = sc[SC_A2 + 16 * (sb0 + 1) + i];
#pragma unroll
            for (int r = 0; r < 4; ++r) { const int t = 16 * tb1 + 4 * g + r, s0 = 16 * sb0 + i, s1 = s0 + 16;
                const float w0 = (s0 <= t) ? __builtin_amdgcn_exp2f(fminf(a20 - M2v[r], 0.f)) * S0[r] : 0.f;
                const float w1 = (s1 <= t) ? __builtin_amdgcn_exp2f(fminf(a21 - M2v[r], 0.f)) * S1[r] : 0.f;
                *(LAS unsigned short*)(lds + ML_WS + t * ML_PV + s0 * 2) = (unsigned short)(pk2(w0, 0.f) & 0xffffu);
                *(LAS unsigned short*)(lds + ML_WS + t * ML_PV + s1 * 2) = (unsigned short)(pk2(w1, 0.f) & 0xffffu); }
        }
        f32x4 P0 = (f32x4){0.f, 0.f, 0.f, 0.f}, P1 = P0, P2 = P0, P3 = P0;
#pragma unroll
        for (int kk = 0; kk < 4; ++kk) {
            u32x4v bw; bw.x = ml_pk2n(Cacc[2 * kk][0], Cacc[2 * kk][1]); bw.y = ml_pk2n(Cacc[2 * kk][2], Cacc[2 * kk][3]); bw.z = ml_pk2n(Cacc[2 * kk + 1][0], Cacc[2 * kk + 1][1]); bw.w = ml_pk2n(Cacc[2 * kk + 1][2], Cacc[2 * kk + 1][3]);
            const ml_bf16x8 bfr = __builtin_bit_cast(ml_bf16x8, bw);
            const int dkb = 128 * dkh + 32 * kk;
#define ML_QFRAG(tb) ({ const v2u lo_ = *(const LAS v2u*)(lds + ML_QS + (16 * (tb) + i) * ML_PQ + (dkb + 4 * g) * 2), hi_ = *(const LAS v2u*)(lds + ML_QS + (16 * (tb) + i) * ML_PQ + (dkb + 16 + 4 * g) * 2); \
            u32x4v q_; q_.x = lo_.x; q_.y = lo_.y; q_.z = hi_.x; q_.w = hi_.y; __builtin_bit_cast(ml_bf16x8, q_); })
            P0 = ML_MFMA(ML_QFRAG(0), bfr, P0); P1 = ML_MFMA(ML_QFRAG(1), bfr, P1); P2 = ML_MFMA(ML_QFRAG(2), bfr, P2); P3 = ML_MFMA(ML_QFRAG(3), bfr, P3);
#undef ML_QFRAG
        }
        __syncthreads();
        if (c + 1 < SEQ / 64) ML_FETCH(c + 1);
        f32x4 H0 = (f32x4){0.f, 0.f, 0.f, 0.f}, H1 = H0;
#pragma unroll
        for (int kk = 0; kk < 2; ++kk) {
            const LAS unsigned char* va = trb + ML_VS + 32 * kk * ML_PV;
            const ml_bf16x8 bfr = ml_tr_read2(va, va + 4 * ML_PV);
            const ml_bf16x8 a0 = *(const LAS ml_bf16x8*)(lds + ML_WS + (16 * (2 * dkh) + i) * ML_PV + (32 * kk + 8 * g) * 2);
            const ml_bf16x8 a1 = *(const LAS ml_bf16x8*)(lds + ML_WS + (16 * (2 * dkh + 1) + i) * ML_PV + (32 * kk + 8 * g) * 2);
            H0 = ML_MFMA(a0, bfr, H0); H1 = ML_MFMA(a1, bfr, H1);
        }
        { const int t = tid >> 3, p = tid & 7; float qn = 0.f;
#pragma unroll
          for (int e = 0; e < 4; ++e) { const v4u qq = *(const LAS v4u*)(lds + ML_QS + t * ML_PQ + (32 * p + 8 * e) * 2); const f32x4 n0 = *(const LAS f32x4*)(nS + 32 * p + 8 * e), n1 = *(const LAS f32x4*)(nS + 32 * p + 8 * e + 4);
              qn += (bflo(qq.x) * n0.x + bfhi(qq.x) * n0.y) + (bflo(qq.y) * n0.z + bfhi(qq.y) * n0.w) + (bflo(qq.z) * n1.x + bfhi(qq.z) * n1.y) + (bflo(qq.w) * n1.z + bfhi(qq.w) * n1.w); }
          const v4u ww = *(const LAS v4u*)(lds + ML_WS + t * ML_PV + 8 * p * 2);
          float d = sc[SC_IW + t] * qn + ((bflo(ww.x) + bfhi(ww.x)) + (bflo(ww.y) + bfhi(ww.y)) + (bflo(ww.z) + bfhi(ww.z)) + (bflo(ww.w) + bfhi(ww.w)));
          d += shfl_xor_l(d, 1, lane); d += shfl_xor_l(d, 2, lane); d += shfl_xor_l(d, 4, lane);
          if (p == 0) sc[SC_DEN + t] = d; }
        { const f32x4 x0 = dkh ? P0 : P2, x1 = dkh ? P1 : P3;
          *(LAS f32x4*)(lds + ML_XCH + ((w * 2 + 0) * 64 + lane) * 16) = x0; *(LAS f32x4*)(lds + ML_XCH + ((w * 2 + 1) * 64 + lane) * 16) = x1; }
        __syncthreads();
        { const f32x4 o0 = dkh ? P2 : P0, o1 = dkh ? P3 : P1;
          const f32x4 p0 = *(const LAS f32x4*)(lds + ML_XCH + (((w ^ 4) * 2 + 0) * 64 + lane) * 16), p1 = *(const LAS f32x4*)(lds + ML_XCH + (((w ^ 4) * 2 + 1) * 64 + lane) * 16);
#pragma unroll
          for (int x = 0; x < 2; ++x) { const int tb = 2 * dkh + x; const f32x4 own = x ? o1 : o0, oth = x ? p1 : p0, hin = x ? H1 : H0;
              const f32x4 iwv = *(const LAS f32x4*)(sc + SC_IW + 16 * tb + 4 * g), dnv = *(const LAS f32x4*)(sc + SC_DEN + 16 * tb + 4 * g), nfv = *(const LAS f32x4*)(sc + SC_NFL + 16 * tb + 4 * g);
#pragma unroll
              for (int r = 0; r < 4; ++r) { const float num = iwv[r] * (own[r] + oth[r]) + hin[r]; const float hv = num / fmaxf(fabsf(dnv[r]), nfv[r]);
                  HMp[(t0 + 16 * tb + 4 * g + r) * 1024 + h * 256 + jv * 64 + 16 * dvb + i] = (bf16)(pk2(hv, 0.f) & 0xffffu); } } }
        const float decay = sc[SC_DECAY];
#pragma unroll
        for (int x = 0; x < 8; ++x) Cacc[x] = Cacc[x] * decay;
        f32x4 nacc0 = (f32x4){0.f, 0.f, 0.f, 0.f}, nacc1 = nacc0;
#pragma unroll
        for (int kk = 0; kk < 2; ++kk) {
            const LAS unsigned char* va = trb + ML_VW + 32 * kk * ML_PV;
            const ml_bf16x8 bfr = ml_tr_read2(va, va + 4 * ML_PV);
            const f32x4 wa = *(const LAS f32x4*)(sc + SC_WS + 32 * kk + 8 * g), wb = *(const LAS f32x4*)(sc + SC_WS + 32 * kk + 8 * g + 4);
            u32x4v ww; ww.x = ml_pk2n(wa[0], wa[1]); ww.y = ml_pk2n(wa[2], wa[3]); ww.z = ml_pk2n(wb[0], wb[1]); ww.w = ml_pk2n(wb[2], wb[3]);
            const ml_bf16x8 wfr = __builtin_bit_cast(ml_bf16x8, ww);
#pragma unroll
            for (int x = 0; x < 8; ++x) { const LAS unsigned char* ka = trk + 32 * kk * ML_PQ + 32 * x; const ml_bf16x8 afr = ml_tr_read2(ka, ka + 4 * ML_PQ);
                Cacc[x] = ML_MFMA(afr, bfr, Cacc[x]);
                if ((x >> 1) == dvb) { if (x & 1) nacc1 = ML_MFMA(afr, wfr, nacc1); else nacc0 = ML_MFMA(afr, wfr, nacc0); } }
        }
        if (i == 0) { LAS f32x4* np0 = (LAS f32x4*)(nS + 128 * dkh + 16 * (2 * dvb) + 4 * g); LAS f32x4* np1 = (LAS f32x4*)(nS + 128 * dkh + 16 * (2 * dvb + 1) + 4 * g);
            *np0 = *np0 * decay + nacc0; *np1 = *np1 * decay + nacc1; }
        __syncthreads();
    }
#undef ML_FETCH
}

struct Args { const float* in[24]; float* out; unsigned char* ws; int l_lo, l_hi, ph_lo, ph_hi, use_bar, do_init, do_final, pad; };
static_assert(sizeof(Args) == 26 * 8 + 8 * 4, "Args has no padding");

__global__ void __launch_bounds__(NWAVES * 64, 2) fwd(Args args) {
    extern __shared__ __attribute__((aligned(16))) unsigned char lds_raw[];
    LAS unsigned char* lds = (LAS unsigned char*)lds_raw;
    volatile LAS unsigned* MISC = (volatile LAS unsigned*)(lds + MISC_OFF);
    const int G = gridDim.x, bx = blockIdx.x, NGW = G * NWAVES;
    const int wave0 = __builtin_amdgcn_readfirstlane((int)threadIdx.x >> 6);
    { const int t0 = threadIdx.x;
      for (int u = t0; u < (LDS_BYTES - LDSCTL_OFF) / 4; u += NWAVES * 64) ((LAS unsigned*)(lds + LDSCTL_OFF))[u] = 0u; }
    __syncthreads();
    XcdBarrier bar; bar.bar = (unsigned*)(args.ws + WS_CTL) + CW_BAR; bar.x = 0; bar.st = nullptr;
    if (args.use_bar) bar = xcd_barrier_post((unsigned*)(args.ws + WS_CTL) + CW_BAR, MISC + 8);
#define GRID_BAR() do { if (args.use_bar) { int bt_; asm volatile("v_mbcnt_lo_u32_b32 %0, -1, 0\n\tv_mbcnt_hi_u32_b32 %0, -1, %0" : "=v"(bt_)); xcd_barrier(bar, bt_ + wave0 * 64); } } while (0)
#define PH_BEGIN() int tid_; asm volatile("v_mbcnt_lo_u32_b32 %0, -1, 0\n\tv_mbcnt_hi_u32_b32 %0, -1, %0" : "=v"(tid_)); tid_ += wave0 * 64; const int tid = tid_, lane = tid & 63, wave = __builtin_amdgcn_readfirstlane(tid >> 6), gw = bx * NWAVES + wave; \
    unsigned char* ws = args.ws; asm volatile("" : "+s"(ws)); unsigned char* BIG = ws + WS_BIG; (void)tid; (void)lane; (void)gw; (void)BIG; \
    bf16* U = (bf16*)(ws + WS_U); (void)U
#define INP(k) ({ int k_ = (k); asm volatile("" : "+s"(k_)); const float* p_ = args.in[k_]; p_; })
#define HID ((bf16*)BIG)
#define Z ((bf16*)BIG)
#define PB ((bf16*)BIG)
#define GT ((bf16*)(ws + WS_GT))
#define VWT ((bf16*)(ws + WS_VWT))
#define QC ((bf16*)(ws + WS_X1))
#define KC (QC + (size_t)M * 1024)
#define DP ((bf16*)(ws + WS_X2))
#define HM ((bf16*)(ws + WS_HM))
#define GAT ((float*)(ws + WS_GAT))
#define KB ((bf16*)(ws + WS_KB))
#define VB ((bf16*)(ws + WS_VT))
#define MEMN ((bf16*)(ws + WS_MEMN))
#define WGU1 ((bf16*)(ws + WS_WGU1))
#define WD1 ((bf16*)(ws + WS_WD1))
#define WGU2 ((bf16*)(ws + WS_WGU2))
#define WD2 ((bf16*)(ws + WS_WD2))
#define WIN ((bf16*)(ws + WS_WIN))
#define WPOOL ((bf16*)(ws + WS_WPOOL))
#define WOUT ((bf16*)(ws + WS_WOUT))
#define WQH ((bf16*)(ws + WS_WQ))
#define WKV ((bf16*)(ws + WS_WKV))
#define WOH ((bf16*)(ws + WS_WO))

    const int lo = args.ph_lo, hi = args.ph_hi;
#ifndef PHMASK
#define PHMASK 0xfff
#endif
#ifndef DUPMASK
#define DUPMASK 0
#endif
#define NREP(k) (1 + ((DUPMASK >> (k)) & 1))
#define IN(k) (((PHMASK >> (k)) & 1) && lo <= (k) && (k) < hi)
#define RSS(k) ((pg8::rss_t*)(ws + WS_RSS) + (size_t)(k) * M)
#define H16 ((bf16*)(ws + WS_H))
#define DUMMY16 ((bf16*)(ws + WS_X1))

    if (args.do_init) {
        PH_BEGIN();
        const float* x = INP(0);
        for (int m = gw; m < M; m += NGW) {
            const GAS f32x4* xr = (const GAS f32x4*)(x + (size_t)m * D) + lane; float ss = 0.f;
#pragma unroll
            for (int j = 0; j < 8; ++j) { const f32x4 v = __builtin_nontemporal_load(xr + 64 * j); v2u w; w.x = pk2(v.x, v.y); w.y = pk2(v.z, v.w); *(GAS v2u*)(H16 + h16_off(m, 256 * j + 4 * lane)) = w;
                const float a0 = bflo(w.x), a1 = bfhi(w.x), a2 = bflo(w.y), a3 = bfhi(w.y); ss += (a0 * a0 + a1 * a1) + (a2 * a2 + a3 * a3); }
            ss = wave_sum(ss, lane);
            if (lane == 0) RSS(0)[m] = (pg8::rss_t)(ss * 1048576.0f + 0.5f);
        }
        GRID_BAR();
    }
    for (int l = args.l_lo; l < args.l_hi; ++l) {
        if (IN(0)) for (int rep = 0; rep < NREP(0); ++rep) {
            PH_BEGIN();
            const float* wg1 = INP(3) + (size_t)l * D * FF; const float* wu1 = INP(4) + (size_t)l * D * FF; const float* wd1 = INP(5) + (size_t)l * FF * D;
            const float* wg2 = INP(20) + (size_t)l * D * FF; const float* wu2 = INP(21) + (size_t)l * D * FF; const float* wd2 = INP(22) + (size_t)l * FF * D;
            const float* win = INP(7) + (size_t)l * D * DIN; const float* wpool = INP(11) + (size_t)l * 4 * 65536; const float* wout = INP(13) + (size_t)l * D * D;
            const float* wq = INP(16) + (size_t)l * D * D; const float* wkv = INP(17) + (size_t)l * D * 2 * D; const float* wo = INP(18) + (size_t)l * D * D;
            const float* g1 = INP(2) + (size_t)l * D; const float* gm = INP(6) + (size_t)l * D; const float* gx = INP(14) + (size_t)l * D; const float* g2 = INP(19) + (size_t)l * D;
            constexpr int T_GU = (D / 128) * (FF / 256), T_DN = (FF / 128) * (D / 256), T_IN = (D / 128) * (DINM / 256), T_PL = 2, T_SQ = (D / 128) * (D / 256), T_KV = (D / 128) * (2 * D / 256);
            constexpr int NTILES = 4 * T_GU + 2 * T_DN + T_IN + 4 * T_PL + 2 * T_SQ + T_KV;
#define CVT_DESC(dst, it_) do { int r = (it_); \
                if (r < T_GU) { dst = CvtDesc{wg1, FF, D, FF, WGU1, 1, g1, r}; break; } r -= T_GU; \
                if (r < T_GU) { dst = CvtDesc{wu1, FF, D, FF, WGU1, 2, g1, r}; break; } r -= T_GU; \
                if (r < T_DN) { dst = CvtDesc{wd1, D, FF, D, WD1, 0, nullptr, r}; break; } r -= T_DN; \
                if (r < T_GU) { dst = CvtDesc{wg2, FF, D, FF, WGU2, 1, g2, r}; break; } r -= T_GU; \
                if (r < T_GU) { dst = CvtDesc{wu2, FF, D, FF, WGU2, 2, g2, r}; break; } r -= T_GU; \
                if (r < T_DN) { dst = CvtDesc{wd2, D, FF, D, WD2, 0, nullptr, r}; break; } r -= T_DN; \
                if (r < T_IN) { dst = CvtDesc{win, DIN, D, DINM, WIN, 0, gm, r}; break; } r -= T_IN; \
                if (r < 4 * T_PL) { const int g_ = r / T_PL; dst = CvtDesc{wpool + (size_t)g_ * 65536, 256, 256, 256, WPOOL + (size_t)g_ * 65536, 0, nullptr, r % T_PL}; break; } r -= 4 * T_PL; \
                if (r < T_SQ) { dst = CvtDesc{wout, D, D, D, WOUT, 0, nullptr, r}; break; } r -= T_SQ; \
                if (r < T_KV) { dst = CvtDesc{wkv, 2 * D, D, 2 * D, WKV, 0, nullptr, r}; break; } r -= T_KV; \
                dst = CvtDesc{wo, D, D, D, WOH, 3, nullptr, r}; } while (0)
            int it0 = bx; asm volatile("" : "+s"(it0));
            if (it0 < NTILES) {
                f32x4 cv[16]; CvtDesc cd; CVT_DESC(cd, it0); cvt_load(cd, cv, tid);
                int buf = 0;
#pragma unroll 1
                for (int it = it0; it < NTILES; it += G) {
                    LAS unsigned char* img = lds + RING_OFF + buf * 66560;
                    cvt_to_lds(cd, cv, img, tid);
                    __syncthreads();
                    CvtDesc cn = cd; const bool more = it + G < NTILES;
                    if (more) { CVT_DESC(cn, it + G); cvt_load(cn, cv, tid); }
                    cvt_store(cd, img, tid);
                    cd = cn; buf ^= 1;
                }
                __syncthreads();
            }
#undef CVT_DESC
            for (int e = bx * (NWAVES * 64) + tid; e < D * D / 8; e += G * NWAVES * 64) { const int k = e >> 8, n8 = (e & 255) * 8; const float sc = gx[k] * 0.044194173824159216f;
                const f32x4 a = __builtin_nontemporal_load((const GAS f32x4*)(wq + (size_t)k * D + n8)), b = __builtin_nontemporal_load((const GAS f32x4*)(wq + (size_t)k * D + n8 + 4));
                v4u o; o.x = pk2(a.x * sc, a.y * sc); o.y = pk2(a.z * sc, a.w * sc); o.z = pk2(b.x * sc, b.y * sc); o.w = pk2(b.z * sc, b.w * sc);
                *(GAS v4u*)(WQH + ((size_t)(n8 >> 9) * D + k) * 512 + (n8 & 511)) = o; }
            for (int e = bx * (NWAVES * 64) + tid; e < 256 * D; e += G * NWAVES * 64) { const int rr = e >> 11, k = e & (D - 1);
                const float v = (rr < 8) ? win[(size_t)k * DIN + DINM + rr] * gm[k] : 0.f; WIN[((size_t)(20 * 32 + (k >> 6)) * 256 + rr) * 64 + (k & 63)] = (bf16)(pk2(v, 0.f) & 0xffffu); }
            f32x4 v[8];
            for (int m = gw; m < MMEM; m += NGW) rms_row(INP(1) + (size_t)m * D, INP(15) + (size_t)l * D, MEMN + (size_t)m * D, lane, v);
            GRID_BAR();
        }
        if (IN(1)) for (int rep = 0; rep < NREP(1); ++rep) {
            PH_BEGIN();
            pg8::Gemm g{H16, WGU1, D, 0, 44, 1, 1}; pg8::StaticOrder S; S.init(128, 44, G, bx);
            pg8::EpiSwiGLU E{HID, 64, RSS(4 * l), (LAS float*)(lds + LDSCTL_OFF + 12288)};
            pg8::gemm_phase<pg8::EpiSwiGLU, pg8::StaticOrder, PG8_ALIGN, PG8_SP2, true>(lds + RING_OFF, g, S, E, tid);
            { pg8::Gemm g2{MEMN, WKV, D, 0, 16, 0, 1}; pg8::StaticOrder S2; S2.init(16, 16, G, bx);
              pg8::EpiBf16K<1> E2{KB, nullptr, 1.0f, MMEM, nullptr, nullptr, nullptr, nullptr};
              pg8::gemm_phase<pg8::EpiBf16K<1>, pg8::StaticOrder, PG8_ALIGN, PG8_SP2>(lds + RING_OFF, g2, S2, E2, tid); }
            GRID_BAR();
        }
        if (IN(2)) for (int rep = 0; rep < NREP(2); ++rep) {
            PH_BEGIN();
            const bool dummy = rep + 1 < NREP(2);
            pg8::Gemm g{HID, WD1, FF, 0, 8, 1, 1}; pg8::StaticOrder S; S.init(128, 8, G, bx);
            pg8::EpiResid16 E{H16, dummy ? DUMMY16 : H16, 0.5f, dummy ? RSS(17) : RSS(4 * l + 1)};
            pg8::gemm_phase<pg8::EpiResid16, pg8::StaticOrder, false, PG8_SP2, true>(lds + RING_OFF, g, S, E, tid);
            GRID_BAR();
        }
        if (IN(3)) for (int rep = 0; rep < NREP(3); ++rep) {
            PH_BEGIN();
            pg8::Gemm g{H16, WIN, D, 0, 21, 1, 1}; pg8::StaticOrder S; S.init(128, 21, G, bx);
            pg8::EpiBf16K<0> E{Z, nullptr, 1.0f, 0, RSS(4 * l + 1), GAT, INP(8) + l * 8, (LAS float*)(lds + LDSCTL_OFF + 12288)};
            pg8::gemm_phase<pg8::EpiBf16K<0>, pg8::StaticOrder, PG8_ALIGN, PG8_SP2>(lds + RING_OFF, g, S, E, tid);
            const bool lateWG = (G == 256) && bx >= 128;
#pragma unroll 1
            for (int part = 0; part < 2; ++part) {
                pg8::Gemm g2{KB, WQH, 512, 16, 8}; pg8::StaticOrder S2; S2.init(64, 8, G, bx);
                if (G == 256) { if (part == 0) S2.slice(0, 256, 256, bx); else S2.slice(256, 256, 128, lateWG ? bx - 128 : 256); } else if (part == 1) S2.slice(0, 0, G, 1);
                pg8::EpiBf16K<5> E2{GT, nullptr, 1.0f, 0, nullptr, nullptr, nullptr, nullptr};
                pg8::gemm_phase<pg8::EpiBf16K<5>, pg8::StaticOrder, PG8_ALIGN, PG8_SP2>(lds + RING_OFF, g2, S2, E2, tid);
                pg8::Gemm g3{WOH, VB, 512, 8, 16}; pg8::StaticOrder S3; S3.init(32, 16, G, bx);
                if (G == 256) { if (part == 0) S3.slice(0, 256, 256, bx); else S3.slice(256, 256, 128, lateWG ? bx - 128 : 256); } else if (part == 1) S3.slice(0, 0, G, 1);
                pg8::EpiBf16K<6> E3{VWT, nullptr, 1.0f, 0, nullptr, nullptr, nullptr, nullptr};
                pg8::gemm_phase<pg8::EpiBf16K<6>, pg8::StaticOrder, PG8_ALIGN, PG8_SP2>(lds + RING_OFF, g3, S3, E3, tid);
            }
            GRID_BAR();
        }
        if (IN(4)) for (int rep = 0; rep < NREP(4); ++rep) {
            PH_BEGIN();
            const float* cw = INP(9) + (size_t)l * 4 * 2048;
#define UNPK8(dst, zz) do { dst[0] = bflo(zz.x); dst[1] = bfhi(zz.x); dst[2] = bflo(zz.y); dst[3] = bfhi(zz.y); dst[4] = bflo(zz.z); dst[5] = bfhi(zz.z); dst[6] = bflo(zz.w); dst[7] = bfhi(zz.w); } while (0)
            for (int blk = bx; blk < 256; blk += G) {
                const int tokb = blk * 128;
                {
                    const int o = tid & 255, c0 = o * 8, t1 = tokb + 64 * (tid >> 8), s1 = t1 & (SEQ - 1);
                    f32x4 W0[2], W1[2], W2[2], W3[2], XA[2], XB[2], XC[2];
#pragma unroll
                    for (int h2 = 0; h2 < 2; ++h2) { W0[h2] = *(const f32x4*)(cw + c0 + 4 * h2); W1[h2] = *(const f32x4*)(cw + 2048 + c0 + 4 * h2); W2[h2] = *(const f32x4*)(cw + 4096 + c0 + 4 * h2); W3[h2] = *(const f32x4*)(cw + 6144 + c0 + 4 * h2); }
#define UNPKV(dst, zz) do { dst[0][0] = bflo(zz.x); dst[0][1] = bfhi(zz.x); dst[0][2] = bflo(zz.y); dst[0][3] = bfhi(zz.y); dst[1][0] = bflo(zz.z); dst[1][1] = bfhi(zz.z); dst[1][2] = bflo(zz.w); dst[1][3] = bfhi(zz.w); } while (0)
                    const bf16* zcol = Z + 1024 + c0;
                    { v4u z3 = (v4u){0u, 0u, 0u, 0u}, z2 = z3, z1 = z3;
                      if (s1 >= 3) z3 = *(const GAS v4u*)(zcol + (size_t)(t1 - 3) * ZP);
                      if (s1 >= 2) z2 = *(const GAS v4u*)(zcol + (size_t)(t1 - 2) * ZP);
                      if (s1 >= 1) z1 = *(const GAS v4u*)(zcol + (size_t)(t1 - 1) * ZP);
                      UNPKV(XA, z3); UNPKV(XB, z2); UNPKV(XC, z1); }
                    const float qs = (c0 < 1024) ? 0.0625f : 1.0f;
                    bf16* dcol = (c0 < 1024) ? (QC + c0) : (KC + (c0 - 1024));
                    v4u zr[8];
#pragma unroll
                    for (int u = 0; u < 8; ++u) zr[u] = *(const GAS v4u*)(zcol + (size_t)(t1 + u) * ZP);
                    for (int tt = 0; tt < 64; tt += 8) {
                        v4u zq[8];
#pragma unroll
                        for (int u = 0; u < 8; ++u) zq[u] = (tt + 8 < 64) ? *(const GAS v4u*)(zcol + (size_t)(t1 + tt + 8 + u) * ZP) : (v4u){0u, 0u, 0u, 0u};
#pragma unroll
                        for (int u = 0; u < 8; ++u) { f32x4 XD[2], Y[2]; UNPKV(XD, zr[u]);
#pragma unroll
                            for (int h2 = 0; h2 < 2; ++h2) { const f32x4 a = W0[h2] * XA[h2] + W1[h2] * XB[h2] + W2[h2] * XC[h2] + W3[h2] * XD[h2];
                                f32x4 e = a * -1.4426950408889634f;
#pragma unroll
                                for (int j = 0; j < 4; ++j) e[j] = __builtin_amdgcn_exp2f(e[j]);
                                e = e + 1.0f;
#pragma unroll
                                for (int j = 0; j < 4; ++j) e[j] = __builtin_amdgcn_rcpf(e[j]);
                                Y[h2] = (a * qs) * e; XA[h2] = XB[h2]; XB[h2] = XC[h2]; XC[h2] = XD[h2]; }
                            v4u wv; wv.x = pk2(Y[0][0], Y[0][1]); wv.y = pk2(Y[0][2], Y[0][3]); wv.z = pk2(Y[1][0], Y[1][1]); wv.w = pk2(Y[1][2], Y[1][3]);
                            *(GAS v4u*)(dcol + (size_t)(t1 + tt + u) * 1024) = wv; }
#pragma unroll
                        for (int u = 0; u < 8; ++u) zr[u] = zq[u];
                    }
                }
                {
                    const int o = tid & 127, c0 = o * 8, g = o >> 5, wdw = 2 << g, t1 = tokb + 32 * (tid >> 7), s1 = t1 & (SEQ - 1);
                    const bf16* zcol = Z + c0;
                    f32x4 S[2]; S[0] = (f32x4){0.f, 0.f, 0.f, 0.f}; S[1] = S[0];
                    for (int j = 1; j <= wdw; ++j) if (s1 - j >= 0) { const v4u zz = *(const GAS v4u*)(zcol + (size_t)(t1 - j) * ZP); f32x4 x[2]; UNPKV(x, zz); S[0] += x[0]; S[1] += x[1]; }
                    bf16* dcol = DP + (size_t)g * M * 256 + (c0 & 255);
                    for (int tt = 0; tt < 32; tt += 8) {
                        v4u zn[8], zo[8];
#pragma unroll
                        for (int u = 0; u < 8; ++u) { const int t = t1 + tt + u, sq = s1 + tt + u; zn[u] = *(const GAS v4u*)(zcol + (size_t)t * ZP);
                            zo[u] = (v4u){0u, 0u, 0u, 0u}; if (sq >= wdw) zo[u] = *(const GAS v4u*)(zcol + (size_t)(t - wdw) * ZP); }
#pragma unroll
                        for (int u = 0; u < 8; ++u) { const int sq = s1 + tt + u; f32x4 xn[2], xo[2], d[2]; UNPKV(xn, zn[u]); UNPKV(xo, zo[u]);
                            const float inv = __builtin_amdgcn_rcpf((float)((sq + 1 < wdw) ? (sq + 1) : wdw));
#pragma unroll
                            for (int h2 = 0; h2 < 2; ++h2) { S[h2] += xn[h2] - xo[h2]; d[h2] = S[h2] * inv - xn[h2]; }
                            v4u wv; wv.x = pk2(d[0][0], d[0][1]); wv.y = pk2(d[0][2], d[0][3]); wv.z = pk2(d[1][0], d[1][1]); wv.w = pk2(d[1][2], d[1][3]);
                            *(GAS v4u*)(dcol + (size_t)(t1 + tt + u) * 256) = wv; }
                    }
                }
            }
#undef UNPK8
#undef UNPKV
            GRID_BAR();
        }
        if (IN(5)) for (int rep = 0; rep < NREP(5); ++rep) {
            PH_BEGIN();
            {
                pg8::Gemm g{DP, WPOOL, 256, 128, 1, 0, 1}; pg8::StaticOrder S; S.init(512, 1, G, bx);
                pg8::EpiBf16K<3> E{U, INP(12) + (size_t)l * 1024, 1.0f, 0, nullptr, nullptr, nullptr, nullptr};
                pg8::gemm_phase<pg8::EpiBf16K<3>, pg8::StaticOrder, PG8_ALIGN, PG8_SP2>(lds + RING_OFF, g, S, E, tid);
            }
            __syncthreads();
            for (int wgi = bx; wgi < 256; wgi += G) { const int item = (G == 256) ? ((((wgi & 7) + 8 * (wgi >> 5)) << 2) | ((wgi >> 3) & 3)) : wgi;
                mlstm_item(lds + RING_OFF, QC, KC, Z, GAT, HM, item, tid); }
            GRID_BAR();
        }
        if (IN(6)) for (int rep = 0; rep < NREP(6); ++rep) {
            PH_BEGIN();
            const float* hn = INP(10) + (size_t)l * 1024;
            const int hq = lane >> 4, i16 = lane & 15, col = hq * 256 + 16 * i16;
            f32x4 gn[4];
#pragma unroll
            for (int q = 0; q < 4; ++q) gn[q] = *(const GAS f32x4*)(hn + col + 4 * q);
            for (int m0 = 2 * gw; m0 < M; m0 += 2 * NGW) {
                v4u hh[2][2], og[2][2];
#pragma unroll
                for (int r2 = 0; r2 < 2; ++r2) { const size_t m = (size_t)(m0 + r2);
                    hh[r2][0] = *(const GAS v4u*)(HM + m * 1024 + col); hh[r2][1] = *(const GAS v4u*)(HM + m * 1024 + col + 8);
                    og[r2][0] = *(const GAS v4u*)(Z + m * ZP + 4096 + col); og[r2][1] = *(const GAS v4u*)(Z + m * ZP + 4096 + col + 8); }
#pragma unroll
                for (int r2 = 0; r2 < 2; ++r2) { const size_t m = (size_t)(m0 + r2);
                    f32x4 av[4], ov[4]; const v4u z0 = hh[r2][0], z1 = hh[r2][1], q0 = og[r2][0], q1 = og[r2][1];
#define UNPQ(dst, lo, hi) do { dst[0] = bflo(lo); dst[1] = bfhi(lo); dst[2] = bflo(hi); dst[3] = bfhi(hi); } while (0)
                    UNPQ(av[0], z0.x, z0.y); UNPQ(av[1], z0.z, z0.w); UNPQ(av[2], z1.x, z1.y); UNPQ(av[3], z1.z, z1.w);
                    UNPQ(ov[0], q0.x, q0.y); UNPQ(ov[1], q0.z, q0.w); UNPQ(ov[2], q1.x, q1.y); UNPQ(ov[3], q1.z, q1.w);
#undef UNPQ
                    float ss = 0.f;
                    ss = pg8::dot2_bf16(z0.x, ss); ss = pg8::dot2_bf16(z0.y, ss); ss = pg8::dot2_bf16(z0.z, ss); ss = pg8::dot2_bf16(z0.w, ss);
                    ss = pg8::dot2_bf16(z1.x, ss); ss = pg8::dot2_bf16(z1.y, ss); ss = pg8::dot2_bf16(z1.z, ss); ss = pg8::dot2_bf16(z1.w, ss);
                    ss += shfl_xor_l(ss, 1, lane); ss += shfl_xor_l(ss, 2, lane); ss += shfl_xor_l(ss, 4, lane); ss += shfl_xor_l(ss, 8, lane);
                    const float r = __builtin_amdgcn_rsqf(ss * (1.f / 256.f) + EPS);
                    f32x4 yv[4];
#pragma unroll
                    for (int q = 0; q < 4; ++q) { f32x4 e = ov[q] * -1.4426950408889634f;
#pragma unroll
                        for (int j = 0; j < 4; ++j) e[j] = __builtin_amdgcn_exp2f(e[j]);
                        e = e + 1.0f;
#pragma unroll
                        for (int j = 0; j < 4; ++j) e[j] = __builtin_amdgcn_rcpf(e[j]);
                        yv[q] = (av[q] * gn[q]) * r * e; }
                    v4u w0, w1; w0.x = pk2(yv[0][0], yv[0][1]); w0.y = pk2(yv[0][2], yv[0][3]); w0.z = pk2(yv[1][0], yv[1][1]); w0.w = pk2(yv[1][2], yv[1][3]);
                    w1.x = pk2(yv[2][0], yv[2][1]); w1.y = pk2(yv[2][2], yv[2][3]); w1.z = pk2(yv[3][0], yv[3][1]); w1.w = pk2(yv[3][2], yv[3][3]);
                    bf16* up = U + h16_off((int)m, 1024 + col); *(GAS v4u*)up = w0; *(GAS v4u*)(up + 8) = w1; }
            }
            GRID_BAR();
        }
        if (IN(7)) for (int rep = 0; rep < NREP(7); ++rep) {
            PH_BEGIN();
            const bool dummy = rep + 1 < NREP(7);
            pg8::Gemm g{U, WOUT, D, 0, 8, 1, 1}; pg8::StaticOrder S; S.init(128, 8, G, bx);
            pg8::EpiResid16 E{H16, dummy ? DUMMY16 : H16, 1.0f, dummy ? RSS(17) : RSS(4 * l + 2)};
            pg8::gemm_phase<pg8::EpiResid16, pg8::StaticOrder, false, PG8_SP2, true>(lds + RING_OFF, g, S, E, tid);
            GRID_BAR();
        }
        if (IN(8)) for (int rep = 0; rep < NREP(8); ++rep) {
            PH_BEGIN();
            pg8::Gemm g{H16, GT, D, 8, 4, 1}; pg8::StaticOrder S; S.init(128, 4, G, bx);
            pg8::EpiSoftmaxP E{PB, RSS(4 * l + 2), (LAS float*)(lds + LDSCTL_OFF + 1024)};
            pg8::gemm_phase<pg8::EpiSoftmaxP, pg8::StaticOrder, true, PG8_SP2, true>(lds + RING_OFF, g, S, E, tid);
            GRID_BAR();
        }
        if (IN(9)) for (int rep = 0; rep < NREP(9); ++rep) {
            PH_BEGIN();
            const bool dummy = rep + 1 < NREP(9);
            pg8::Gemm g{PB, VWT, 1024, 8, 8, 1}; pg8::StaticOrder S; S.init(128, 8, G, bx);
            pg8::EpiResid16 E{H16, dummy ? DUMMY16 : H16, 1.0f, dummy ? RSS(17) : RSS(4 * l + 3)};
            pg8::gemm_phase<pg8::EpiResid16, pg8::StaticOrder, false, PG8_SP2, true>(lds + RING_OFF, g, S, E, tid);
            GRID_BAR();
        }
        if (IN(10)) for (int rep = 0; rep < NREP(10); ++rep) {
            PH_BEGIN();
            pg8::Gemm g{H16, WGU2, D, 0, 44, 1, 1}; pg8::StaticOrder S; S.init(128, 44, G, bx);
            pg8::EpiSwiGLU E{HID, 64, RSS(4 * l + 3), (LAS float*)(lds + LDSCTL_OFF + 12288)};
            pg8::gemm_phase<pg8::EpiSwiGLU, pg8::StaticOrder, PG8_ALIGN, PG8_SP2, true>(lds + RING_OFF, g, S, E, tid);
            GRID_BAR();
        }
        if (IN(11)) for (int rep = 0; rep < NREP(11); ++rep) {
            PH_BEGIN();
            const bool dummy = rep + 1 < NREP(11);
            pg8::Gemm g{HID, WD2, FF, 0, 8, 1, 1}; pg8::StaticOrder S; S.init(128, 8, G, bx);
            pg8::EpiResid16 E{H16, dummy ? DUMMY16 : H16, 0.5f, dummy ? RSS(17) : RSS(4 * l + 4)};
            pg8::gemm_phase<pg8::EpiResid16, pg8::StaticOrder, false, PG8_SP2, true>(lds + RING_OFF, g, S, E, tid);
            GRID_BAR();
        }
    }
    if (args.do_final) {
        PH_BEGIN();
        const float* gf = INP(23);
        f32x4 gvv[8];
#pragma unroll
        for (int j = 0; j < 8; ++j) gvv[j] = *((const GAS f32x4*)gf + lane + 64 * j);
        for (int m = gw; m < M; m += NGW) {
            const float r = pg8::rms_scale(RSS(16), m);
            GAS f32x4* orow = (GAS f32x4*)(args.out + (size_t)m * D) + lane;
            v2u w[8];
#pragma unroll
            for (int j = 0; j < 8; ++j) w[j] = *(const GAS v2u*)(H16 + h16_off(m, 256 * j + 4 * lane));
#pragma unroll
            for (int j = 0; j < 8; ++j) { f32x4 x; x[0] = bflo(w[j].x); x[1] = bfhi(w[j].x); x[2] = bflo(w[j].y); x[3] = bfhi(w[j].y);
                __builtin_nontemporal_store(x * r * gvv[j], orow + 64 * j); }
        }
    }
#undef IN
#undef GRID_BAR
}

extern "C" void kernel_launch(void* const* d_in, const int* in_sizes, int n_in, void* d_out, int out_size, void* d_ws, size_t ws_size, hipStream_t stream) {
    static int grid = 0;
    if (grid == 0) {
        if (n_in != 24 || in_sizes[0] != M * D || out_size != M * D || ws_size < WS_END) { fprintf(stderr, "kernel_launch: unexpected shapes / workspace (n_in %d, ws %zu, need %zu)\n", n_in, ws_size, (size_t)WS_END); grid = -1; return; }
        int dev = 0, cus = 0;
        if (hipGetDevice(&dev) != hipSuccess || hipDeviceGetAttribute(&cus, hipDeviceAttributeMultiprocessorCount, dev) != hipSuccess) { grid = -1; return; }
        if (hipFuncSetAttribute((const void*)fwd, hipFuncAttributeMaxDynamicSharedMemorySize, LDS_BYTES) != hipSuccess) { fprintf(stderr, "kernel_launch: hipFuncSetAttribute failed\n"); grid = -1; return; }
        int per_cu = 0;
        if (hipOccupancyMaxActiveBlocksPerMultiprocessor(&per_cu, (const void*)fwd, NWAVES * 64, LDS_BYTES) != hipSuccess || per_cu < 1) { fprintf(stderr, "kernel_launch: occupancy query says %d\n", per_cu); }
        (void)hipGetLastError();
        grid = cus;
    }
    if (grid < 0) return;
    (void)hipMemsetAsync((char*)d_ws + WS_CTL, 0, CTL_ZERO_BYTES, stream);
    Args a{};
    for (int i = 0; i < 24; ++i) a.in[i] = (const float*)d_in[i];
    a.out = (float*)d_out; a.ws = (unsigned char*)d_ws;
#if MK_ONE_LAUNCH
    a.l_lo = 0; a.l_hi = DEPTH; a.ph_lo = 0; a.ph_hi = N_PH; a.use_bar = 1; a.do_init = 1; a.do_final = 1;
    hipLaunchKernelGGL(fwd, dim3(grid), dim3(NWAVES * 64), LDS_BYTES, stream, a);
#else
    a.l_lo = 0; a.l_hi = 0; a.ph_lo = 0; a.ph_hi = 0; a.use_bar = 0; a.do_init = 1; a.do_final = 0;
    hipLaunchKernelGGL(fwd, dim3(grid), dim3(NWAVES * 64), LDS_BYTES, stream, a);
    for (int l = 0; l < DEPTH; ++l)
        for (int ph = 0; ph < N_PH; ++ph) {
            a.l_lo = l; a.l_hi = l + 1; a.ph_lo = ph; a.ph_hi = ph + 1; a.use_bar = 0; a.do_init = 0; a.do_final = 0;
            hipLaunchKernelGGL(fwd, dim3(grid), dim3(NWAVES * 64), LDS_BYTES, stream, a);
        }
    a.l_lo = 0; a.l_hi = 0; a.ph_lo = 0; a.ph_hi = 0; a.use_bar = 0; a.do_init = 0; a.do_final = 1;
    hipLaunchKernelGGL(fwd, dim3(grid), dim3(NWAVES * 64), LDS_BYTES, stream, a);
#endif
}
```
